# Optimizing an MI355X kernel written in HIP

```python
import math
import jax, jax.numpy as jnp
from jax import lax
import numpy as np

D_MODEL = 1024
BATCH = 8
SEQ = 8192
DEPTH = 1
DEC_BATCH = 32
DEC_SEQ = 32
PAST_LEN = 1024

CHUNK = 64
Q_BLOCK = 128
N_MEM = 256
EPS = 1e-6
DA_HEADS = 4
DA_HEAD_DIM = D_MODEL // 16
DA_VDIM = 2 * DA_HEAD_DIM
DA_QK = DA_HEADS * 2 * DA_HEAD_DIM
DA_WIDTH = DA_HEADS * DA_VDIM
ROPE_THETA = 500000.0
ROT_DIM = DA_HEAD_DIM // 4
LRU_WIDTH = D_MODEL // 4
LRU_BLOCKS = 4
LRU_BLOCK = LRU_WIDTH // LRU_BLOCKS
CONV_W = 4
LRU_C = 8.0
MX_HEADS = 4
MX_HEAD_DIM = D_MODEL // 16
MX_WIDTH = MX_HEADS * MX_HEAD_DIM
MIX_WIDTH = DA_WIDTH + LRU_WIDTH + MX_WIDTH
IN_SIZES = (DA_QK, DA_QK, DA_WIDTH, DA_WIDTH, LRU_WIDTH, LRU_WIDTH, MX_WIDTH, MX_WIDTH)
IN_WIDTH = 2 * DA_QK + 2 * DA_WIDTH + 2 * LRU_WIDTH + 2 * MX_WIDTH

kernel_name = "hybrid_diffattn_rglru_memxattn_stream_step"


def rms_norm(x, g):
    xf = x.astype(jnp.float32)
    y = xf * lax.rsqrt(jnp.mean(xf * xf, axis=-1, keepdims=True) + EPS)
    return (y * g.astype(jnp.float32)).astype(x.dtype)


def rope(x, pos):
    half = ROT_DIM // 2
    inv = ROPE_THETA ** (-jnp.arange(0, ROT_DIM, 2, dtype=jnp.float32) / ROT_DIM)
    ang = pos.astype(jnp.float32)[:, None] * inv[None, :]
    shape = (1, pos.shape[0]) + (1,) * (x.ndim - 3) + (half,)
    cos = jnp.cos(ang).reshape(shape)
    sin = jnp.sin(ang).reshape(shape)
    xr = x[..., :ROT_DIM].astype(jnp.float32)
    x1, x2 = xr[..., :half], xr[..., half:]
    rot = jnp.concatenate([x1 * cos - x2 * sin, x2 * cos + x1 * sin], axis=-1).astype(x.dtype)
    return jnp.concatenate([rot, x[..., ROT_DIM:]], axis=-1)


def split_cols(t, sizes):
    idx, acc = [], 0
    for s in sizes[:-1]:
        acc += s
        idx.append(acc)
    return jnp.split(t, idx, axis=-1)


def diff_attend(q, k, v, q_pos, k_pos, lam):
    s = jnp.einsum('bqhcd,bkhcd->bhcqk', q, k).astype(jnp.float32) * (DA_HEAD_DIM ** -0.5)
    mask = (k_pos[None, :] // CHUNK) <= (q_pos[:, None] // CHUNK)
    s = jnp.where(mask[None, None, None], s, jnp.float32(-1e30))
    p = jax.nn.softmax(s, axis=-1)
    w = p[:, :, 0] - lam * p[:, :, 1]
    return jnp.einsum('bhqk,bkhe->bqhe', w.astype(v.dtype), v)


def lru_branch(xb, conv_buf, h0, conv_w, conv_b, w_a, b_a, w_x, b_x, lru_lambda):
    B, T, W = xb.shape
    xp = jnp.concatenate([conv_buf.astype(xb.dtype), xb], axis=1)
    xc = conv_b
    for j in range(CONV_W):
        xc = xc + xp[:, j:j + T] * conv_w[j]
    new_buf = xp[:, -(CONV_W - 1):]
    xbk = xc.reshape(B, T, LRU_BLOCKS, LRU_BLOCK)
    r = jax.nn.sigmoid(jnp.einsum('btni,nij->btnj', xbk, w_a).reshape(B, T, W) + b_a)
    i = jax.nn.sigmoid(jnp.einsum('btni,nij->btnj', xbk, w_x).reshape(B, T, W) + b_x)
    log_a = -LRU_C * r.astype(jnp.float32) * jax.nn.softplus(-lru_lambda.astype(jnp.float32))
    a = jnp.exp(log_a)
    b = jnp.sqrt(-jnp.expm1(2.0 * log_a)) * (i * xc).astype(jnp.float32)

    def combine(e, l):
        return (e[0] * l[0], l[0] * e[1] + l[1])

    a_cum, h = lax.associative_scan(combine, (a, b), axis=1)
    h = h + a_cum * h0.astype(jnp.float32)[:, None, :]
    return h.astype(xb.dtype), new_buf, h[:, -1].astype(xb.dtype)


def mem_kv(mem, mem_norm_g, w_mem_kv, mx_k_norm_g):
    B, N, _ = mem.shape
    kv = rms_norm(mem, mem_norm_g) @ w_mem_kv
    k, v = split_cols(kv, (MX_WIDTH, MX_WIDTH))
    k = rms_norm(k.reshape(B, N, MX_HEADS, MX_HEAD_DIM), mx_k_norm_g)
    return k, v.reshape(B, N, MX_HEADS, MX_HEAD_DIM)


def layer(x, q_pos, past_k, past_v, conv_buf, h0, m_k, m_v, p, lambda_init, blocked):
    B, T, _ = x.shape
    hn = rms_norm(x, p['norm_g'])
    proj = hn @ p['w_in']
    dq, dk, dv, dg, lx, lg, mq, mg = split_cols(proj, IN_SIZES)
    q = rope(rms_norm(dq.reshape(B, T, DA_HEADS, 2, DA_HEAD_DIM), p['da_q_norm_g']), q_pos)
    k_new = rope(rms_norm(dk.reshape(B, T, DA_HEADS, 2, DA_HEAD_DIM), p['da_k_norm_g']), q_pos)
    v_new = dv.reshape(B, T, DA_HEADS, DA_VDIM)
    if past_k is None:
        k_all, v_all, k_pos = k_new, v_new, q_pos
    else:
        k_all = jnp.concatenate([past_k.astype(k_new.dtype), k_new], axis=1)
        v_all = jnp.concatenate([past_v.astype(v_new.dtype), v_new], axis=1)
        k_pos = jnp.arange(past_k.shape[1] + T, dtype=jnp.int32)
    f32 = jnp.float32
    lam = (jnp.exp(jnp.sum(p['lambda_q1'].astype(f32) * p['lambda_k1'].astype(f32)))
           - jnp.exp(jnp.sum(p['lambda_q2'].astype(f32) * p['lambda_k2'].astype(f32))) + lambda_init)
    if blocked:
        nb = T // Q_BLOCK
        qb = q.reshape(B, nb, Q_BLOCK, DA_HEADS, 2, DA_HEAD_DIM).transpose(1, 0, 2, 3, 4, 5)
        pb = q_pos.reshape(nb, Q_BLOCK)
        ob = lax.map(lambda a: diff_attend(a[0], k_all, v_all, a[1], k_pos, lam), (qb, pb))
        o = ob.transpose(1, 0, 2, 3, 4).reshape(B, T, DA_HEADS, DA_VDIM)
    else:
        o = diff_attend(q, k_all, v_all, q_pos, k_pos, lam)
    o = rms_norm(o, p['da_subln_g']) * (1.0 - lambda_init)
    out_a = o.reshape(B, T, DA_WIDTH) * jax.nn.silu(dg)
    hl, new_buf, h_last = lru_branch(lx, conv_buf, h0, p['lru_conv_w'], p['lru_conv_b'], p['lru_w_a'],
                                     p['lru_b_a'], p['lru_w_x'], p['lru_b_x'], p['lru_lambda'])
    out_b = hl * jax.nn.silu(lg)
    qm = rms_norm(mq.reshape(B, T, MX_HEADS, MX_HEAD_DIM), p['mx_q_norm_g'])
    sm = jnp.einsum('bqhd,bkhd->bhqk', qm, m_k.astype(qm.dtype)).astype(f32) * (MX_HEAD_DIM ** -0.5)
    pm = jax.nn.softmax(sm, axis=-1)
    om = jnp.einsum('bhqk,bkhd->bqhd', pm.astype(qm.dtype), m_v.astype(qm.dtype)).reshape(B, T, MX_WIDTH)
    out_c = om * jax.nn.silu(mg)
    y = x + jnp.concatenate([out_a, out_b, out_c], axis=-1) @ p['w_out']
    return y, k_new, v_new, new_buf, h_last


def setup_inputs(seed: int = 0) -> dict:
    key = jax.random.key(seed)
    ks = jax.random.split(key, 40)
    n = lambda i, shape, s=1.0: jax.random.normal(ks[i], shape, jnp.float32) * s
    a8 = jax.random.uniform(ks[39], (DEPTH, LRU_WIDTH), jnp.float32, 0.9, 0.999)
    a0 = a8 ** (1.0 / LRU_C)
    return {
        'x_prompt': n(0, (BATCH, SEQ, D_MODEL)),
        'x_sample': n(1, (DEC_BATCH, DEC_SEQ, D_MODEL)),
        'mem_prompt': n(2, (BATCH, N_MEM, D_MODEL)),
        'cache_diff_k': n(3, (DEPTH, DEC_BATCH, PAST_LEN, DA_HEADS, 2, DA_HEAD_DIM)),
        'cache_diff_v': n(4, (DEPTH, DEC_BATCH, PAST_LEN, DA_HEADS, DA_VDIM)),
        'cache_mem_k': n(5, (DEPTH, DEC_BATCH, N_MEM, MX_HEADS, MX_HEAD_DIM)),
        'cache_mem_v': n(6, (DEPTH, DEC_BATCH, N_MEM, MX_HEADS, MX_HEAD_DIM)),
        'state_lru_conv': n(7, (DEPTH, DEC_BATCH, CONV_W - 1, LRU_WIDTH)),
        'state_lru_h': n(8, (DEPTH, DEC_BATCH, LRU_WIDTH)),
        'norm_g': 1.0 + n(9, (DEPTH, D_MODEL), 0.02),
        'w_in': n(10, (DEPTH, D_MODEL, IN_WIDTH), D_MODEL ** -0.5),
        'da_q_norm_g': 1.0 + n(11, (DEPTH, DA_HEAD_DIM), 0.02),
        'da_k_norm_g': 1.0 + n(12, (DEPTH, DA_HEAD_DIM), 0.02),
        'lambda_q1': n(13, (DEPTH, DA_HEAD_DIM), 0.1),
        'lambda_k1': n(14, (DEPTH, DA_HEAD_DIM), 0.1),
        'lambda_q2': n(15, (DEPTH, DA_HEAD_DIM), 0.1),
        'lambda_k2': n(16, (DEPTH, DA_HEAD_DIM), 0.1),
        'da_subln_g': 1.0 + n(17, (DEPTH, DA_VDIM), 0.02),
        'lru_conv_w': n(18, (DEPTH, CONV_W, LRU_WIDTH), CONV_W ** -0.5),
        'lru_conv_b': n(19, (DEPTH, LRU_WIDTH), 0.01),
        'lru_w_a': n(20, (DEPTH, LRU_BLOCKS, LRU_BLOCK, LRU_BLOCK), LRU_BLOCK ** -0.5),
        'lru_b_a': n(21, (DEPTH, LRU_WIDTH), 0.01),
        'lru_w_x': n(22, (DEPTH, LRU_BLOCKS, LRU_BLOCK, LRU_BLOCK), LRU_BLOCK ** -0.5),
        'lru_b_x': n(23, (DEPTH, LRU_WIDTH), 0.01),
        'lru_lambda': jnp.log(a0) - jnp.log1p(-a0),
        'mem_norm_g': 1.0 + n(24, (DEPTH, D_MODEL), 0.02),
        'w_mem_kv': n(25, (DEPTH, D_MODEL, 2 * MX_WIDTH), D_MODEL ** -0.5),
        'mx_q_norm_g': 1.0 + n(26, (DEPTH, MX_HEAD_DIM), 0.02),
        'mx_k_norm_g': 1.0 + n(27, (DEPTH, MX_HEAD_DIM), 0.02),
        'w_out': n(28, (DEPTH, MIX_WIDTH, D_MODEL), MIX_WIDTH ** -0.5),
    }


def reference(x_prompt, x_sample, mem_prompt, cache_diff_k, cache_diff_v, cache_mem_k, cache_mem_v,
              state_lru_conv, state_lru_h, norm_g, w_in, da_q_norm_g, da_k_norm_g, lambda_q1, lambda_k1,
              lambda_q2, lambda_k2, da_subln_g, lru_conv_w, lru_conv_b, lru_w_a, lru_b_a, lru_w_x, lru_b_x,
              lru_lambda, mem_norm_g, w_mem_kv, mx_q_norm_g, mx_k_norm_g, w_out):
    Bp, Tp, _ = x_prompt.shape
    Bs, Ts, _ = x_sample.shape
    pos_p = jnp.arange(Tp, dtype=jnp.int32)
    pos_s = cache_diff_k.shape[2] + jnp.arange(Ts, dtype=jnp.int32)
    yp, ys = x_prompt, x_sample
    kp_l, vp_l, mkp_l, mvp_l, cp_l, hp_l = [], [], [], [], [], []
    ks_l, vs_l, cs_l, hs_l = [], [], [], []
    for l in range(DEPTH):
        p = dict(norm_g=norm_g[l], w_in=w_in[l], da_q_norm_g=da_q_norm_g[l], da_k_norm_g=da_k_norm_g[l],
                 lambda_q1=lambda_q1[l], lambda_k1=lambda_k1[l], lambda_q2=lambda_q2[l], lambda_k2=lambda_k2[l],
                 da_subln_g=da_subln_g[l], lru_conv_w=lru_conv_w[l], lru_conv_b=lru_conv_b[l],
                 lru_w_a=lru_w_a[l], lru_b_a=lru_b_a[l], lru_w_x=lru_w_x[l], lru_b_x=lru_b_x[l],
                 lru_lambda=lru_lambda[l], mx_q_norm_g=mx_q_norm_g[l], w_out=w_out[l])
        lambda_init = 0.8 - 0.6 * math.exp(-0.3 * l)
        mk_p, mv_p = mem_kv(mem_prompt, mem_norm_g[l], w_mem_kv[l], mx_k_norm_g[l])
        zbuf = jnp.zeros((Bp, CONV_W - 1, LRU_WIDTH), yp.dtype)
        zh = jnp.zeros((Bp, LRU_WIDTH), yp.dtype)
        yp, k_p, v_p, c_p, h_p = layer(yp, pos_p, None, None, zbuf, zh, mk_p, mv_p, p, lambda_init,
                                       Tp > Q_BLOCK and Tp % Q_BLOCK == 0)
        ys, k_s, v_s, c_s, h_s = layer(ys, pos_s, cache_diff_k[l], cache_diff_v[l], state_lru_conv[l],
                                       state_lru_h[l], cache_mem_k[l], cache_mem_v[l], p, lambda_init, False)
        kp_l.append(k_p); vp_l.append(v_p); mkp_l.append(mk_p); mvp_l.append(mv_p)
        cp_l.append(c_p); hp_l.append(h_p)
        ks_l.append(k_s); vs_l.append(v_s); cs_l.append(c_s); hs_l.append(h_s)
    return (yp, ys,
            jnp.stack(kp_l), jnp.stack(vp_l), jnp.stack(mkp_l), jnp.stack(mvp_l),
            jnp.stack(cp_l), jnp.stack(hp_l),
            jnp.stack(ks_l), jnp.stack(vs_l), jnp.stack(cs_l), jnp.stack(hs_l))
```

```cpp
#include <hip/hip_runtime.h>
#include <hip/hip_cooperative_groups.h>
#include <cstdio>
#include <cstdint>
#include <cmath>
namespace cg = cooperative_groups;
#ifndef MK_N_LAUNCHES
#define MK_N_LAUNCHES 1
#endif
namespace pg8 {
#define PG8_LAS __attribute__((address_space(3)))
typedef unsigned short bf16_t;
typedef short bf16x8 __attribute__((ext_vector_type(8)));
typedef float f32x4 __attribute__((ext_vector_type(4)));
typedef unsigned u32x4 __attribute__((ext_vector_type(4)));
constexpr int BM = 256, BK = 64, HALF = 128, HTB = HALF * BK * 2  , STAGE_BYTES = 8 * HTB, NXCD = 8, WGM = 8;

__host__ __device__ __forceinline__ int lds_byte(int r, int c) { const int st = (r >> 4) * 2 + (c >> 5), rr = r & 15, cc = c & 31, ob = rr * 64 + cc * 2; return st * 1024 + (ob ^ (((ob >> 9) & 1) << 5)); }
__host__ __device__ __forceinline__ void stage_rc(int b, int& R, int& C) { const int st = b / 1024, sb = b % 1024, swz = sb ^ (((sb >> 9) & 1) << 5); R = (st >> 1) * 16 + swz / 64; C = (st & 1) * 32 + (swz % 64) / 2; }
__host__ __device__ __forceinline__ int perm32(int rho) { const int n = rho >> 4, i = rho & 15; return 8 * (i >> 2) + 4 * n + (i & 3); }

struct Unit { int pm, pn; };
struct Gemm { const bf16_t* A; const bf16_t* Bt; int M, N, K; };

struct StaticOrder {
    int nM, nN, nwg, G, c;
    __host__ __device__ void init(int M, int N, int G_, int c_) { nM = M / BM; nN = N / BM; nwg = nM * nN; G = G_; c = c_; }
    __host__ __device__ bool next(int i, Unit& u) const {
        const long L = (long)i * G + c; if (L >= nwg) return false;
        int wgid = (int)L; { const int q = nwg / NXCD, r = nwg % NXCD, xcd = wgid % NXCD, off = wgid / NXCD; wgid = (xcd < r ? xcd * (q + 1) : r * (q + 1) + (xcd - r) * q) + off; }
        const int nig = WGM * nN, gid = wgid / nig, fm = gid * WGM, gsz = (nM - fm) < WGM ? (nM - fm) : WGM;
        u.pm = fm + ((wgid % nig) % gsz); u.pn = (wgid % nig) / gsz; return true;
    }
    __device__ __forceinline__ void a_ready(const Unit&) const {}
    __device__ __forceinline__ void done(const Unit&) const {}
};

__device__ __forceinline__ unsigned cvt_pk_bf16(float lo, float hi) { unsigned r; asm volatile("v_cvt_pk_bf16_f32 %0, %1, %2" : "=v"(r) : "v"(lo), "v"(hi)); return r; }
typedef float f32x2 __attribute__((ext_vector_type(2)));
template <class Epi, class Sched, bool ALIGN_EPI = false, bool SP2 = false>
__device__ __forceinline__ void gemm_phase(PG8_LAS unsigned char* lds, const Gemm g, const Sched& S, const Epi& E) {
    const int tid = threadIdx.x, wid = __builtin_amdgcn_readfirstlane(tid >> 6), lane = tid & 63, wr = wid >> 2, wc = wid & 3, fr = lane & 15, fq = lane >> 4;
    const int K = g.K, nt = K / BK;
    unsigned voffA[2], voffB[2];
#pragma unroll
    for (int i = 0; i < 2; ++i) { int R, C; stage_rc(tid * 16 + i * 8192, R, C); const int Rb = Epi::PERM ? ((R & ~31) + perm32(R & 31)) : R;
        voffA[i] = (unsigned)(R * K + C) * 2u; voffB[i] = (unsigned)(Rb * K + C) * 2u; }
    const size_t kstep = (size_t)(BK * 2);
    const size_t hstep = (size_t)HALF * K * 2;
    const size_t tstep = 2 * hstep;
    const unsigned ldsw = (unsigned)wid * 1024u;
    const int aoff = lds_byte(wr * 64 + fr, fq * 8), boff = lds_byte(wc * 32 + fr, fq * 8);
#define PG8_SA(b, h) (((b) * 2 + (h)) * HTB)
#define PG8_SB(b, h) ((4 + (b) * 2 + (h)) * HTB)
#define PG8_STAGE(bufoff, gbase, voff) do { _Pragma("unroll") for (int _i = 0; _i < 2; ++_i) \
        __builtin_amdgcn_global_load_lds((const unsigned*)((const char*)(gbase) + (voff)[_i]), (PG8_LAS unsigned*)(lds + (bufoff) + ldsw + _i * 8192), 16, 0, 0); } while (0)
#define PG8_LDA(dst, b, h) do { _Pragma("unroll") for (int m = 0; m < 4; ++m) _Pragma("unroll") for (int k = 0; k < 2; ++k) dst[m][k] = *(const PG8_LAS bf16x8*)(lds + PG8_SA(b, h) + aoff + m * 2048 + k * 1024); } while (0)
#define PG8_LDB(dst, b, h) do { _Pragma("unroll") for (int n = 0; n < 2; ++n) _Pragma("unroll") for (int k = 0; k < 2; ++k) dst[n][k] = *(const PG8_LAS bf16x8*)(lds + PG8_SB(b, h) + boff + n * 2048 + k * 1024); } while (0)
#define PG8_MMA(ai, bj, At, Bt) do { __builtin_amdgcn_s_setprio(1); _Pragma("unroll") for (int m = 0; m < 4; ++m) _Pragma("unroll") for (int n = 0; n < 2; ++n) _Pragma("unroll") for (int k = 0; k < 2; ++k) \
        acc[ai][bj][m][n] = __builtin_amdgcn_mfma_f32_16x16x32_bf16(Bt[n][k], At[m][k], acc[ai][bj][m][n], 0, 0, 0); __builtin_amdgcn_s_setprio(0); } while (0)
#define PG8_WAIT_V(n) asm volatile("s_waitcnt vmcnt(" #n ")" ::: "memory")
#define PG8_WAIT_L(n) asm volatile("s_waitcnt lgkmcnt(" #n ")" ::: "memory")
#define PG8_BAR __builtin_amdgcn_s_barrier()
#define PG8_SCHED __builtin_amdgcn_sched_barrier(0)
    Unit cur, nxt; int ui = 0;
    if (!S.next(0, cur)) return;
    f32x4 acc[2][2][4][2];
#pragma unroll
    for (int a = 0; a < 2; ++a)
#pragma unroll
        for (int b = 0; b < 2; ++b)
#pragma unroll
            for (int m = 0; m < 4; ++m)
#pragma unroll
                for (int n = 0; n < 2; ++n) acc[a][b][m][n] = (f32x4){0.f, 0.f, 0.f, 0.f};
    bf16x8 At[4][2], B0[2][2], B1[2][2];
    const char* cA = (const char*)g.A + (size_t)cur.pm * tstep; const char* cB = (const char*)g.Bt + (size_t)cur.pn * tstep;
    S.a_ready(cur);
    if constexpr (SP2) {
        PG8_STAGE(PG8_SB(0, 0), cB, voffB); PG8_STAGE(PG8_SB(0, 1), cB + hstep, voffB); PG8_STAGE(PG8_SA(0, 0), cA, voffA); PG8_STAGE(PG8_SA(0, 1), cA + hstep, voffA);
        if (wr == 1) PG8_BAR;
        PG8_WAIT_V(2); PG8_BAR;
        PG8_STAGE(PG8_SB(1, 0), cB + kstep, voffB); PG8_STAGE(PG8_SA(1, 0), cA + kstep, voffA); PG8_STAGE(PG8_SB(1, 1), cB + hstep + kstep, voffB);
        PG8_WAIT_V(6); PG8_BAR;
    } else {
        PG8_STAGE(PG8_SB(0, 0), cB, voffB); PG8_STAGE(PG8_SA(0, 0), cA, voffA); PG8_STAGE(PG8_SB(0, 1), cB + hstep, voffB); PG8_STAGE(PG8_SA(0, 1), cA + hstep, voffA);
        if (wr == 1) PG8_BAR;
        PG8_WAIT_V(4); PG8_BAR;
        PG8_STAGE(PG8_SB(1, 0), cB + kstep, voffB); PG8_STAGE(PG8_SA(1, 0), cA + kstep, voffA); PG8_STAGE(PG8_SB(1, 1), cB + hstep + kstep, voffB);
        PG8_WAIT_V(6); PG8_BAR;
    }
    for (;;) {
        const bool has_next = S.next(ui + 1, nxt);
        const char* nA = has_next ? (const char*)g.A + (size_t)nxt.pm * tstep : cA; const char* nB = has_next ? (const char*)g.Bt + (size_t)nxt.pn * tstep : cB;
        for (int t = 0; t < nt; t += 2) {
            const bool last = (t == nt - 2);
            const char* a1 = cA + (size_t)(t + 1) * kstep;
            const char* a2 = last ? nA : cA + (size_t)(t + 2) * kstep; const char* b2 = last ? nB : cB + (size_t)(t + 2) * kstep;
            const char* a3 = a2 + kstep; const char* b3 = b2 + kstep;
            if (last && has_next) S.a_ready(nxt);
            if constexpr (SP2) {
            PG8_LDB(B0, 0, 0); PG8_LDB(B1, 0, 1); PG8_SCHED; PG8_LDA(At, 0, 0); PG8_STAGE(PG8_SA(1, 1), a1 + hstep, voffA);
            PG8_WAIT_V(8); PG8_WAIT_L(0); PG8_BAR; PG8_MMA(0, 0, At, B0); PG8_MMA(0, 1, At, B1); PG8_BAR; PG8_SCHED;
            PG8_LDA(At, 0, 1); PG8_STAGE(PG8_SB(0, 0), b2, voffB); PG8_STAGE(PG8_SB(0, 1), b2 + hstep, voffB); PG8_STAGE(PG8_SA(0, 0), a2, voffA);
            PG8_WAIT_V(8); PG8_WAIT_L(0); PG8_BAR; PG8_MMA(1, 0, At, B0); PG8_MMA(1, 1, At, B1); PG8_BAR; PG8_SCHED;
            PG8_LDB(B0, 1, 0); PG8_LDB(B1, 1, 1); PG8_SCHED; PG8_LDA(At, 1, 0); PG8_STAGE(PG8_SA(0, 1), a2 + hstep, voffA);
            PG8_WAIT_V(8); PG8_WAIT_L(0); PG8_BAR; PG8_MMA(0, 0, At, B0); PG8_MMA(0, 1, At, B1); PG8_BAR; PG8_SCHED;
            PG8_LDA(At, 1, 1); PG8_STAGE(PG8_SB(1, 0), b3, voffB); PG8_STAGE(PG8_SB(1, 1), b3 + hstep, voffB); PG8_STAGE(PG8_SA(1, 0), a3, voffA);
            PG8_WAIT_V(8); PG8_WAIT_L(0); PG8_BAR; PG8_MMA(1, 0, At, B0); PG8_MMA(1, 1, At, B1); PG8_BAR; PG8_SCHED;
            } else {
            PG8_LDB(B0, 0, 0); PG8_SCHED; PG8_LDA(At, 0, 0); PG8_STAGE(PG8_SA(1, 1), a1 + hstep, voffA);
            PG8_WAIT_L(8); PG8_BAR; PG8_WAIT_L(0); PG8_MMA(0, 0, At, B0); PG8_BAR; PG8_SCHED;
            PG8_LDB(B1, 0, 1); PG8_STAGE(PG8_SB(0, 0), b2, voffB);
            PG8_BAR; PG8_WAIT_L(0); PG8_MMA(0, 1, At, B1); PG8_BAR;
            PG8_LDA(At, 0, 1); PG8_STAGE(PG8_SA(0, 0), a2, voffA);
            PG8_BAR; PG8_WAIT_L(0); PG8_MMA(1, 0, At, B0); PG8_BAR; PG8_SCHED;
            PG8_STAGE(PG8_SB(0, 1), b2 + hstep, voffB);
            PG8_WAIT_V(6); PG8_BAR; PG8_MMA(1, 1, At, B1); PG8_BAR;
            PG8_LDB(B0, 1, 0); PG8_SCHED; PG8_LDA(At, 1, 0); PG8_STAGE(PG8_SA(0, 1), a2 + hstep, voffA);
            PG8_WAIT_L(8); PG8_BAR; PG8_WAIT_L(0); PG8_MMA(0, 0, At, B0); PG8_BAR; PG8_SCHED;
            PG8_LDB(B1, 1, 1); PG8_STAGE(PG8_SB(1, 0), b3, voffB);
            PG8_BAR; PG8_WAIT_L(0); PG8_MMA(0, 1, At, B1); PG8_BAR;
            PG8_LDA(At, 1, 1); PG8_STAGE(PG8_SA(1, 0), a3, voffA);
            PG8_BAR; PG8_WAIT_L(0); PG8_MMA(1, 0, At, B0); PG8_BAR; PG8_SCHED;
            PG8_STAGE(PG8_SB(1, 1), b3 + hstep, voffB);
            PG8_WAIT_V(6); PG8_BAR; PG8_MMA(1, 1, At, B1); PG8_BAR;
            }
        }
        if constexpr (ALIGN_EPI) { if (wr == 0) PG8_BAR; }
        if constexpr (!Epi::AFTER_DRAIN) { E(acc, cur, wr, wc, fr, fq); S.done(cur); }
        if (!has_next) break;
#pragma unroll
        for (int a = 0; a < 2; ++a)
#pragma unroll
            for (int b = 0; b < 2; ++b)
#pragma unroll
                for (int m = 0; m < 4; ++m)
#pragma unroll
                    for (int n = 0; n < 2; ++n) acc[a][b][m][n] = (f32x4){0.f, 0.f, 0.f, 0.f};
        cur = nxt; cA = nA; cB = nB; ++ui;
        if constexpr (ALIGN_EPI) { if (wr == 1) PG8_BAR; }
    }
    PG8_WAIT_V(0);
    if constexpr (!ALIGN_EPI) { if (wr == 0) PG8_BAR; }
    PG8_BAR;
    if constexpr (Epi::AFTER_DRAIN) { E.fused(acc, cur, wr, wc, fr, fq, lds, wid, lane); S.done(cur); }
#undef PG8_SA
#undef PG8_SB
#undef PG8_STAGE
#undef PG8_LDA
#undef PG8_LDB
#undef PG8_MMA
#undef PG8_WAIT_V
#undef PG8_WAIT_L
#undef PG8_BAR
#undef PG8_SCHED
}
}

constexpr int NB = 8, SEQ = 8192, SBAT = 32, STOK = 32, PAST = 1024;
constexpr int NTOK_P = NB * SEQ;
constexpr int NTOK_S = SBAT * STOK;
constexpr int NTOK = NTOK_P + NTOK_S;
constexpr int NMEMROW = NB * 256;
constexpr int AROWS = NTOK + NMEMROW;
constexpr int KSROWS = 1088;
constexpr float EPSN = 1e-6f;
constexpr float C2 = 0.125f * 1.4426950408889634f;
constexpr float ONE_M_LINIT = 0.8f, LAMBDA_INIT = 0.2f;
constexpr size_t O_YP = 0;
constexpr size_t O_YS = O_YP + (size_t)NTOK_P * 1024;
constexpr size_t O_KP = O_YS + (size_t)NTOK_S * 1024;
constexpr size_t O_VP = O_KP + (size_t)NTOK_P * 512;
constexpr size_t O_MK = O_VP + (size_t)NTOK_P * 512;
constexpr size_t O_MV = O_MK + (size_t)NMEMROW * 256;
constexpr size_t O_CP = O_MV + (size_t)NMEMROW * 256;
constexpr size_t O_HP = O_CP + 8 * 3 * 256;
constexpr size_t O_KS = O_HP + 8 * 256;
constexpr size_t O_VS = O_KS + (size_t)NTOK_S * 512;
constexpr size_t O_CS = O_VS + (size_t)NTOK_S * 512;
constexpr size_t O_HS = O_CS + 32 * 3 * 256;
constexpr size_t O_END = O_HS + 32 * 256;
constexpr size_t MiB = 1u << 20;
constexpr size_t WS_WIN = 0, WS_WOUT = 8 * MiB, WS_ROPE = 10 * MiB, WS_SEGA = 11 * MiB, WS_SEGH = 12 * MiB, WS_AALL = 16 * MiB,
                 WS_QB = 152 * MiB, WS_KB = 218 * MiB, WS_VB = 282 * MiB, WS_KS = 346 * MiB, WS_VS = 382 * MiB, WS_MIX = 418 * MiB,
                 WS_LX = 548 * MiB, WS_MQ = 614 * MiB, WS_MKA = 648 * MiB, WS_MVA = 654 * MiB, WS_HL = 660 * MiB, WS_AC = 724 * MiB, WS_END = 788 * MiB;
constexpr int LDS_BYTES = 147456;
constexpr int LDS_WSF = 133120;
constexpr int RED_SLOT_F = 33280 / 4;

typedef unsigned short bf16_t;
typedef float f32x4 __attribute__((ext_vector_type(4)));
typedef float f32x2v __attribute__((ext_vector_type(2)));
typedef unsigned u32x4 __attribute__((ext_vector_type(4)));
typedef unsigned u32x2 __attribute__((ext_vector_type(2)));
#define LAS __attribute__((address_space(3)))

__device__ __forceinline__ unsigned f2bf(float f) { unsigned u = __builtin_bit_cast(unsigned, f); return (u + 0x7fffu + ((u >> 16) & 1u)) >> 16; }
__device__ __forceinline__ unsigned pk2(float lo, float hi) { return f2bf(lo) | (f2bf(hi) << 16); }
__device__ __forceinline__ float bf2f(unsigned short b) { return __builtin_bit_cast(float, (unsigned)b << 16); }
__device__ __forceinline__ float fast_exp(float x) { return __builtin_amdgcn_exp2f(x * 1.4426950408889634f); }
__device__ __forceinline__ float sigmoidf_(float x) { return __builtin_amdgcn_rcpf(1.0f + fast_exp(-x)); }
__device__ __forceinline__ float siluf_(float x) { return x * sigmoidf_(x); }
template <int M> __device__ __forceinline__ float lane_xor(float v) { return __builtin_bit_cast(float, __builtin_amdgcn_ds_swizzle(__builtin_bit_cast(int, v), (M << 10) | 0x1f)); }
__device__ __forceinline__ float sum_xor32(float v) { const unsigned u = __builtin_bit_cast(unsigned, v); auto rr = __builtin_amdgcn_permlane32_swap(u, u, false, false);
    return __builtin_bit_cast(float, (unsigned)rr[0]) + __builtin_bit_cast(float, (unsigned)rr[1]); }
__device__ __forceinline__ float sum32(float v) { v += lane_xor<1>(v); v += lane_xor<2>(v); v += lane_xor<4>(v); v += lane_xor<8>(v); v += lane_xor<16>(v); return v; }
__device__ __forceinline__ float wave_sum(float v) { return sum_xor32(sum32(v)); }
__device__ __forceinline__ void st_bf16x8(bf16_t* p, const float (&v)[8]) {
    u32x4 w; w.x = pk2(v[0], v[1]); w.y = pk2(v[2], v[3]); w.z = pk2(v[4], v[5]); w.w = pk2(v[6], v[7]); *(u32x4*)p = w;
}
__device__ __forceinline__ void st_f32x8(float* p, const float (&v)[8]) {
    *(f32x4*)p = (f32x4){v[0], v[1], v[2], v[3]}; *(f32x4*)(p + 4) = (f32x4){v[4], v[5], v[6], v[7]};
}

struct SchedIn {
    int G, c;
    __device__ bool next(int i, pg8::Unit& u) const {
        const long L = (long)i * G + c; constexpr int nM = NTOK / 256, nN = 12, nwg = nM * nN;
        if (L >= nwg + 16) return false;
        if (L >= nwg) { const int r = (int)L - nwg; u.pm = nM + (r >> 1); u.pn = 12 + (r & 1); return true; }
        int wgid = (int)L; { const int q = nwg / 8, xcd = wgid % 8, off = wgid / 8; wgid = xcd * q + off; }
        const int nig = 8 * nN, gid = wgid / nig, fm = gid * 8, gsz = (nM - fm) < 8 ? (nM - fm) : 8;
        u.pm = fm + ((wgid % nig) % gsz); u.pn = (wgid % nig) / gsz; return true;
    }
    __device__ __forceinline__ void a_ready(const pg8::Unit&) const {}
    __device__ __forceinline__ void done(const pg8::Unit&) const {}
};
struct SchedOut {
    int G, c;
    __device__ bool next(int i, pg8::Unit& u) const {
        const long L = (long)i * G + c; constexpr int nM = NTOK / 256, nN = 4, nwg = nM * nN;
        if (L >= nwg) return false;
        int wgid = (int)L; { const int q = nwg / 8, xcd = wgid % 8, off = wgid / 8; wgid = xcd * q + off; }
        const int nig = 8 * nN, gid = wgid / nig, fm = gid * 8, gsz = (nM - fm) < 8 ? (nM - fm) : 8;
        u.pm = fm + ((wgid % nig) % gsz); u.pn = (wgid % nig) / gsz; return true;
    }
    __device__ __forceinline__ void a_ready(const pg8::Unit&) const {}
    __device__ __forceinline__ void done(const pg8::Unit&) const {}
};

struct EpiIn {
    static constexpr bool PERM = true, AFTER_DRAIN = false;
    unsigned char* ws; float* out;
    const float *gq, *gk, *gmq, *gmk;
    __device__ __forceinline__ void operator()(const f32x4 (&acc)[2][2][4][2], const pg8::Unit& u, int wr, int wc, int fr, int fq) const {
        bf16_t* const Qb = (bf16_t*)(ws + WS_QB); bf16_t* const Kb = (bf16_t*)(ws + WS_KB); bf16_t* const Vb = (bf16_t*)(ws + WS_VB); bf16_t* const KS = (bf16_t*)(ws + WS_KS); bf16_t* const VS = (bf16_t*)(ws + WS_VS);
        bf16_t* const MIX = (bf16_t*)(ws + WS_MIX); bf16_t* const MQ = (bf16_t*)(ws + WS_MQ); bf16_t* const MKA = (bf16_t*)(ws + WS_MKA); bf16_t* const MVA = (bf16_t*)(ws + WS_MVA);
        float* const LX = (float*)(ws + WS_LX); const f32x2v* const rope = (const f32x2v*)(ws + WS_ROPE);
        const int pn = u.pn;
        const int cl0 = 64 * wc + 8 * fq;
        const int rb = u.pm * 256 + wr * 64 + fr;
        const float* g = nullptr;
        if (pn < 2) g = gq; else if (pn < 4) g = gk; else if (pn == 10) g = gmq; else if (pn == 12) g = gmk;
        float gv[2][8];
#pragma unroll
        for (int bj = 0; bj < 2; ++bj)
#pragma unroll
            for (int k = 0; k < 8; ++k) gv[bj][k] = g ? g[32 * bj + 8 * fq + k] : 1.f;
#pragma unroll
        for (int ai = 0; ai < 2; ++ai)
#pragma unroll
            for (int m = 0; m < 4; ++m) {
                const int row = rb + ai * 128 + m * 16;
                float v[2][8];
#pragma unroll
                for (int bj = 0; bj < 2; ++bj)
#pragma unroll
                    for (int n = 0; n < 2; ++n)
#pragma unroll
                        for (int e = 0; e < 4; ++e) v[bj][4 * n + e] = acc[ai][bj][m][n][e];
                if (g) {
                    float ss = 0.f;
#pragma unroll
                    for (int bj = 0; bj < 2; ++bj)
#pragma unroll
                        for (int k = 0; k < 8; ++k) ss += v[bj][k] * v[bj][k];
                    ss += lane_xor<16>(ss); ss = sum_xor32(ss);
                    const float rs = __builtin_amdgcn_rsqf(ss * (1.0f / 64.0f) + EPSN);
#pragma unroll
                    for (int bj = 0; bj < 2; ++bj)
#pragma unroll
                        for (int k = 0; k < 8; ++k) v[bj][k] *= rs * gv[bj][k];
                    if (pn < 4) {
                        const int pos = row < NTOK_P ? (row & (SEQ - 1)) : (PAST + (row & 31));
                        float pv[8];
#pragma unroll
                        for (int k = 0; k < 8; ++k) pv[k] = lane_xor<16>(v[0][k]);
                        if (fq < 2) {
                            const f32x2v* cs = rope + (size_t)pos * 8;
#pragma unroll
                            for (int k = 0; k < 8; ++k) { const f32x2v t = cs[k]; v[0][k] = fq == 0 ? (v[0][k] * t.x - pv[k] * t.y) : (v[0][k] * t.x + pv[k] * t.y); }
                        }
                    }
                }
                if (pn < 2) {
#pragma unroll
                    for (int bj = 0; bj < 2; ++bj) { float o[8];
#pragma unroll
                        for (int k = 0; k < 8; ++k) o[k] = v[bj][k] * C2;
                        st_bf16x8(Qb + (size_t)row * 512 + 256 * pn + cl0 + 32 * bj, o); }
                } else if (pn < 6) {
                    const bool isk = pn < 4; const int col = 256 * (pn - (isk ? 2 : 4)) + cl0;
                    float* of; bf16_t* ob;
                    if (row < NTOK_P) { of = out + (isk ? O_KP : O_VP) + (size_t)row * 512 + col; ob = (isk ? Kb : Vb) + (size_t)row * 512 + col; }
                    else { const int rs_ = row - NTOK_P; of = out + (isk ? O_KS : O_VS) + (size_t)rs_ * 512 + col;
                           ob = (isk ? KS : VS) + ((size_t)(rs_ >> 5) * KSROWS + PAST + (rs_ & 31)) * 512 + col; }
#pragma unroll
                    for (int bj = 0; bj < 2; ++bj) { st_f32x8(of + 32 * bj, v[bj]); st_bf16x8(ob + 32 * bj, v[bj]); }
                } else if (pn == 8) {
#pragma unroll
                    for (int bj = 0; bj < 2; ++bj) st_f32x8(LX + (size_t)row * 256 + cl0 + 32 * bj, v[bj]);
                } else if (pn == 10) {
#pragma unroll
                    for (int bj = 0; bj < 2; ++bj) { float o[8];
#pragma unroll
                        for (int k = 0; k < 8; ++k) o[k] = v[bj][k] * C2;
                        st_bf16x8(MQ + (size_t)row * 256 + cl0 + 32 * bj, o); }
                } else if (pn >= 12) {
                    const int rm = row - NTOK;
#pragma unroll
                    for (int bj = 0; bj < 2; ++bj) { st_f32x8(out + (pn == 12 ? O_MK : O_MV) + (size_t)rm * 256 + cl0 + 32 * bj, v[bj]);
                        st_bf16x8((pn == 12 ? MKA : MVA) + (size_t)rm * 256 + cl0 + 32 * bj, v[bj]); }
                } else {
                    const int colb = pn == 6 ? 0 : pn == 7 ? 256 : pn == 9 ? 512 : 768;
#pragma unroll
                    for (int bj = 0; bj < 2; ++bj) { float o[8];
#pragma unroll
                        for (int k = 0; k < 8; ++k) o[k] = siluf_(v[bj][k]);
                        st_bf16x8(MIX + (size_t)row * 1024 + colb + cl0 + 32 * bj, o); }
                }
            }
    }
};
struct EpiOut {
    static constexpr bool PERM = true, AFTER_DRAIN = false;
    const float *xp, *xs; float* out;
    __device__ __forceinline__ void operator()(const f32x4 (&acc)[2][2][4][2], const pg8::Unit& u, int wr, int wc, int fr, int fq) const {
        const int col0 = 256 * u.pn + 64 * wc + 8 * fq, rb = u.pm * 256 + wr * 64 + fr;
#pragma unroll
        for (int ai = 0; ai < 2; ++ai)
#pragma unroll
            for (int m = 0; m < 4; ++m) {
                const int row = rb + ai * 128 + m * 16;
                const float* xr = (row < NTOK_P ? xp + (size_t)row * 1024 : xs + (size_t)(row - NTOK_P) * 1024) + col0;
                float* yr = out + (size_t)row * 1024 + col0;
#pragma unroll
                for (int bj = 0; bj < 2; ++bj)
#pragma unroll
                    for (int n = 0; n < 2; ++n) { const f32x4 xv = *(const f32x4*)(xr + 32 * bj + 4 * n); *(f32x4*)(yr + 32 * bj + 4 * n) = xv + acc[ai][bj][m][n]; }
            }
    }
};

namespace att {
typedef short bf16x8 __attribute__((ext_vector_type(8)));
typedef short s16x4 __attribute__((ext_vector_type(4)));
typedef float f32x16 __attribute__((ext_vector_type(16)));
typedef float f32x2_t __attribute__((ext_vector_type(2)));
typedef __bf16 bf16x2_t __attribute__((ext_vector_type(2)));
__device__ __forceinline__ unsigned cvtpk(float lo, float hi) { f32x2_t v = {lo, hi}; bf16x2_t b = __builtin_convertvector(v, bf16x2_t); return __builtin_bit_cast(unsigned, b); }
__device__ __forceinline__ void glds16(const void* gsrc, unsigned lds_dst) { unsigned keep;
    asm volatile("s_mov_b32 %0, m0\n\ts_mov_b32 m0, %2\n\ts_nop 0\n\tglobal_load_lds_dwordx4 %1, off\n\ts_mov_b32 m0, %0" : "=&s"(keep) : "v"(gsrc), "s"(lds_dst) : "memory"); }
#define ATT_WAIT_BAR() asm volatile("s_waitcnt vmcnt(0) lgkmcnt(0)\n\ts_barrier" ::: "memory")
#define ATT_LBAR() asm volatile("s_waitcnt lgkmcnt(0)\n\ts_barrier" ::: "memory")
__device__ __forceinline__ s16x4 vtr(LAS const unsigned char* p) { typedef short v4i16_t __attribute__((ext_vector_type(4)));
    return __builtin_bit_cast(s16x4, __builtin_amdgcn_ds_read_tr16_b64_v4i16((LAS v4i16_t*)p)); }
__device__ __forceinline__ int crow(int r, int hh) { return (r & 3) + 8 * (r >> 2) + 4 * hh; }

template <int NC, int DV>
__device__ __forceinline__ void attn_loop(unsigned char* ldsg, const bf16_t* Qrow, const unsigned char* Kg, const unsigned char* Vg, int kvstride, int NT, int last_nh, int mode, int wpar, int c,
                                          f32x16 (&O)[DV / 32], float& l) {
    constexpr int KROW = NC * 128, VROW = DV * 2, KT = 64 * KROW, VT = 64 * VROW, BUF = KT + VT, KPW = KT / 8192, VPW = VT / 8192;
    const int tid = threadIdx.x, lane = tid & 63, r32 = lane & 31, hh = lane >> 5; const int w = __builtin_amdgcn_readfirstlane(tid >> 6);
    LAS const unsigned char* lds3 = (LAS const unsigned char*)ldsg; const unsigned lds0 = (unsigned)(uintptr_t)ldsg;
    unsigned ksrc[KPW], vsrc[VPW];
#pragma unroll
    for (int i = 0; i < KPW; ++i) { const int pos = 64 * (KPW * w + i) + lane; constexpr int CPR = KROW / 16; const int row = pos / CPR, cp = pos % CPR;
        const int cc = cp ^ (KROW == 256 ? (row & 15) : ((row >> 1) & 7)); ksrc[i] = (unsigned)(row * kvstride + cc * 16); }
#pragma unroll
    for (int i = 0; i < VPW; ++i) { const int pos = 64 * (VPW * w + i) + lane; constexpr int CPR = VROW / 16; const int row = pos / CPR, cp = pos % CPR;
        const int cc = cp ^ (VROW == 256 ? 4 * (row & 3) : 4 * ((row >> 1) & 1)); vsrc[i] = (unsigned)(row * kvstride + cc * 16); }
#define ATT_ISSUE(j) do { const size_t tb_ = (size_t)(j) * 64 * (size_t)kvstride; const unsigned sb_ = lds0 + ((j) & 1) * BUF; \
        _Pragma("unroll") for (int i_ = 0; i_ < KPW; ++i_) glds16(Kg + tb_ + ksrc[i_], (unsigned)__builtin_amdgcn_readfirstlane(sb_ + 1024 * (KPW * w + i_))); \
        _Pragma("unroll") for (int i_ = 0; i_ < VPW; ++i_) glds16(Vg + tb_ + vsrc[i_], (unsigned)__builtin_amdgcn_readfirstlane(sb_ + KT + 1024 * (VPW * w + i_))); } while (0)
    ATT_ISSUE(0);
    bf16x8 q[4];
#pragma unroll
    for (int ks = 0; ks < 4; ++ks) q[ks] = *(const bf16x8*)(Qrow + c * 64 + ks * 16 + hh * 8);
    const int kx = KROW == 256 ? (r32 & 15) : ((r32 >> 1) & 7);
    const int kb = r32 * KROW + ((hh ^ (kx & 1)) << 4), kxh = (kx & ~1) << 4, cb = c << 7;
    const int L = lane & 15, gp = (lane >> 4) & 1, sw = VROW == 256 ? ((L >> 2) & 3) : ((L >> 3) & 1);
    int vo[DV / 32];
#pragma unroll
    for (int db = 0; db < DV / 32; ++db) vo[db] = (4 * hh + (L >> 2)) * VROW + ((((db ^ sw) << 2) + 2 * gp + ((L & 3) >> 1)) << 4) + 8 * (L & 1);
    ATT_WAIT_BAR();
#pragma nounroll
    for (int j = 0; j < NT; ++j) {
        if (j + 1 < NT) ATT_ISSUE(j + 1);
        const bool active = mode == 0 ? (j <= wpar) : mode == 1 ? ((j & 3) == wpar) : ((j >> 1) == wpar);
        if (active) {
            const int nh = (j == NT - 1) ? last_nh : 2;
            LAS const unsigned char* Kt = lds3 + (j & 1) * BUF; LAS const unsigned char* Vt = Kt + KT;
#pragma unroll
            for (int kh = 0; kh < 2; ++kh) {
                if (kh < nh) {
                    f32x16 X = {};
#pragma unroll
                    for (int ks = 0; ks < 4; ++ks) {
                        const int co = kb + ((cb + (ks << 5)) ^ kxh) + kh * 32 * KROW;
                        const bf16x8 a0 = *(LAS const bf16x8*)(Kt + co);
                        X = __builtin_amdgcn_mfma_f32_32x32x16_bf16(a0, q[ks], X, 0, 0, 0);
                    }
                    float s = 0.f; u32x4 pk[2];
#pragma unroll
                    for (int r = 0; r < 16; ++r) { X[r] = __builtin_amdgcn_exp2f(X[r]); s += X[r]; }
#pragma unroll
                    for (int s2 = 0; s2 < 2; ++s2) pk[s2] = (u32x4){cvtpk(X[8 * s2], X[8 * s2 + 1]), cvtpk(X[8 * s2 + 2], X[8 * s2 + 3]), cvtpk(X[8 * s2 + 4], X[8 * s2 + 5]), cvtpk(X[8 * s2 + 6], X[8 * s2 + 7])};
                    l += s;
#pragma unroll
                    for (int s2 = 0; s2 < 2; ++s2) {
                        const bf16x8 pa = __builtin_bit_cast(bf16x8, pk[s2]);
#pragma unroll
                        for (int db = 0; db < DV / 32; ++db) {
                            const s16x4 lo = vtr(Vt + vo[db] + (32 * kh + 16 * s2) * VROW), hi = vtr(Vt + vo[db] + (32 * kh + 16 * s2 + 8) * VROW);
                            const bf16x8 vb = (bf16x8){lo[0], lo[1], lo[2], lo[3], hi[0], hi[1], hi[2], hi[3]};
                            O[db] = __builtin_amdgcn_mfma_f32_32x32x16_bf16(pa, vb, O[db], 0, 0, 0);
                        }
                    }
                }
            }
        }
        ATT_WAIT_BAR();
    }
#undef ATT_ISSUE
}

template <int NDB>
__device__ __forceinline__ void tree_reduce4(f32x16 (&O)[NDB], float& l, LAS float* red, int w, int lane) {
    constexpr int SLOTF = (NDB * 16 + 1) * 64; const int grp = w >> 2, idx = w & 3;
#pragma unroll
    for (int step = 2; step >= 1; step >>= 1) {
        if (idx >= step && idx < 2 * step) { LAS float* s = red + (grp * 2 + idx - step) * SLOTF + lane;
#pragma unroll
            for (int db = 0; db < NDB; ++db) {
#pragma unroll
                for (int r = 0; r < 16; ++r) s[64 * (db * 16 + r)] = O[db][r];
                asm volatile("" ::: "memory"); }
            s[64 * NDB * 16] = l; }
        ATT_LBAR();
        if (idx < step) { LAS const float* s = red + (grp * 2 + idx) * SLOTF + lane;
#pragma unroll
            for (int db = 0; db < NDB; ++db) {
#pragma unroll
                for (int r = 0; r < 16; ++r) O[db][r] += s[64 * (db * 16 + r)];
                asm volatile("s_waitcnt lgkmcnt(0)" ::: "memory"); }
            l += s[64 * NDB * 16]; }
        ATT_LBAR();
    }
}
__device__ __forceinline__ void diff_finish(f32x16 (&O)[4], float l, int c, bool doit, float lam, LAS float* wsf, LAS float* xs, int tok0, int h, const float* gsub, bf16_t* MIX) {
    int lane = threadIdx.x & 63; asm volatile("" : "+v"(lane), "+v"(tok0));
    const int r32 = lane & 31, hh = lane >> 5;
    const float ls = sum_xor32(l);
    if (hh == 0) wsf[r32] = (c == 0 ? 1.0f : lam) / ls;
    asm volatile("s_waitcnt lgkmcnt(0)" ::: "memory");
    if (doit && c == 1) {
#pragma unroll
        for (int r = 0; r < 16; ++r) { const float a = wsf[crow(r, hh)];
#pragma unroll
            for (int db = 0; db < 4; ++db) xs[64 * (db * 16 + r) + lane] = O[db][r] * a; }
    }
    ATT_LBAR();
    if (doit && c == 0) {
        float gs[4];
#pragma unroll
        for (int db = 0; db < 4; ++db) gs[db] = gsub[32 * db + r32] * ONE_M_LINIT;
#pragma unroll
        for (int r = 0; r < 16; ++r) {
            const int qr = crow(r, hh); const float a = wsf[qr];
            float o[4], ss = 0.f;
#pragma unroll
            for (int db = 0; db < 4; ++db) { o[db] = O[db][r] * a - xs[64 * (db * 16 + r) + lane]; ss += o[db] * o[db]; }
            ss = sum32(ss);
            const float rs = __builtin_amdgcn_rsqf(ss * (1.0f / 128.0f) + EPSN);
            bf16_t* p = MIX + (size_t)(tok0 + qr) * 1024 + h * 128 + r32;
#pragma unroll
            for (int db = 0; db < 4; ++db) { const float gate = bf2f(p[32 * db]); p[32 * db] = (bf16_t)f2bf(o[db] * rs * gs[db] * gate); }
            asm volatile("" ::: "memory");
        }
    }
    ATT_LBAR();
}
__device__ __forceinline__ void mem_finish(f32x16 (&O)[2], float l, int part, bool doit, bool pair, LAS float* wsf, LAS float* xs, int tok0, int h, bf16_t* MIX) {
    int lane = threadIdx.x & 63; asm volatile("" : "+v"(lane), "+v"(tok0));
    const int r32 = lane & 31, hh = lane >> 5;
    const float ls = sum_xor32(l);
    if (doit && part == 1) {
#pragma unroll
        for (int db = 0; db < 2; ++db)
#pragma unroll
            for (int r = 0; r < 16; ++r) xs[64 * (db * 16 + r) + lane] = O[db][r];
        xs[64 * 32 + lane] = ls;
    }
    ATT_LBAR();
    if (doit && part == 0) {
        const float lt = ls + (pair ? xs[64 * 32 + lane] : 0.f);
        if (hh == 0) wsf[r32] = 1.0f / lt;
        asm volatile("s_waitcnt lgkmcnt(0)" ::: "memory");
#pragma unroll
        for (int r = 0; r < 16; ++r) {
            const int qr = crow(r, hh); const float a = wsf[qr];
            bf16_t* p = MIX + (size_t)(tok0 + qr) * 1024 + 768 + h * 64 + r32;
#pragma unroll
            for (int db = 0; db < 2; ++db) { const float gate = bf2f(p[32 * db]); p[32 * db] = (bf16_t)f2bf((O[db][r] + (pair ? xs[64 * (db * 16 + r) + lane] : 0.f)) * a * gate); }
            asm volatile("" ::: "memory");
        }
    }
    ATT_LBAR();
}
}

struct Args { const float* in[30]; float* out; unsigned char* ws; double rope_r0; double inv2pi; int ph_lo, ph_hi; };
enum { I_XP = 0, I_XS, I_MEM, I_CDK, I_CDV, I_CMK, I_CMV, I_SCONV, I_SH, I_NORMG, I_WIN, I_GQ, I_GK, I_LQ1, I_LK1, I_LQ2, I_LK2, I_GSUB, I_CONVW, I_CONVB, I_WA, I_BA, I_WX, I_BX,
       I_LAMBDA, I_MEMNG, I_WMEM, I_GMQ, I_GMK, I_WOUT };

__device__ __forceinline__ void p0_transpose_item(const float* W, int N, bf16_t* WT, int row_off, LAS float* scr, int item, int lane) {
    const int nblk = N / 32, kb = item / nblk, nb = item % nblk, k0 = 64 * kb, n0 = 32 * nb;
#pragma unroll 8
    for (int i = 0; i < 32; ++i) { const int kk = 2 * i + (lane >> 5); scr[kk * 33 + (lane & 31)] = W[(size_t)(k0 + kk) * N + n0 + (lane & 31)]; }
    asm volatile("s_waitcnt lgkmcnt(0)" ::: "memory");
    const int cl = n0 & 255, p0 = (n0 & ~255) + 128 * ((cl >> 5) & 1) + 32 * (cl >> 6);
    const int c = lane & 7;
#pragma unroll
    for (int j = 0; j < 4; ++j) { const int n = (lane >> 3) + 8 * j; const LAS float* s = scr + (8 * c) * 33 + n;
        u32x4 o; o.x = pk2(s[0 * 33], s[1 * 33]); o.y = pk2(s[2 * 33], s[3 * 33]); o.z = pk2(s[4 * 33], s[5 * 33]); o.w = pk2(s[6 * 33], s[7 * 33]);
        *(u32x4*)(WT + (size_t)(row_off + p0 + n) * 1024 + k0 + 8 * c) = o; }
    asm volatile("s_waitcnt lgkmcnt(0)" ::: "memory");
}
__device__ __forceinline__ void rms_row_to_bf16(const float* xrow, const float* g, bf16_t* orow, int lane) {
    const f32x4* xr = (const f32x4*)xrow + lane; const f32x4* gr = (const f32x4*)g + lane;
    f32x4 v[4]; float s = 0.f;
#pragma unroll
    for (int j = 0; j < 4; ++j) { v[j] = xr[64 * j]; s += (v[j].x * v[j].x + v[j].y * v[j].y) + (v[j].z * v[j].z + v[j].w * v[j].w); }
    const float rs = __builtin_amdgcn_rsqf(wave_sum(s) * (1.f / 1024.f) + EPSN);
    unsigned long long* o8 = (unsigned long long*)orow + lane;
#pragma unroll
    for (int j = 0; j < 4; ++j) { const f32x4 gg = gr[64 * j]; const f32x4 t = v[j] * gg * rs;
        o8[64 * j] = (unsigned long long)pk2(t.x, t.y) | ((unsigned long long)pk2(t.z, t.w) << 32); }
}

__global__ void __launch_bounds__(512, 2) fwd_kernel(Args args) {
    extern __shared__ __attribute__((aligned(16))) unsigned char lds[];
    const int tid = threadIdx.x, lane = tid & 63; const int wave = __builtin_amdgcn_readfirstlane(tid >> 6);
    const int G = gridDim.x, bx = blockIdx.x;
    const int vcu = (G % 8 == 0) ? (bx % 8) * (G / 8) + bx / 8 : bx;
    unsigned char* ws = args.ws; float* out = args.out;
    const int lo = args.ph_lo, hi = args.ph_hi;
#define IN(k) (lo <= (k) && (k) < hi)
#define GRID_SYNC(k) do { if (IN(k) && IN((k) + 1)) { cg::this_grid().sync(); } } while (0)

    if (IN(0)) {
        bf16_t* const WIN = (bf16_t*)(ws + WS_WIN); bf16_t* const WOUT = (bf16_t*)(ws + WS_WOUT); f32x2v* const ROPE = (f32x2v*)(ws + WS_ROPE); bf16_t* const AALL = (bf16_t*)(ws + WS_AALL); bf16_t* const KS = (bf16_t*)(ws + WS_KS); bf16_t* const VS = (bf16_t*)(ws + WS_VS); bf16_t* const MKA = (bf16_t*)(ws + WS_MKA); bf16_t* const MVA = (bf16_t*)(ws + WS_MVA);
#ifndef SKIP_P0
        LAS float* scr = (LAS float*)((LAS unsigned char*)lds + wave * 16384);
        const int gw = vcu * 8 + wave, NGW = G * 8;
        constexpr int I_IN = 16 * 96, I_MEMW = 16 * 16, I_OUTW = 16 * 32;
        for (int it = gw; it < I_IN + I_MEMW + I_OUTW; it += NGW) {
            int r = it;
            if (r < I_IN) { p0_transpose_item(args.in[I_WIN], 3072, WIN, 0, scr, r, lane); continue; } r -= I_IN;
            if (r < I_MEMW) { p0_transpose_item(args.in[I_WMEM], 512, WIN, 3072, scr, r, lane); continue; } r -= I_MEMW;
            p0_transpose_item(args.in[I_WOUT], 1024, WOUT, 0, scr, r, lane);
        }
        for (int m = gw; m < AROWS; m += NGW) {
            const float* src = m < NTOK_P ? args.in[I_XP] + (size_t)m * 1024 : m < NTOK ? args.in[I_XS] + (size_t)(m - NTOK_P) * 1024 : args.in[I_MEM] + (size_t)(m - NTOK) * 1024;
            rms_row_to_bf16(src, m < NTOK ? args.in[I_NORMG] : args.in[I_MEMNG], AALL + (size_t)m * 1024, lane);
        }
        for (int m = gw; m < 2 * SBAT * PAST; m += NGW) {
            const int which = m >= SBAT * PAST, r = which ? m - SBAT * PAST : m, b = r >> 10, t = r & 1023;
            const f32x4* s = (const f32x4*)(args.in[which ? I_CDV : I_CDK] + (size_t)r * 512) + 2 * lane; const f32x4 a = s[0], c = s[1];
            u32x4 o; o.x = pk2(a.x, a.y); o.y = pk2(a.z, a.w); o.z = pk2(c.x, c.y); o.w = pk2(c.z, c.w);
            *((u32x4*)((which ? VS : KS) + ((size_t)b * KSROWS + t) * 512) + lane) = o;
        }
        for (int m = gw; m < 2 * SBAT * 256; m += NGW) {
            const int which = m >= SBAT * 256, r = which ? m - SBAT * 256 : m;
            const f32x4 a = *((const f32x4*)(args.in[which ? I_CMV : I_CMK] + (size_t)r * 256) + lane);
            u32x2 o; o.x = pk2(a.x, a.y); o.y = pk2(a.z, a.w);
            *((u32x2*)((which ? MVA : MKA) + (size_t)(NMEMROW + r) * 256) + lane) = o;
        }
        for (int idx = (vcu * 512 + tid); idx < SEQ * 8; idx += G * 512) {
            const int pos = idx >> 3, i = idx & 7; double f = args.inv2pi;
            for (int k = 0; k < i; ++k) f *= args.rope_r0;
            double rev = (double)pos * f; rev -= __builtin_rint(rev);
            const float fr = (float)rev; ROPE[idx] = (f32x2v){__builtin_amdgcn_cosf(fr), __builtin_amdgcn_sinf(fr)};
        }
#endif
        asm volatile("s_waitcnt vmcnt(0) lgkmcnt(0)" ::: "memory"); __syncthreads();
    }
    GRID_SYNC(0);

    if (IN(1)) {
        bf16_t* const WIN = (bf16_t*)(ws + WS_WIN); bf16_t* const AALL = (bf16_t*)(ws + WS_AALL);
#ifndef SKIP_P1
        pg8::Gemm g{AALL, WIN, AROWS, 3584, 1024}; SchedIn S{G, bx};
        EpiIn E{ws, out, args.in[I_GQ], args.in[I_GK], args.in[I_GMQ], args.in[I_GMK]};
        pg8::gemm_phase<EpiIn, SchedIn, true, true>((LAS unsigned char*)lds, g, S, E);
#endif
        asm volatile("s_waitcnt vmcnt(0) lgkmcnt(0)" ::: "memory"); __syncthreads();
    }
    GRID_SYNC(1);

    if (IN(2)) {
        bf16_t* const QB = (bf16_t*)(ws + WS_QB); bf16_t* const KB = (bf16_t*)(ws + WS_KB); bf16_t* const VB = (bf16_t*)(ws + WS_VB); bf16_t* const KS = (bf16_t*)(ws + WS_KS); bf16_t* const VS = (bf16_t*)(ws + WS_VS); bf16_t* const MIX = (bf16_t*)(ws + WS_MIX); float* const LX = (float*)(ws + WS_LX); bf16_t* const MQ = (bf16_t*)(ws + WS_MQ); bf16_t* const MKA = (bf16_t*)(ws + WS_MKA); bf16_t* const MVA = (bf16_t*)(ws + WS_MVA); float* const HL = (float*)(ws + WS_HL); float* const AC = (float*)(ws + WS_AC); float* const SEGA = (float*)(ws + WS_SEGA); float* const SEGH = (float*)(ws + WS_SEGH);
        LAS float* wsf = (LAS float*)((LAS unsigned char*)lds + LDS_WSF) + wave * 64;
        float lam;
        { const float d1 = wave_sum(args.in[I_LQ1][lane] * args.in[I_LK1][lane]), d2 = wave_sum(args.in[I_LQ2][lane] * args.in[I_LK2][lane]); lam = expf(d1) - expf(d2) + LAMBDA_INIT; }
        const int r32 = lane & 31;
#ifndef SKIP_P2A
        const int qg = wave & 3, cw = wave >> 2;
        LAS float* xs = (LAS float*)lds + qg * 4160;
        for (int vv = vcu; vv < 256; vv += G) {
            const int bh = vv >> 3, s = vv & 7, b = bh >> 2, h = bh & 3;
#pragma nounroll
            for (int i = 0; i < 8; ++i) {
                const int qb = 16 * (i >> 1) + ((i & 1) ? 15 - s : s);
                const int tok0 = b * SEQ + qb * 128 + qg * 32;
                {   att::f32x16 O[4]; float l = 0.f;
#pragma unroll
                    for (int db = 0; db < 4; ++db) O[db] = att::f32x16{};
                    att::attn_loop<2, 128>(lds, QB + (size_t)(tok0 + r32) * 512 + h * 128, (const unsigned char*)(KB + (size_t)b * SEQ * 512 + h * 128), (const unsigned char*)(VB + (size_t)b * SEQ * 512 + h * 128),
                                           1024, 2 * qb + 2, 2, 0, 2 * qb + (qg >> 1), cw, O, l);
                    att::diff_finish(O, l, cw, true, lam, wsf, xs, tok0, h, args.in[I_GSUB], MIX); }
                {   att::f32x16 O[2]; float l = 0.f; O[0] = att::f32x16{}; O[1] = att::f32x16{};
                    att::attn_loop<1, 64>(lds, MQ + (size_t)(tok0 + r32) * 256 + h * 64, (const unsigned char*)(MKA + (size_t)b * 256 * 256 + h * 64), (const unsigned char*)(MVA + (size_t)b * 256 * 256 + h * 64),
                                          512, 4, 2, 2, cw, 0, O, l);
                    att::mem_finish(O, l, cw, true, true, wsf, xs, tok0, h, MIX); }
            }
        }
        for (int uu = vcu; uu < 128; uu += G) {
            const int b = uu >> 2, h = uu & 3, tok0 = NTOK_P + b * 32;
            {   att::f32x16 O[4]; float l = 0.f;
#pragma unroll
                for (int db = 0; db < 4; ++db) O[db] = att::f32x16{};
                att::attn_loop<2, 128>(lds, QB + (size_t)(tok0 + r32) * 512 + h * 128, (const unsigned char*)(KS + (size_t)b * KSROWS * 512 + h * 128), (const unsigned char*)(VS + (size_t)b * KSROWS * 512 + h * 128),
                                       1024, 17, 1, 1, qg, cw, O, l);
                att::tree_reduce4<4>(O, l, (LAS float*)lds, wave, lane);
                att::diff_finish(O, l, cw, qg == 0, lam, wsf, (LAS float*)lds, tok0, h, args.in[I_GSUB], MIX); }
            {   att::f32x16 O[2]; float l = 0.f; O[0] = att::f32x16{}; O[1] = att::f32x16{};
                att::attn_loop<1, 64>(lds, MQ + (size_t)(tok0 + r32) * 256 + h * 64, (const unsigned char*)(MKA + (size_t)(NB + b) * 256 * 256 + h * 64), (const unsigned char*)(MVA + (size_t)(NB + b) * 256 * 256 + h * 64),
                                      512, 4, 2, 1, cw == 0 ? qg : 7, 0, O, l);
                att::tree_reduce4<2>(O, l, (LAS float*)lds, wave, lane);
                att::mem_finish(O, l, 0, wave == 0, false, wsf, (LAS float*)lds, tok0, h, MIX); }
        }
#endif
#ifndef SKIP_P2L
        for (int uu = (G - 1 - vcu); uu < 640; uu += G) {
            const bool smp = uu >= 512; int b, n, row0, ntok, seg0;
            if (!smp) { b = uu >> 6; n = (uu >> 4) & 3; const int c = uu & 15; row0 = b * SEQ + c * 512; ntok = 512; seg0 = 8 * c; }
            else { const int r = uu - 512; b = r >> 2; n = r & 3; row0 = NTOK_P + b * 32; ntok = 32; seg0 = 0; }
            const int t0 = wave * 64, ch = n * 64 + lane;
            if (t0 < ntok) {
                const int ntw = (ntok - t0) < 64 ? (ntok - t0) : 64;
                const float* cw = args.in[I_CONVW]; const float cw0 = cw[ch], cw1 = cw[256 + ch], cw2 = cw[512 + ch], cw3 = cw[768 + ch], cb = args.in[I_CONVB][ch];
                float xm3, xm2, xm1;
                if (seg0 + wave > 0) { const float* p = LX + (size_t)(row0 + t0) * 256 + ch; xm3 = p[-3 * 256]; xm2 = p[-2 * 256]; xm1 = p[-256]; }
                else if (smp) { const float* p = args.in[I_SCONV] + (size_t)b * 3 * 256 + ch; xm3 = p[0]; xm2 = p[256]; xm1 = p[512]; }
                else { xm3 = 0.f; xm2 = 0.f; xm1 = 0.f; }
                LAS float* xc = (LAS float*)lds + wave * 4096;
                for (int t = 0; t < ntw; ++t) { const float x = LX[(size_t)(row0 + t0 + t) * 256 + ch]; xc[t * 64 + lane] = cb + cw0 * xm3 + cw1 * xm2 + cw2 * xm1 + cw3 * x; xm3 = xm2; xm2 = xm1; xm1 = x; }
                asm volatile("s_waitcnt lgkmcnt(0)" ::: "memory");
                float wa[64], wx[64];
                { const float* pa = args.in[I_WA] + (size_t)n * 4096 + lane; const float* px = args.in[I_WX] + (size_t)n * 4096 + lane;
#pragma unroll
                  for (int i = 0; i < 64; ++i) { wa[i] = pa[i * 64]; wx[i] = px[i * 64]; } }
                const float ba = args.in[I_BA][ch], bxx = args.in[I_BX][ch];
                const float sp = log1pf(expf(-args.in[I_LAMBDA][ch]));
                float hcur = smp ? args.in[I_SH][(size_t)b * 256 + ch] : 0.f, acur = 1.f;
                for (int t = 0; t < ntw; ++t) {
                    float ga = ba, gx = bxx;
#pragma unroll
                    for (int i4 = 0; i4 < 16; ++i4) { const f32x4 xv = *(LAS const f32x4*)(xc + t * 64 + 4 * i4);
                        ga += xv.x * wa[4 * i4] + xv.y * wa[4 * i4 + 1] + xv.z * wa[4 * i4 + 2] + xv.w * wa[4 * i4 + 3];
                        gx += xv.x * wx[4 * i4] + xv.y * wx[4 * i4 + 1] + xv.z * wx[4 * i4 + 2] + xv.w * wx[4 * i4 + 3]; }
                    const float xcj = xc[t * 64 + lane];
                    const float rg = sigmoidf_(ga), ig = sigmoidf_(gx);
                    const float la = -8.0f * rg * sp, a = expf(la), bb = sqrtf(-expm1f(2.0f * la)) * (ig * xcj);
                    hcur = a * hcur + bb; acur *= a;
                    const size_t row = (size_t)(row0 + t0 + t);
                    if (!smp) { HL[row * 256 + ch] = hcur; AC[row * 256 + ch] = acur; }
                    else { bf16_t* p = MIX + row * 1024 + 512 + ch; *p = (bf16_t)f2bf(hcur * bf2f(*p)); }
                }
                if (!smp) { const size_t si = ((size_t)b * 128 + seg0 + wave) * 256 + ch; SEGA[si] = acur; SEGH[si] = hcur; }
                else { out[O_HS + (size_t)b * 256 + ch] = hcur;
#pragma unroll
                    for (int k = 0; k < 3; ++k) out[O_CS + ((size_t)b * 3 + k) * 256 + ch] = LX[(size_t)(row0 + 29 + k) * 256 + ch]; }
            }
            asm volatile("s_waitcnt lgkmcnt(0)" ::: "memory"); __syncthreads();
        }
#endif
        asm volatile("s_waitcnt vmcnt(0) lgkmcnt(0)" ::: "memory"); __syncthreads();
    }
    GRID_SYNC(2);

    if (IN(3)) {
        bf16_t* const MIX = (bf16_t*)(ws + WS_MIX); float* const LX = (float*)(ws + WS_LX); float* const HL = (float*)(ws + WS_HL); float* const AC = (float*)(ws + WS_AC); float* const SEGA = (float*)(ws + WS_SEGA); float* const SEGH = (float*)(ws + WS_SEGH);
#ifndef SKIP_P3
        for (int uu = vcu; uu < 256; uu += G) {
            const int b = uu >> 5, gI = uu & 31, ch = tid & 255, th = tid >> 8, s0 = 4 * gI + 2 * th;
            const float* sa = SEGA + (size_t)b * 128 * 256 + ch; const float* sh = SEGH + (size_t)b * 128 * 256 + ch;
            float H = 0.f;
            for (int s = 0; s < s0; ++s) H = sa[s * 256] * H + sh[s * 256];
            for (int s = s0; s < s0 + 2; ++s) {
                const size_t rbase = (size_t)b * SEQ + 64 * s;
#pragma unroll 4
                for (int t = 0; t < 64; ++t) { const size_t row = rbase + t; const float hv = HL[row * 256 + ch] + AC[row * 256 + ch] * H;
                    bf16_t* p = MIX + row * 1024 + 512 + ch; *p = (bf16_t)f2bf(hv * bf2f(*p));
                    if (s == 127 && t == 63) out[O_HP + (size_t)b * 256 + ch] = hv; }
                H = sa[s * 256] * H + sh[s * 256];
            }
            if (gI == 31 && th == 0) {
#pragma unroll
                for (int k = 0; k < 3; ++k) out[O_CP + ((size_t)b * 3 + k) * 256 + ch] = LX[((size_t)b * SEQ + SEQ - 3 + k) * 256 + ch];
            }
        }
#endif
        asm volatile("s_waitcnt vmcnt(0) lgkmcnt(0)" ::: "memory"); __syncthreads();
    }
    GRID_SYNC(3);

    if (IN(4)) {
        bf16_t* const MIX = (bf16_t*)(ws + WS_MIX); bf16_t* const WOUT = (bf16_t*)(ws + WS_WOUT);
#ifndef SKIP_P4
        pg8::Gemm g{MIX, WOUT, NTOK, 1024, 1024}; SchedOut S{G, bx};
        EpiOut E{args.in[I_XP], args.in[I_XS], out};
        pg8::gemm_phase<EpiOut, SchedOut, true, true>((LAS unsigned char*)lds, g, S, E);
#endif
    }
#undef IN
#undef GRID_SYNC
}

extern "C" void kernel_launch(void* const* d_in, const int* in_sizes, int n_in, void* d_out, int out_size, void* d_ws, size_t ws_size, hipStream_t stream) {
    static int grid = 0;
    if (grid == 0) {
        if (n_in != 30 || (size_t)out_size != O_END || ws_size < WS_END) { fprintf(stderr, "kernel_launch: unexpected shapes (n_in %d out %d ws %zu)\n", n_in, out_size, ws_size); grid = -1; return; }
        int dev = 0, cus = 0, per_cu = 0;
        hipGetDevice(&dev); hipDeviceGetAttribute(&cus, hipDeviceAttributeMultiprocessorCount, dev);
        if (hipFuncSetAttribute((const void*)fwd_kernel, hipFuncAttributeMaxDynamicSharedMemorySize, LDS_BYTES) != hipSuccess) { fprintf(stderr, "kernel_launch: hipFuncSetAttribute failed\n"); grid = -1; return; }
        if (hipOccupancyMaxActiveBlocksPerMultiprocessor(&per_cu, (const void*)fwd_kernel, 512, LDS_BYTES) != hipSuccess || per_cu < 1) { fprintf(stderr, "kernel_launch: occupancy query says %d\n", per_cu); per_cu = 1; }
        (void)hipGetLastError();
        grid = cus;
    }
    if (grid < 0) return;
    Args a{};
    for (int i = 0; i < 30; ++i) a.in[i] = (const float*)d_in[i];
    a.out = (float*)d_out; a.ws = (unsigned char*)d_ws;
    a.rope_r0 = std::pow(500000.0, -1.0 / 8.0); a.inv2pi = 1.0 / (2.0 * M_PI);
#if MK_N_LAUNCHES == 1
    a.ph_lo = 0; a.ph_hi = 5;
    void* kargs[] = {&a};
    hipError_t e = hipLaunchCooperativeKernel((const void*)fwd_kernel, dim3(grid), dim3(512), kargs, LDS_BYTES, stream);
    if (e != hipSuccess) fprintf(stderr, "cooperative launch failed: %s (grid %d)\n", hipGetErrorString(e), grid);
#else
    for (int p = 0; p < 5; ++p) { a.ph_lo = p; a.ph_hi = p + 1; hipLaunchKernelGGL(fwd_kernel, dim3(grid), dim3(512), LDS_BYTES, stream, a); }
#endif
}
```

```cpp
#include <hip/hip_runtime.h>
#include <hip/hip_cooperative_groups.h>
#include <cstdio>
#include <cstdint>
#include <cmath>
namespace cg = cooperative_groups;
#ifndef MK_N_LAUNCHES
#define MK_N_LAUNCHES 1
#endif
namespace pg8 {
#define PG8_LAS __attribute__((address_space(3)))
typedef unsigned short bf16_t;
typedef short bf16x8 __attribute__((ext_vector_type(8)));
typedef float f32x4 __attribute__((ext_vector_type(4)));
typedef unsigned u32x4 __attribute__((ext_vector_type(4)));
constexpr int BM = 256, BK = 64, HALF = 128, HTB = HALF * BK * 2  , STAGE_BYTES = 8 * HTB, NXCD = 8, WGM = 8;

__host__ __device__ __forceinline__ int lds_byte(int r, int c) { const int st = (r >> 4) * 2 + (c >> 5), rr = r & 15, cc = c & 31, ob = rr * 64 + cc * 2; return st * 1024 + (ob ^ (((ob >> 9) & 1) << 5)); }
__host__ __device__ __forceinline__ void stage_rc(int b, int& R, int& C) { const int st = b / 1024, sb = b % 1024, swz = sb ^ (((sb >> 9) & 1) << 5); R = (st >> 1) * 16 + swz / 64; C = (st & 1) * 32 + (swz % 64) / 2; }
__host__ __device__ __forceinline__ int perm32(int rho) { const int n = rho >> 4, i = rho & 15; return 8 * (i >> 2) + 4 * n + (i & 3); }

struct Unit { int pm, pn; };
struct Gemm { const bf16_t* A; const bf16_t* Bt; int M, N, K; };

struct StaticOrder {
    int nM, nN, nwg, G, c;
    __host__ __device__ void init(int M, int N, int G_, int c_) { nM = M / BM; nN = N / BM; nwg = nM * nN; G = G_; c = c_; }
    __host__ __device__ bool next(int i, Unit& u) const {
        const long L = (long)i * G + c; if (L >= nwg) return false;
        int wgid = (int)L; { const int q = nwg / NXCD, r = nwg % NXCD, xcd = wgid % NXCD, off = wgid / NXCD; wgid = (xcd < r ? xcd * (q + 1) : r * (q + 1) + (xcd - r) * q) + off; }
        const int nig = WGM * nN, gid = wgid / nig, fm = gid * WGM, gsz = (nM - fm) < WGM ? (nM - fm) : WGM;
        u.pm = fm + ((wgid % nig) % gsz); u.pn = (wgid % nig) / gsz; return true;
    }
    __device__ __forceinline__ void a_ready(const Unit&) const {}
    __device__ __forceinline__ void done(const Unit&) const {}
};

__device__ __forceinline__ unsigned cvt_pk_bf16(float lo, float hi) { unsigned r; asm volatile("v_cvt_pk_bf16_f32 %0, %1, %2" : "=v"(r) : "v"(lo), "v"(hi)); return r; }
typedef float f32x2 __attribute__((ext_vector_type(2)));
template <class Epi, class Sched, bool ALIGN_EPI = false, bool SP2 = false>
__device__ __forceinline__ void gemm_phase(PG8_LAS unsigned char* lds, const Gemm g, const Sched& S, const Epi& E) {
    const int tid = threadIdx.x, wid = __builtin_amdgcn_readfirstlane(tid >> 6), lane = tid & 63, wr = wid >> 2, wc = wid & 3, fr = lane & 15, fq = lane >> 4;
    const int K = g.K, nt = K / BK;
    unsigned voffA[2], voffB[2];
#pragma unroll
    for (int i = 0; i < 2; ++i) { int R, C; stage_rc(tid * 16 + i * 8192, R, C); const int Rb = Epi::PERM ? ((R & ~31) + perm32(R & 31)) : R;
        voffA[i] = (unsigned)(R * K + C) * 2u; voffB[i] = (unsigned)(Rb * K + C) * 2u; }
    const size_t kstep = (size_t)(BK * 2);
    const size_t hstep = (size_t)HALF * K * 2;
    const size_t tstep = 2 * hstep;
    const unsigned ldsw = (unsigned)wid * 1024u;
    const int aoff = lds_byte(wr * 64 + fr, fq * 8), boff = lds_byte(wc * 32 + fr, fq * 8);
#define PG8_SA(b, h) (((b) * 2 + (h)) * HTB)
#define PG8_SB(b, h) ((4 + (b) * 2 + (h)) * HTB)
#define PG8_STAGE(bufoff, gbase, voff) do { _Pragma("unroll") for (int _i = 0; _i < 2; ++_i) \
        __builtin_amdgcn_global_load_lds((const unsigned*)((const char*)(gbase) + (voff)[_i]), (PG8_LAS unsigned*)(lds + (bufoff) + ldsw + _i * 8192), 16, 0, 0); } while (0)
#define PG8_LDA(dst, b, h) do { _Pragma("unroll") for (int m = 0; m < 4; ++m) _Pragma("unroll") for (int k = 0; k < 2; ++k) dst[m][k] = *(const PG8_LAS bf16x8*)(lds + PG8_SA(b, h) + aoff + m * 2048 + k * 1024); } while (0)
#define PG8_LDB(dst, b, h) do { _Pragma("unroll") for (int n = 0; n < 2; ++n) _Pragma("unroll") for (int k = 0; k < 2; ++k) dst[n][k] = *(const PG8_LAS bf16x8*)(lds + PG8_SB(b, h) + boff + n * 2048 + k * 1024); } while (0)
#define PG8_MMA(ai, bj, At, Bt) do { __builtin_amdgcn_s_setprio(1); _Pragma("unroll") for (int m = 0; m < 4; ++m) _Pragma("unroll") for (int n = 0; n < 2; ++n) _Pragma("unroll") for (int k = 0; k < 2; ++k) \
        acc[ai][bj][m][n] = __builtin_amdgcn_mfma_f32_16x16x32_bf16(Bt[n][k], At[m][k], acc[ai][bj][m][n], 0, 0, 0); __builtin_amdgcn_s_setprio(0); } while (0)
#define PG8_WAIT_V(n) asm volatile("s_waitcnt vmcnt(" #n ")" ::: "memory")
#define PG8_WAIT_L(n) asm volatile("s_waitcnt lgkmcnt(" #n ")" ::: "memory")
#define PG8_BAR __builtin_amdgcn_s_barrier()
#define PG8_SCHED __builtin_amdgcn_sched_barrier(0)
    Unit cur, nxt; int ui = 0;
    if (!S.next(0, cur)) return;
    f32x4 acc[2][2][4][2];
    E.init(acc, cur, wr, wc, fr, fq);
    bf16x8 At[4][2], B0[2][2], B1[2][2];
    const char* cA = (const char*)g.A + (size_t)cur.pm * tstep; const char* cB = (const char*)g.Bt + (size_t)cur.pn * tstep;
    S.a_ready(cur);
    if constexpr (SP2) {
        PG8_STAGE(PG8_SB(0, 0), cB, voffB); PG8_STAGE(PG8_SB(0, 1), cB + hstep, voffB); PG8_STAGE(PG8_SA(0, 0), cA, voffA); PG8_STAGE(PG8_SA(0, 1), cA + hstep, voffA);
        if (wr == 1) PG8_BAR;
        PG8_WAIT_V(2); PG8_BAR;
        PG8_STAGE(PG8_SB(1, 0), cB + kstep, voffB); PG8_STAGE(PG8_SA(1, 0), cA + kstep, voffA); PG8_STAGE(PG8_SB(1, 1), cB + hstep + kstep, voffB);
        PG8_WAIT_V(6); PG8_BAR;
    } else {
        PG8_STAGE(PG8_SB(0, 0), cB, voffB); PG8_STAGE(PG8_SA(0, 0), cA, voffA); PG8_STAGE(PG8_SB(0, 1), cB + hstep, voffB); PG8_STAGE(PG8_SA(0, 1), cA + hstep, voffA);
        if (wr == 1) PG8_BAR;
        PG8_WAIT_V(4); PG8_BAR;
        PG8_STAGE(PG8_SB(1, 0), cB + kstep, voffB); PG8_STAGE(PG8_SA(1, 0), cA + kstep, voffA); PG8_STAGE(PG8_SB(1, 1), cB + hstep + kstep, voffB);
        PG8_WAIT_V(6); PG8_BAR;
    }
    for (;;) {
        const bool has_next = S.next(ui + 1, nxt);
        const char* nA = has_next ? (const char*)g.A + (size_t)nxt.pm * tstep : cA; const char* nB = has_next ? (const char*)g.Bt + (size_t)nxt.pn * tstep : cB;
        for (int t = 0; t < nt; t += 2) {
            const bool last = (t == nt - 2);
            const char* a1 = cA + (size_t)(t + 1) * kstep;
            const char* a2 = last ? nA : cA + (size_t)(t + 2) * kstep; const char* b2 = last ? nB : cB + (size_t)(t + 2) * kstep;
            const char* a3 = a2 + kstep; const char* b3 = b2 + kstep;
            if (last && has_next) S.a_ready(nxt);
            if constexpr (SP2) {
            PG8_LDB(B0, 0, 0); PG8_LDB(B1, 0, 1); PG8_SCHED; PG8_LDA(At, 0, 0); PG8_STAGE(PG8_SA(1, 1), a1 + hstep, voffA);
            PG8_WAIT_V(8); PG8_WAIT_L(0); PG8_BAR; PG8_MMA(0, 0, At, B0); PG8_MMA(0, 1, At, B1); PG8_BAR; PG8_SCHED;
            PG8_LDA(At, 0, 1); PG8_STAGE(PG8_SB(0, 0), b2, voffB); PG8_STAGE(PG8_SB(0, 1), b2 + hstep, voffB); PG8_STAGE(PG8_SA(0, 0), a2, voffA);
            PG8_WAIT_V(8); PG8_WAIT_L(0); PG8_BAR; PG8_MMA(1, 0, At, B0); PG8_MMA(1, 1, At, B1); PG8_BAR; PG8_SCHED;
            PG8_LDB(B0, 1, 0); PG8_LDB(B1, 1, 1); PG8_SCHED; PG8_LDA(At, 1, 0); PG8_STAGE(PG8_SA(0, 1), a2 + hstep, voffA);
            PG8_WAIT_V(8); PG8_WAIT_L(0); PG8_BAR; PG8_MMA(0, 0, At, B0); PG8_MMA(0, 1, At, B1); PG8_BAR; PG8_SCHED;
            PG8_LDA(At, 1, 1); PG8_STAGE(PG8_SB(1, 0), b3, voffB); PG8_STAGE(PG8_SB(1, 1), b3 + hstep, voffB); PG8_STAGE(PG8_SA(1, 0), a3, voffA);
            PG8_WAIT_V(8); PG8_WAIT_L(0); PG8_BAR; PG8_MMA(1, 0, At, B0); PG8_MMA(1, 1, At, B1); PG8_BAR; PG8_SCHED;
            } else {
            PG8_LDB(B0, 0, 0); PG8_SCHED; PG8_LDA(At, 0, 0); PG8_STAGE(PG8_SA(1, 1), a1 + hstep, voffA);
            PG8_WAIT_L(8); PG8_BAR; PG8_WAIT_L(0); PG8_MMA(0, 0, At, B0); PG8_BAR; PG8_SCHED;
            PG8_LDB(B1, 0, 1); PG8_STAGE(PG8_SB(0, 0), b2, voffB);
            PG8_BAR; PG8_WAIT_L(0); PG8_MMA(0, 1, At, B1); PG8_BAR;
            PG8_LDA(At, 0, 1); PG8_STAGE(PG8_SA(0, 0), a2, voffA);
            PG8_BAR; PG8_WAIT_L(0); PG8_MMA(1, 0, At, B0); PG8_BAR; PG8_SCHED;
            PG8_STAGE(PG8_SB(0, 1), b2 + hstep, voffB);
            PG8_WAIT_V(6); PG8_BAR; PG8_MMA(1, 1, At, B1); PG8_BAR;
            PG8_LDB(B0, 1, 0); PG8_SCHED; PG8_LDA(At, 1, 0); PG8_STAGE(PG8_SA(0, 1), a2 + hstep, voffA);
            PG8_WAIT_L(8); PG8_BAR; PG8_WAIT_L(0); PG8_MMA(0, 0, At, B0); PG8_BAR; PG8_SCHED;
            PG8_LDB(B1, 1, 1); PG8_STAGE(PG8_SB(1, 0), b3, voffB);
            PG8_BAR; PG8_WAIT_L(0); PG8_MMA(0, 1, At, B1); PG8_BAR;
            PG8_LDA(At, 1, 1); PG8_STAGE(PG8_SA(1, 0), a3, voffA);
            PG8_BAR; PG8_WAIT_L(0); PG8_MMA(1, 0, At, B0); PG8_BAR; PG8_SCHED;
            PG8_STAGE(PG8_SB(1, 1), b3 + hstep, voffB);
            PG8_WAIT_V(6); PG8_BAR; PG8_MMA(1, 1, At, B1); PG8_BAR;
            }
        }
        if constexpr (ALIGN_EPI) { if (wr == 0) PG8_BAR; }
        if constexpr (!Epi::AFTER_DRAIN) { E(acc, cur, wr, wc, fr, fq); S.done(cur); }
        if (!has_next) break;
        E.init(acc, nxt, wr, wc, fr, fq);
        cur = nxt; cA = nA; cB = nB; ++ui;
        if constexpr (ALIGN_EPI) { if (wr == 1) PG8_BAR; }
    }
    PG8_WAIT_V(0);
    if constexpr (!ALIGN_EPI) { if (wr == 0) PG8_BAR; }
    PG8_BAR;
    if constexpr (Epi::AFTER_DRAIN) { E.fused(acc, cur, wr, wc, fr, fq, lds, wid, lane); S.done(cur); }
#undef PG8_SA
#undef PG8_SB
#undef PG8_STAGE
#undef PG8_LDA
#undef PG8_LDB
#undef PG8_MMA
#undef PG8_WAIT_V
#undef PG8_WAIT_L
#undef PG8_BAR
#undef PG8_SCHED
}
}

constexpr int NB = 8, SEQ = 8192, SBAT = 32, STOK = 32, PAST = 1024;
constexpr int NTOK_P = NB * SEQ;
constexpr int NTOK_S = SBAT * STOK;
constexpr int NTOK = NTOK_P + NTOK_S;
constexpr int NMEMROW = NB * 256;
constexpr int AROWS = NTOK + NMEMROW;
constexpr int KSROWS = 1088;
constexpr float EPSN = 1e-6f;
constexpr float C2 = 0.125f * 1.4426950408889634f;
constexpr float ONE_M_LINIT = 0.8f, LAMBDA_INIT = 0.2f;
constexpr size_t O_YP = 0;
constexpr size_t O_YS = O_YP + (size_t)NTOK_P * 1024;
constexpr size_t O_KP = O_YS + (size_t)NTOK_S * 1024;
constexpr size_t O_VP = O_KP + (size_t)NTOK_P * 512;
constexpr size_t O_MK = O_VP + (size_t)NTOK_P * 512;
constexpr size_t O_MV = O_MK + (size_t)NMEMROW * 256;
constexpr size_t O_CP = O_MV + (size_t)NMEMROW * 256;
constexpr size_t O_HP = O_CP + 8 * 3 * 256;
constexpr size_t O_KS = O_HP + 8 * 256;
constexpr size_t O_VS = O_KS + (size_t)NTOK_S * 512;
constexpr size_t O_CS = O_VS + (size_t)NTOK_S * 512;
constexpr size_t O_HS = O_CS + 32 * 3 * 256;
constexpr size_t O_END = O_HS + 32 * 256;
constexpr size_t MiB = 1u << 20;
constexpr size_t WS_WIN = 0, WS_WOUT = 8 * MiB, WS_ROPE = 10 * MiB, WS_GAIN = 10 * MiB + 768 * 1024, WS_BAR = 10 * MiB + 800 * 1024, WS_SEGA = 11 * MiB, WS_SEGH = 12 * MiB, WS_AALL = 16 * MiB,
                 WS_QB = 152 * MiB, WS_KB = 218 * MiB, WS_VB = 282 * MiB, WS_KS = 346 * MiB, WS_VS = 382 * MiB, WS_MIX = 418 * MiB,
                 WS_LX = 548 * MiB, WS_MQ = 614 * MiB, WS_MKA = 648 * MiB, WS_MVA = 654 * MiB, WS_HL = 660 * MiB, WS_AC = 724 * MiB, WS_END = 788 * MiB;
#ifndef STAG_P1
#define STAG_P1 2000u
#endif
#ifndef STAG_P4
#define STAG_P4 1400u
#endif
constexpr int LDS_BYTES = 163840;
constexpr int LDS_TR = 131072, LDS_TA = 139264, LDS_GAIN = 143360, LDS_STG = 144384;
constexpr int LDS_WSF = 133120;
constexpr int RED_SLOT_F = 33280 / 4;

typedef unsigned short bf16_t;
typedef float f32x4 __attribute__((ext_vector_type(4)));
typedef float f32x2v __attribute__((ext_vector_type(2)));
typedef unsigned u32x4 __attribute__((ext_vector_type(4)));
typedef unsigned u32x2 __attribute__((ext_vector_type(2)));
#define LAS __attribute__((address_space(3)))

__device__ __forceinline__ unsigned f2bf(float f) { unsigned u = __builtin_bit_cast(unsigned, f); return (u + 0x7fffu + ((u >> 16) & 1u)) >> 16; }
__device__ __forceinline__ unsigned pk2(float lo, float hi) { return f2bf(lo) | (f2bf(hi) << 16); }
__device__ __forceinline__ unsigned hw_pk2(float lo, float hi) { typedef float f2_t __attribute__((ext_vector_type(2))); typedef __bf16 b2_t __attribute__((ext_vector_type(2)));
    f2_t v = {lo, hi}; b2_t b = __builtin_convertvector(v, b2_t); return __builtin_bit_cast(unsigned, b); }
__device__ __forceinline__ float bf2f(unsigned short b) { return __builtin_bit_cast(float, (unsigned)b << 16); }
__device__ __forceinline__ float fast_exp(float x) { return __builtin_amdgcn_exp2f(x * 1.4426950408889634f); }
__device__ __forceinline__ float sigmoidf_(float x) { return __builtin_amdgcn_rcpf(1.0f + fast_exp(-x)); }
__device__ __forceinline__ float siluf_(float x) { return x * sigmoidf_(x); }
template <int M> __device__ __forceinline__ float lane_xor(float v) { return __builtin_bit_cast(float, __builtin_amdgcn_ds_swizzle(__builtin_bit_cast(int, v), (M << 10) | 0x1f)); }
__device__ __forceinline__ float sum_xor32(float v) { const unsigned u = __builtin_bit_cast(unsigned, v); auto rr = __builtin_amdgcn_permlane32_swap(u, u, false, false);
    return __builtin_bit_cast(float, (unsigned)rr[0]) + __builtin_bit_cast(float, (unsigned)rr[1]); }
__device__ __forceinline__ float sum32(float v) { v += lane_xor<1>(v); v += lane_xor<2>(v); v += lane_xor<4>(v); v += lane_xor<8>(v); v += lane_xor<16>(v); return v; }
__device__ __forceinline__ float wave_sum(float v) { return sum_xor32(sum32(v)); }
__device__ __forceinline__ void st_bf16x8(bf16_t* p, const float (&v)[8]) {
    u32x4 w; w.x = hw_pk2(v[0], v[1]); w.y = hw_pk2(v[2], v[3]); w.z = hw_pk2(v[4], v[5]); w.w = hw_pk2(v[6], v[7]); *(u32x4*)p = w;
}
__device__ __forceinline__ void st_f32x8(float* p, const float (&v)[8]) {
    *(f32x4*)p = (f32x4){v[0], v[1], v[2], v[3]}; *(f32x4*)(p + 4) = (f32x4){v[4], v[5], v[6], v[7]};
}

__device__ __forceinline__ void stage_store_f32(LAS float* st, int fr, int fq, const float (&v)[8], float* gbase, size_t pitch) {
    *(LAS f32x4*)(st + fr * 36 + 8 * fq) = (f32x4){v[0], v[1], v[2], v[3]}; *(LAS f32x4*)(st + fr * 36 + 8 * fq + 4) = (f32x4){v[4], v[5], v[6], v[7]};
    asm volatile("s_waitcnt lgkmcnt(0)" ::: "memory");
    int lane = fr + 16 * fq; asm volatile("" : "+v"(lane));
    const int tr = lane >> 3, tc = 4 * (lane & 7);
    const f32x4 t0 = *(LAS const f32x4*)(st + tr * 36 + tc), t1 = *(LAS const f32x4*)(st + (8 + tr) * 36 + tc);
    asm volatile("s_waitcnt lgkmcnt(0)" ::: "memory");
    *(f32x4*)(gbase + (size_t)tr * pitch + tc) = t0; *(f32x4*)(gbase + (size_t)(8 + tr) * pitch + tc) = t1;
}

struct SchedIn {
    int G, c;
    __device__ bool next(int i, pg8::Unit& u) const {
        const long L = (long)i * G + c; constexpr int nM = NTOK / 256, nN = 12, nwg = nM * nN;
        if (L >= nwg + 16) return false;
        if (L >= nwg) { const int r = (int)L - nwg; u.pm = nM + (r >> 1); u.pn = 12 + (r & 1); return true; }
        int wgid = (int)L; { const int q = nwg / 8, xcd = wgid % 8, off = wgid / 8; wgid = xcd * q + off; }
        const int nig = 8 * nN, gid = wgid / nig, fm = gid * 8, gsz = (nM - fm) < 8 ? (nM - fm) : 8;
        u.pm = fm + ((wgid % nig) % gsz); u.pn = (wgid % nig) / gsz; return true;
    }
    __device__ __forceinline__ void a_ready(const pg8::Unit&) const {}
    __device__ __forceinline__ void done(const pg8::Unit&) const {}
};
struct SchedOut {
    int G, c;
    __device__ bool next(int i, pg8::Unit& u) const {
        const long L = (long)i * G + c; constexpr int nM = NTOK_P / 256, nN = 4, nwg = nM * nN;
        if (L >= nwg) return false;
        int wgid = (int)L; { const int q = nwg / 8, xcd = wgid % 8, off = wgid / 8; wgid = xcd * q + off; }
        const int nig = 8 * nN, gid = wgid / nig, fm = gid * 8, gsz = (nM - fm) < 8 ? (nM - fm) : 8;
        u.pm = fm + ((wgid % nig) % gsz); u.pn = (wgid % nig) / gsz; return true;
    }
    __device__ __forceinline__ void a_ready(const pg8::Unit&) const {}
    __device__ __forceinline__ void done(const pg8::Unit&) const {}
};

struct SchedOne {
    int pm, pn;
    __device__ bool next(int i, pg8::Unit& u) const { if (i > 0) return false; u.pm = pm; u.pn = pn; return true; }
    __device__ __forceinline__ void a_ready(const pg8::Unit&) const {}
    __device__ __forceinline__ void done(const pg8::Unit&) const {}
};
struct EpiIn {
    static constexpr bool PERM = true, AFTER_DRAIN = false;
    __device__ __forceinline__ void init(f32x4 (&acc)[2][2][4][2], const pg8::Unit&, int, int, int, int) const {
#pragma unroll
        for (int a = 0; a < 2; ++a)
#pragma unroll
            for (int b = 0; b < 2; ++b)
#pragma unroll
                for (int m = 0; m < 4; ++m)
#pragma unroll
                    for (int n = 0; n < 2; ++n) acc[a][b][m][n] = (f32x4){0.f, 0.f, 0.f, 0.f};
    }
    unsigned char* ws; float* out; LAS unsigned char* ldsb;
    __device__ __forceinline__ void operator()(const f32x4 (&acc)[2][2][4][2], const pg8::Unit& u, int wr, int wc, int fr, int fq) const {
        bf16_t* const Qb = (bf16_t*)(ws + WS_QB); bf16_t* const Kb = (bf16_t*)(ws + WS_KB); bf16_t* const Vb = (bf16_t*)(ws + WS_VB); bf16_t* const KS = (bf16_t*)(ws + WS_KS); bf16_t* const VS = (bf16_t*)(ws + WS_VS);
        bf16_t* const MIX = (bf16_t*)(ws + WS_MIX); bf16_t* const MQ = (bf16_t*)(ws + WS_MQ); bf16_t* const MKA = (bf16_t*)(ws + WS_MKA); bf16_t* const MVA = (bf16_t*)(ws + WS_MVA);
        float* const LX = (float*)(ws + WS_LX);
        const int pn = u.pn;
        LAS float* const stg = (LAS float*)(ldsb + LDS_STG) + (wr * 4 + wc) * 576;
        const int cl0 = 64 * wc + 8 * fq;
        const int rb = u.pm * 256 + wr * 64 + fr;
        LAS const float* g = nullptr;
        { LAS const float* const gains = (LAS const float*)(ldsb + LDS_GAIN); if (pn < 2) g = gains; else if (pn < 4) g = gains + 64; else if (pn == 10) g = gains + 128; else if (pn == 12) g = gains + 192; }
        float gv[2][8];
#pragma unroll
        for (int bj = 0; bj < 2; ++bj)
#pragma unroll
            for (int k = 0; k < 8; ++k) gv[bj][k] = g ? g[32 * bj + 8 * fq + k] : 1.f;
#pragma unroll
        for (int ai = 0; ai < 2; ++ai)
#pragma unroll
            for (int m = 0; m < 4; ++m) {
                const int row = rb + ai * 128 + m * 16;
                float v[2][8];
#pragma unroll
                for (int bj = 0; bj < 2; ++bj)
#pragma unroll
                    for (int n = 0; n < 2; ++n)
#pragma unroll
                        for (int e = 0; e < 4; ++e) v[bj][4 * n + e] = acc[ai][bj][m][n][e];
                if (g) {
                    float ss = 0.f;
#pragma unroll
                    for (int bj = 0; bj < 2; ++bj)
#pragma unroll
                        for (int k = 0; k < 8; ++k) ss += v[bj][k] * v[bj][k];
                    ss += lane_xor<16>(ss); ss = sum_xor32(ss);
                    const float rs = __builtin_amdgcn_rsqf(ss * (1.0f / 64.0f) + EPSN);
#pragma unroll
                    for (int bj = 0; bj < 2; ++bj)
#pragma unroll
                        for (int k = 0; k < 8; ++k) v[bj][k] *= rs * gv[bj][k];
                    if (pn < 4) {
                        const int pos = row < NTOK_P ? (row & (SEQ - 1)) : (PAST + (row & 31));
                        float pv[8];
#pragma unroll
                        for (int k = 0; k < 8; ++k) pv[k] = lane_xor<16>(v[0][k]);
                        if (fq < 2) {
                            LAS const f32x2v* tr = (LAS const f32x2v*)(ldsb + LDS_TR) + (pos & 127) * 8; LAS const f32x2v* ta = (LAS const f32x2v*)(ldsb + LDS_TA) + (pos >> 7) * 8;
#pragma unroll
                            for (int k = 0; k < 8; ++k) { const f32x2v R = tr[k], A = ta[k]; const float cc = A.x * R.x - A.y * R.y, sn = A.y * R.x + A.x * R.y;
                                v[0][k] = fq == 0 ? (v[0][k] * cc - pv[k] * sn) : (v[0][k] * cc + pv[k] * sn); }
                        }
                    }
                }
                if (pn < 2) {
#pragma unroll
                    for (int bj = 0; bj < 2; ++bj) { float o[8];
#pragma unroll
                        for (int k = 0; k < 8; ++k) o[k] = v[bj][k] * C2;
                        st_bf16x8(Qb + (size_t)row * 512 + 256 * pn + cl0 + 32 * bj, o); }
                } else if (pn < 6) {
                    const bool isk = pn < 4; const int col = 256 * (pn - (isk ? 2 : 4)) + cl0;
                    float* of; bf16_t* ob;
                    if (row < NTOK_P) { of = out + (isk ? O_KP : O_VP) + (size_t)row * 512 + col; ob = (isk ? Kb : Vb) + (size_t)row * 512 + col; }
                    else { const int rs_ = row - NTOK_P; of = out + (isk ? O_KS : O_VS) + (size_t)rs_ * 512 + col;
                           ob = (isk ? KS : VS) + ((size_t)(rs_ >> 5) * KSROWS + PAST + (rs_ & 31)) * 512 + col; }
                    float* const gb = of - (size_t)fr * 512 - 8 * fq;
#pragma unroll
                    for (int bj = 0; bj < 2; ++bj) { stage_store_f32(stg, fr, fq, v[bj], gb + 32 * bj, 512); st_bf16x8(ob + 32 * bj, v[bj]); }
                } else if (pn == 8) {
                    float* const gb = LX + (size_t)(row - fr) * 256 + 64 * wc;
#pragma unroll
                    for (int bj = 0; bj < 2; ++bj) stage_store_f32(stg, fr, fq, v[bj], gb + 32 * bj, 256);
                } else if (pn == 10) {
#pragma unroll
                    for (int bj = 0; bj < 2; ++bj) { float o[8];
#pragma unroll
                        for (int k = 0; k < 8; ++k) o[k] = v[bj][k] * C2;
                        st_bf16x8(MQ + (size_t)row * 256 + cl0 + 32 * bj, o); }
                } else if (pn >= 12) {
                    const int rm = row - NTOK;
#pragma unroll
                    for (int bj = 0; bj < 2; ++bj) { st_f32x8(out + (pn == 12 ? O_MK : O_MV) + (size_t)rm * 256 + cl0 + 32 * bj, v[bj]);
                        st_bf16x8((pn == 12 ? MKA : MVA) + (size_t)rm * 256 + cl0 + 32 * bj, v[bj]); }
                } else {
                    const int colb = pn == 6 ? 0 : pn == 7 ? 256 : pn == 9 ? 512 : 768;
#pragma unroll
                    for (int bj = 0; bj < 2; ++bj) { float o[8];
#pragma unroll
                        for (int k = 0; k < 8; ++k) o[k] = siluf_(v[bj][k]);
                        st_bf16x8(MIX + (size_t)row * 1024 + colb + cl0 + 32 * bj, o); }
                }
            }
    }
};
struct EpiOut {
    static constexpr bool PERM = true, AFTER_DRAIN = false;
    const float *xp, *xs; float* out; LAS unsigned char* ldsb;
    __device__ __forceinline__ void init(f32x4 (&acc)[2][2][4][2], const pg8::Unit& u, int wr, int wc, int fr, int fq) const {
        const int lane = fr + 16 * fq; LAS float* st = (LAS float*)(ldsb + LDS_TR) + (wr * 4 + wc) * 576;
        const int tr = lane >> 3, tc = 4 * (lane & 7);
#pragma unroll
        for (int ai = 0; ai < 2; ++ai)
#pragma unroll
            for (int m = 0; m < 4; ++m)
#pragma unroll
                for (int bj = 0; bj < 2; ++bj) {
                    int trr = tr; asm volatile("" : "+v"(trr));
                    const int row0 = u.pm * 256 + ai * 128 + wr * 64 + m * 16, col = 256 * u.pn + 64 * wc + 32 * bj + tc;
#pragma unroll
                    for (int j2 = 0; j2 < 2; ++j2) { const int row = row0 + 8 * j2 + trr;
                        acc[ai][bj][m][j2] = *(const f32x4*)((row < NTOK_P ? xp + (size_t)row * 1024 : xs + (size_t)(row - NTOK_P) * 1024) + col); }
                }
#pragma unroll
        for (int ai = 0; ai < 2; ++ai)
#pragma unroll
            for (int m = 0; m < 4; ++m)
#pragma unroll
                for (int bj = 0; bj < 2; ++bj) {
#pragma unroll
                    for (int j2 = 0; j2 < 2; ++j2) *(LAS f32x4*)(st + (8 * j2 + tr) * 36 + tc) = acc[ai][bj][m][j2];
                    asm volatile("s_waitcnt lgkmcnt(0)" ::: "memory");
#pragma unroll
                    for (int n = 0; n < 2; ++n) acc[ai][bj][m][n] = *(LAS const f32x4*)(st + fr * 36 + 8 * fq + 4 * n);
                    asm volatile("s_waitcnt lgkmcnt(0)" ::: "memory");
                }
    }
    __device__ __forceinline__ void operator()(const f32x4 (&acc)[2][2][4][2], const pg8::Unit& u, int wr, int wc, int fr, int fq) const {
        const int lane = fr + 16 * fq; LAS float* st = (LAS float*)(ldsb + LDS_TR) + (wr * 4 + wc) * 576;
        const int tr = lane >> 3, tc = 4 * (lane & 7);
#pragma unroll
        for (int ai = 0; ai < 2; ++ai)
#pragma unroll
            for (int m = 0; m < 4; ++m)
#pragma unroll
                for (int bj = 0; bj < 2; ++bj) {
#pragma unroll
                    for (int n = 0; n < 2; ++n) *(LAS f32x4*)(st + fr * 36 + 8 * fq + 4 * n) = acc[ai][bj][m][n];
                    asm volatile("s_waitcnt lgkmcnt(0)" ::: "memory");
                    int trr = tr; asm volatile("" : "+v"(trr));
                    const int row0 = u.pm * 256 + ai * 128 + wr * 64 + m * 16, col = 256 * u.pn + 64 * wc + 32 * bj + tc;
                    f32x4 t[2];
#pragma unroll
                    for (int j2 = 0; j2 < 2; ++j2) t[j2] = *(LAS const f32x4*)(st + (8 * j2 + tr) * 36 + tc);
                    asm volatile("s_waitcnt lgkmcnt(0)" ::: "memory");
#pragma unroll
                    for (int j2 = 0; j2 < 2; ++j2) *(f32x4*)(out + (size_t)(row0 + 8 * j2 + trr) * 1024 + col) = t[j2];
                }
    }
};

namespace att {
typedef short bf16x8 __attribute__((ext_vector_type(8)));
typedef short s16x4 __attribute__((ext_vector_type(4)));
typedef float f32x16 __attribute__((ext_vector_type(16)));
typedef float f32x2_t __attribute__((ext_vector_type(2)));
typedef __bf16 bf16x2_t __attribute__((ext_vector_type(2)));
__device__ __forceinline__ unsigned cvtpk(float lo, float hi) { f32x2_t v = {lo, hi}; bf16x2_t b = __builtin_convertvector(v, bf16x2_t); return __builtin_bit_cast(unsigned, b); }
__device__ __forceinline__ void glds16(const void* gsrc, unsigned lds_dst) { unsigned keep;
    asm volatile("s_mov_b32 %0, m0\n\ts_mov_b32 m0, %2\n\ts_nop 0\n\tglobal_load_lds_dwordx4 %1, off\n\ts_mov_b32 m0, %0" : "=&s"(keep) : "v"(gsrc), "s"(lds_dst) : "memory"); }
#define ATT_WAIT_BAR() asm volatile("s_waitcnt vmcnt(0) lgkmcnt(0)\n\ts_barrier" ::: "memory")
#ifndef ATT_PRIO
#define ATT_PRIO(x) do {} while (0)
#endif
#define ATT_LBAR() asm volatile("s_waitcnt lgkmcnt(0)\n\ts_barrier" ::: "memory")
__device__ __forceinline__ s16x4 vtr(LAS const unsigned char* p) { typedef short v4i16_t __attribute__((ext_vector_type(4)));
    return __builtin_bit_cast(s16x4, __builtin_amdgcn_ds_read_tr16_b64_v4i16((LAS v4i16_t*)p)); }
__device__ __forceinline__ int crow(int r, int hh) { return (r & 3) + 8 * (r >> 2) + 4 * hh; }

template <int NC, int DV, bool PRE = false>
__device__ __forceinline__ void attn_loop(unsigned char* ldsg, const bf16_t* Qrow, const unsigned char* Kg, const unsigned char* Vg, int kvstride, int NT, int last_nh, int mode, int wpar, int c,
                                          f32x16 (&O)[DV / 32], float& l) {
    constexpr int KROW = NC * 128, VROW = DV * 2, KT = 64 * KROW, VT = 64 * VROW, BUF = KT + VT, KPW = KT / 8192, VPW = VT / 8192, PPW = KPW + VPW;
    const int tid = threadIdx.x, lane = tid & 63, r32 = lane & 31, hh = lane >> 5; const int w = __builtin_amdgcn_readfirstlane(tid >> 6);
    LAS const unsigned char* lds3 = (LAS const unsigned char*)ldsg; const unsigned lds0 = (unsigned)(uintptr_t)ldsg;
    unsigned ksrc[KPW], vsrc[VPW];
#pragma unroll
    for (int i = 0; i < KPW; ++i) { const int pos = 64 * (KPW * w + i) + lane; constexpr int CPR = KROW / 16; const int row = pos / CPR, cp = pos % CPR;
        const int cc = cp ^ (KROW == 256 ? (row & 15) : ((row >> 1) & 7)); ksrc[i] = (unsigned)(row * kvstride + cc * 16); }
#pragma unroll
    for (int i = 0; i < VPW; ++i) { const int pos = 64 * (VPW * w + i) + lane; constexpr int CPR = VROW / 16; const int row = pos / CPR, cp = pos % CPR;
        const int cc = cp ^ (VROW == 256 ? 4 * (row & 3) : 4 * ((row >> 1) & 1)); vsrc[i] = (unsigned)(row * kvstride + cc * 16); }
#define ATT_ISSUE(j) do { const size_t tb_ = (size_t)(j) * 64 * (size_t)kvstride; const unsigned sb_ = lds0 + ((j) & 3) * BUF; \
        _Pragma("unroll") for (int i_ = 0; i_ < KPW; ++i_) glds16(Kg + tb_ + ksrc[i_], (unsigned)__builtin_amdgcn_readfirstlane(sb_ + 1024 * (KPW * w + i_))); \
        _Pragma("unroll") for (int i_ = 0; i_ < VPW; ++i_) glds16(Vg + tb_ + vsrc[i_], (unsigned)__builtin_amdgcn_readfirstlane(sb_ + KT + 1024 * (VPW * w + i_))); } while (0)
    bf16x8 q[4];
#pragma unroll
    for (int ks = 0; ks < 4; ++ks) q[ks] = *(const bf16x8*)(Qrow + c * 64 + ks * 16 + hh * 8);
    if (!PRE) { ATT_ISSUE(0); if (NT > 1) ATT_ISSUE(1); if (NT > 2) ATT_ISSUE(2); }
    asm volatile("" : "+v"(q[0]), "+v"(q[1]), "+v"(q[2]), "+v"(q[3]) :: "memory");
    const int kx = KROW == 256 ? (r32 & 15) : ((r32 >> 1) & 7);
    const int kb = r32 * KROW + ((hh ^ (kx & 1)) << 4), kxh = (kx & ~1) << 4, cb = c << 7;
    const int L = lane & 15, gp = (lane >> 4) & 1, sw = VROW == 256 ? ((L >> 2) & 3) : ((L >> 3) & 1);
    int vo[DV / 32];
#pragma unroll
    for (int db = 0; db < DV / 32; ++db) vo[db] = (4 * hh + (L >> 2)) * VROW + ((((db ^ sw) << 2) + 2 * gp + ((L & 3) >> 1)) << 4) + 8 * (L & 1);
#pragma nounroll
    for (int j = 0; j < NT; ++j) {
        {   const int rem = NT - 1 - j;
            if (rem >= 2) { if constexpr (PPW == 4) asm volatile("s_waitcnt vmcnt(8) lgkmcnt(0)\n\ts_barrier" ::: "memory"); else asm volatile("s_waitcnt vmcnt(4) lgkmcnt(0)\n\ts_barrier" ::: "memory"); }
            else if (rem == 1) { if constexpr (PPW == 4) asm volatile("s_waitcnt vmcnt(4) lgkmcnt(0)\n\ts_barrier" ::: "memory"); else asm volatile("s_waitcnt vmcnt(2) lgkmcnt(0)\n\ts_barrier" ::: "memory"); }
            else asm volatile("s_waitcnt vmcnt(0) lgkmcnt(0)\n\ts_barrier" ::: "memory"); }
        if (j + 3 < NT) ATT_ISSUE(j + 3);
        const bool active = mode == 0 ? (j <= wpar) : mode == 1 ? ((j & 3) == wpar) : ((j >> 1) == wpar);
        if (active) {
            const int nh = (j == NT - 1) ? last_nh : 2;
            LAS const unsigned char* Kt = lds3 + (j & 3) * BUF; LAS const unsigned char* Vt = Kt + KT;
#pragma unroll
            for (int kh = 0; kh < 2; ++kh) {
                if (kh < nh) {
                    f32x16 X = {};
                    ATT_PRIO(1);
#pragma unroll
                    for (int ks = 0; ks < 4; ++ks) {
                        const int co = kb + ((cb + (ks << 5)) ^ kxh) + kh * 32 * KROW;
                        const bf16x8 a0 = *(LAS const bf16x8*)(Kt + co);
                        X = __builtin_amdgcn_mfma_f32_32x32x16_bf16(a0, q[ks], X, 0, 0, 0);
                    }
                    ATT_PRIO(0);
                    float s = 0.f; u32x4 pk[2];
#pragma unroll
                    for (int r = 0; r < 16; ++r) { X[r] = __builtin_amdgcn_exp2f(X[r]); s += X[r]; }
#pragma unroll
                    for (int s2 = 0; s2 < 2; ++s2) pk[s2] = (u32x4){cvtpk(X[8 * s2], X[8 * s2 + 1]), cvtpk(X[8 * s2 + 2], X[8 * s2 + 3]), cvtpk(X[8 * s2 + 4], X[8 * s2 + 5]), cvtpk(X[8 * s2 + 6], X[8 * s2 + 7])};
                    l += s;
                    ATT_PRIO(1);
#pragma unroll
                    for (int s2 = 0; s2 < 2; ++s2) {
                        const bf16x8 pa = __builtin_bit_cast(bf16x8, pk[s2]);
#pragma unroll
                        for (int db = 0; db < DV / 32; ++db) {
                            const s16x4 lo = vtr(Vt + vo[db] + (32 * kh + 16 * s2) * VROW), hi = vtr(Vt + vo[db] + (32 * kh + 16 * s2 + 8) * VROW);
                            const bf16x8 vb = (bf16x8){lo[0], lo[1], lo[2], lo[3], hi[0], hi[1], hi[2], hi[3]};
                            O[db] = __builtin_amdgcn_mfma_f32_32x32x16_bf16(pa, vb, O[db], 0, 0, 0);
                        }
                    }
                    ATT_PRIO(0);
                }
            }
        }
    }
    ATT_WAIT_BAR();
#undef ATT_ISSUE
}

template <int NC, int DV>
__device__ __forceinline__ void attn_prologue(unsigned char* ldsg, const unsigned char* Kg, const unsigned char* Vg, int kvstride, int NT) {
    constexpr int KROW = NC * 128, VROW = DV * 2, KT = 64 * KROW, VT = 64 * VROW, BUF = KT + VT, KPW = KT / 8192, VPW = VT / 8192;
    const int tid = threadIdx.x, lane = tid & 63; const int w = __builtin_amdgcn_readfirstlane(tid >> 6);
    const unsigned lds0 = (unsigned)(uintptr_t)ldsg;
    unsigned ksrc[KPW], vsrc[VPW];
#pragma unroll
    for (int i = 0; i < KPW; ++i) { const int pos = 64 * (KPW * w + i) + lane; constexpr int CPR = KROW / 16; const int row = pos / CPR, cp = pos % CPR;
        const int cc = cp ^ (KROW == 256 ? (row & 15) : ((row >> 1) & 7)); ksrc[i] = (unsigned)(row * kvstride + cc * 16); }
#pragma unroll
    for (int i = 0; i < VPW; ++i) { const int pos = 64 * (VPW * w + i) + lane; constexpr int CPR = VROW / 16; const int row = pos / CPR, cp = pos % CPR;
        const int cc = cp ^ (VROW == 256 ? 4 * (row & 3) : 4 * ((row >> 1) & 1)); vsrc[i] = (unsigned)(row * kvstride + cc * 16); }
#pragma unroll
    for (int j = 0; j < 3; ++j) if (j < NT) { const size_t tb_ = (size_t)j * 64 * (size_t)kvstride; const unsigned sb_ = lds0 + j * BUF;
#pragma unroll
        for (int i_ = 0; i_ < KPW; ++i_) glds16(Kg + tb_ + ksrc[i_], (unsigned)__builtin_amdgcn_readfirstlane(sb_ + 1024 * (KPW * w + i_)));
#pragma unroll
        for (int i_ = 0; i_ < VPW; ++i_) glds16(Vg + tb_ + vsrc[i_], (unsigned)__builtin_amdgcn_readfirstlane(sb_ + KT + 1024 * (VPW * w + i_))); }
}

template <int NDB>
__device__ __forceinline__ void tree_reduce4(f32x16 (&O)[NDB], float& l, LAS float* red, int w, int lane) {
    constexpr int SLOTF = (NDB * 16 + 1) * 64; const int grp = w >> 2, idx = w & 3;
#pragma unroll
    for (int step = 2; step >= 1; step >>= 1) {
        if (idx >= step && idx < 2 * step) { LAS float* s = red + (grp * 2 + idx - step) * SLOTF + lane;
#pragma unroll
            for (int db = 0; db < NDB; ++db) {
#pragma unroll
                for (int r = 0; r < 16; ++r) s[64 * (db * 16 + r)] = O[db][r];
                asm volatile("" ::: "memory"); }
            s[64 * NDB * 16] = l; }
        ATT_LBAR();
        if (idx < step) { LAS const float* s = red + (grp * 2 + idx) * SLOTF + lane;
#pragma unroll
            for (int db = 0; db < NDB; ++db) {
#pragma unroll
                for (int r = 0; r < 16; ++r) O[db][r] += s[64 * (db * 16 + r)];
                asm volatile("s_waitcnt lgkmcnt(0)" ::: "memory"); }
            l += s[64 * NDB * 16]; }
        ATT_LBAR();
    }
}
__device__ __forceinline__ void diff_finish(f32x16 (&O)[4], float l, int c, bool doit, float lam, LAS float* wsf, LAS float* xs, int tok0, int h, const float* gsub, bf16_t* MIX) {
    int lane = threadIdx.x & 63; asm volatile("" : "+v"(lane), "+v"(tok0));
    const int r32 = lane & 31, hh = lane >> 5;
    const float ls = sum_xor32(l);
    if (hh == 0) wsf[r32] = (c == 0 ? 1.0f : lam) / ls;
    asm volatile("s_waitcnt lgkmcnt(0)" ::: "memory");
    if (doit && c == 1) {
#pragma unroll
        for (int r = 0; r < 16; ++r) { const float a = wsf[crow(r, hh)];
#pragma unroll
            for (int db = 0; db < 4; ++db) xs[64 * (db * 16 + r) + lane] = O[db][r] * a; }
    }
    ATT_LBAR();
    if (doit && c == 0) {
        float gs[4];
#pragma unroll
        for (int db = 0; db < 4; ++db) gs[db] = gsub[32 * db + r32] * ONE_M_LINIT;
#pragma unroll
        for (int r0 = 0; r0 < 16; r0 += 8) {
            unsigned short gt[8][4];
#pragma unroll
            for (int r = 0; r < 8; ++r) { const bf16_t* p = MIX + (size_t)(tok0 + crow(r0 + r, hh)) * 1024 + h * 128 + r32;
#pragma unroll
                for (int db = 0; db < 4; ++db) gt[r][db] = p[32 * db]; }
#pragma unroll
            for (int r = 0; r < 8; ++r) {
                const int qr = crow(r0 + r, hh); const float a = wsf[qr];
                float o[4], ss = 0.f;
#pragma unroll
                for (int db = 0; db < 4; ++db) { o[db] = O[db][r0 + r] * a - xs[64 * (db * 16 + r0 + r) + lane]; ss += o[db] * o[db]; }
                ss = sum32(ss);
                const float rs = __builtin_amdgcn_rsqf(ss * (1.0f / 128.0f) + EPSN);
                bf16_t* p = MIX + (size_t)(tok0 + qr) * 1024 + h * 128 + r32;
#pragma unroll
                for (int db = 0; db < 4; ++db) p[32 * db] = (bf16_t)f2bf(o[db] * rs * gs[db] * bf2f(gt[r][db]));
            }
            asm volatile("" ::: "memory");
        }
    }
    ATT_LBAR();
}
__device__ __forceinline__ void mem_finish(f32x16 (&O)[2], float l, int part, bool doit, bool pair, LAS float* wsf, LAS float* xs, int tok0, int h, bf16_t* MIX) {
    int lane = threadIdx.x & 63; asm volatile("" : "+v"(lane), "+v"(tok0));
    const int r32 = lane & 31, hh = lane >> 5;
    const float ls = sum_xor32(l);
    if (doit && part == 1) {
#pragma unroll
        for (int db = 0; db < 2; ++db)
#pragma unroll
            for (int r = 0; r < 16; ++r) xs[64 * (db * 16 + r) + lane] = O[db][r];
        xs[64 * 32 + lane] = ls;
    }
    ATT_LBAR();
    if (doit && part == 0) {
        const float lt = ls + (pair ? xs[64 * 32 + lane] : 0.f);
        if (hh == 0) wsf[r32] = 1.0f / lt;
        asm volatile("s_waitcnt lgkmcnt(0)" ::: "memory");
        unsigned short gt[16][2];
#pragma unroll
        for (int r = 0; r < 16; ++r) { const bf16_t* p = MIX + (size_t)(tok0 + crow(r, hh)) * 1024 + 768 + h * 64 + r32; gt[r][0] = p[0]; gt[r][1] = p[32]; }
#pragma unroll
        for (int r = 0; r < 16; ++r) {
            const int qr = crow(r, hh); const float a = wsf[qr];
            bf16_t* p = MIX + (size_t)(tok0 + qr) * 1024 + 768 + h * 64 + r32;
#pragma unroll
            for (int db = 0; db < 2; ++db) p[32 * db] = (bf16_t)f2bf((O[db][r] + (pair ? xs[64 * (db * 16 + r) + lane] : 0.f)) * a * bf2f(gt[r][db]));
        }
    }
    ATT_LBAR();
}
}

struct Args { const float* in[30]; float* out; unsigned char* ws; double rope_r0; double inv2pi; int ph_lo, ph_hi; };
enum { I_XP = 0, I_XS, I_MEM, I_CDK, I_CDV, I_CMK, I_CMV, I_SCONV, I_SH, I_NORMG, I_WIN, I_GQ, I_GK, I_LQ1, I_LK1, I_LQ2, I_LK2, I_GSUB, I_CONVW, I_CONVB, I_WA, I_BA, I_WX, I_BX,
       I_LAMBDA, I_MEMNG, I_WMEM, I_GMQ, I_GMK, I_WOUT };

__device__ __forceinline__ void p0_transpose_item(const float* W, int N, bf16_t* WT, int row_off, LAS float* scr, int item, int lane) {
    const int nblk = N / 32, kb = item / nblk, nb = item % nblk, k0 = 64 * kb, n0 = 32 * nb;
#pragma unroll 8
    for (int i = 0; i < 32; ++i) { const int kk = 2 * i + (lane >> 5); scr[kk * 33 + (lane & 31)] = W[(size_t)(k0 + kk) * N + n0 + (lane & 31)]; }
    asm volatile("s_waitcnt lgkmcnt(0)" ::: "memory");
    const int cl = n0 & 255, p0 = (n0 & ~255) + 128 * ((cl >> 5) & 1) + 32 * (cl >> 6);
    const int c = lane & 7;
#pragma unroll
    for (int j = 0; j < 4; ++j) { const int n = (lane >> 3) + 8 * j; const LAS float* s = scr + (8 * c) * 33 + n;
        u32x4 o; o.x = pk2(s[0 * 33], s[1 * 33]); o.y = pk2(s[2 * 33], s[3 * 33]); o.z = pk2(s[4 * 33], s[5 * 33]); o.w = pk2(s[6 * 33], s[7 * 33]);
        *(u32x4*)(WT + (size_t)(row_off + p0 + n) * 1024 + k0 + 8 * c) = o; }
    asm volatile("s_waitcnt lgkmcnt(0)" ::: "memory");
}
__device__ __forceinline__ void rms_row_to_bf16(const float* xrow, const float* g, bf16_t* orow, int lane) {
    const f32x4* xr = (const f32x4*)xrow + lane; const f32x4* gr = (const f32x4*)g + lane;
    f32x4 v[4]; float s = 0.f;
#pragma unroll
    for (int j = 0; j < 4; ++j) { v[j] = xr[64 * j]; s += (v[j].x * v[j].x + v[j].y * v[j].y) + (v[j].z * v[j].z + v[j].w * v[j].w); }
    const float rs = __builtin_amdgcn_rsqf(wave_sum(s) * (1.f / 1024.f) + EPSN);
    unsigned long long* o8 = (unsigned long long*)orow + lane;
#pragma unroll
    for (int j = 0; j < 4; ++j) { const f32x4 gg = gr[64 * j]; const f32x4 t = v[j] * gg * rs;
        o8[64 * j] = (unsigned long long)pk2(t.x, t.y) | ((unsigned long long)pk2(t.z, t.w) << 32); }
}

#define XB_TMO      128
#define XB_XCNT(j)  (256  + 64 * (j))
#define XB_XSUB(j)  (1280 + 64 * (j))
#define XB_XGEN(j)  (2304 + 64 * (j))
#define XB_TOP      3328
#define XB_TOPGEN   3392
#define XCD_BAR_WORDS 3456
#define XB_SPIN_CAP (1u << 18)

__device__ __forceinline__ unsigned xb_ld(unsigned* p)              { return __hip_atomic_load(p, __ATOMIC_RELAXED, __HIP_MEMORY_SCOPE_AGENT); }
__device__ __forceinline__ unsigned xb_add(unsigned* p, unsigned v) { return __hip_atomic_fetch_add(p, v, __ATOMIC_RELAXED, __HIP_MEMORY_SCOPE_AGENT); }
__device__ __forceinline__ unsigned xb_xcc_id() { return (unsigned)__builtin_amdgcn_s_getreg((3 << 11) | 20) & 0xFu; }
#define XB_SPIN(cond, bar) do { unsigned _sp = 0; while (cond) { __builtin_amdgcn_s_sleep(1); \
    if ((++_sp & 255u) == 0u) { if (xb_ld(&(bar)[XB_TMO])) break; if (_sp > XB_SPIN_CAP) { atomicAdd(&(bar)[XB_TMO], 1u); break; } } } } while (0)

struct XcdBarrier {
    unsigned* bar; unsigned x;
    volatile LAS unsigned* st;
};

__device__ __forceinline__ XcdBarrier xcd_barrier_post(unsigned* bar, volatile LAS unsigned* st) {
    XcdBarrier b; b.bar = bar; b.x = xb_xcc_id(); b.st = st;
    if (threadIdx.x == 0) (void)xb_add(&bar[XB_XCNT(b.x)], 1u);
    return b;
}
__device__ __forceinline__ void xcd_barrier_complete(unsigned* bar, unsigned x, unsigned& nloc, unsigned& nx) {
    const unsigned G = gridDim.x * gridDim.y * gridDim.z;
    unsigned sum, cnt, mine, sp = 0u;
    for (;;) {
        sum = 0u; cnt = 0u; mine = 0u;
#pragma unroll
        for (unsigned j = 0; j < 16; ++j) { const unsigned c = xb_ld(&bar[XB_XCNT(j)]); sum += c; cnt += (c > 0u) ? 1u : 0u; mine = (j == x) ? c : mine; }
        if (sum == G) break;
        __builtin_amdgcn_s_sleep(1);
        if ((++sp & 255u) == 0u) { if (xb_ld(&bar[XB_TMO])) break; if (sp > XB_SPIN_CAP) { atomicAdd(&bar[XB_TMO], 1u); break; } }
    }
    nloc = mine > 0u ? mine : 1u; nx = cnt > 0u ? cnt : 1u;
}

__device__ __forceinline__ void xcd_barrier(const XcdBarrier& b) {
    asm volatile("s_waitcnt vmcnt(0)" ::: "memory");
    __syncthreads();
    if (threadIdx.x == 0) {
        unsigned* bar = b.bar;
        __builtin_amdgcn_s_waitcnt(0);
        unsigned nloc = b.st[0], nx = b.st[1];
        if (nloc == 0u) { xcd_barrier_complete(bar, b.x, nloc, nx); b.st[0] = nloc; b.st[1] = nx; }
        const unsigned old = xb_add(&bar[XB_XSUB(b.x)], 1u);
        const unsigned gen = old / nloc;
        if (old + 1u == (gen + 1u) * nloc) {
            __builtin_amdgcn_fence(__ATOMIC_RELEASE, "agent");
            asm volatile("s_waitcnt vmcnt(0)" ::: "memory");
            const unsigned og = xb_add(&bar[XB_TOP], 1u);
            const unsigned tg = og / nx;
            if (og + 1u == (tg + 1u) * nx) xb_add(&bar[XB_TOPGEN], 1u);
            else XB_SPIN(xb_ld(&bar[XB_TOPGEN]) == tg, bar);
            __builtin_amdgcn_fence(__ATOMIC_ACQUIRE, "agent");
            xb_add(&bar[XB_XGEN(b.x)], 1u);
            asm volatile("s_waitcnt vmcnt(0)" ::: "memory");
        } else {
            XB_SPIN(xb_ld(&bar[XB_XGEN(b.x)]) == gen, bar);
            __builtin_amdgcn_fence(__ATOMIC_ACQUIRE, "agent");
            asm volatile("s_waitcnt vmcnt(0)" ::: "memory");
        }
    }
    __syncthreads();
}

__device__ __forceinline__ void grid_bar(unsigned* ctr, unsigned target) {
    asm volatile("s_waitcnt vmcnt(0) lgkmcnt(0)" ::: "memory");
    __syncthreads();
    if (threadIdx.x == 0) {
        __builtin_amdgcn_fence(__ATOMIC_RELEASE, "agent");
        asm volatile("s_waitcnt vmcnt(0)" ::: "memory");
        __hip_atomic_fetch_add(ctr, 1u, __ATOMIC_RELAXED, __HIP_MEMORY_SCOPE_AGENT);
        while (__hip_atomic_load(ctr, __ATOMIC_RELAXED, __HIP_MEMORY_SCOPE_AGENT) < target) __builtin_amdgcn_s_sleep(2);
        __builtin_amdgcn_fence(__ATOMIC_ACQUIRE, "agent");
        asm volatile("s_waitcnt vmcnt(0)" ::: "memory");
    }
    __syncthreads();
}

__device__ __forceinline__ void stagger(bool late, unsigned ticks) {
    if (late) { const unsigned long long t0 = __builtin_amdgcn_s_memrealtime(); while (__builtin_amdgcn_s_memrealtime() - t0 < ticks) __builtin_amdgcn_s_sleep(20); }
}

__global__ void __launch_bounds__(512, 2) fwd_kernel(Args args) {
    extern __shared__ __attribute__((aligned(16))) unsigned char lds[];
    const int tid = threadIdx.x, lane = tid & 63; const int wave = __builtin_amdgcn_readfirstlane(tid >> 6);
    const int G = gridDim.x, bx = blockIdx.x;
    const int vcu = (G % 8 == 0) ? (bx % 8) * (G / 8) + bx / 8 : bx;
    unsigned char* ws = args.ws; float* out = args.out;
    const int lo = args.ph_lo, hi = args.ph_hi;
#define IN(k) (lo <= (k) && (k) < hi)
#define GRID_SYNC(k) do { if (IN(k) && IN((k) + 1)) xcd_barrier(xbar); } while (0)
    XcdBarrier xbar; xbar.bar = (unsigned*)(ws + WS_BAR); xbar.x = 0; xbar.st = (volatile LAS unsigned*)((LAS unsigned char*)lds + LDS_BYTES - 16);
    if (hi - lo > 1) {
        if (bx == 0) for (int i = tid; i < XCD_BAR_WORDS; i += 512) __hip_atomic_store((unsigned*)(ws + WS_BAR) + i, 0u, __ATOMIC_RELAXED, __HIP_MEMORY_SCOPE_AGENT);
        if (tid < 2) xbar.st[tid] = 0u;
        cg::this_grid().sync();
        xbar = xcd_barrier_post((unsigned*)(ws + WS_BAR), xbar.st);
    }

    if (IN(0)) {
        bf16_t* const WIN = (bf16_t*)(ws + WS_WIN); bf16_t* const WOUT = (bf16_t*)(ws + WS_WOUT); f32x2v* const ROPE = (f32x2v*)(ws + WS_ROPE); bf16_t* const AALL = (bf16_t*)(ws + WS_AALL); bf16_t* const KS = (bf16_t*)(ws + WS_KS); bf16_t* const VS = (bf16_t*)(ws + WS_VS); bf16_t* const MKA = (bf16_t*)(ws + WS_MKA); bf16_t* const MVA = (bf16_t*)(ws + WS_MVA);
#ifndef SKIP_P0
        LAS float* scr = (LAS float*)((LAS unsigned char*)lds + wave * 16384);
        const int gw = vcu * 8 + wave, NGW = G * 8;
        constexpr int I_IN = 16 * 96, I_MEMW = 16 * 16, I_OUTW = 16 * 32;
        for (int it = gw; it < I_IN + I_MEMW + I_OUTW; it += NGW) {
            int r = it;
            if (r < I_IN) { p0_transpose_item(args.in[I_WIN], 3072, WIN, 0, scr, r, lane); continue; } r -= I_IN;
            if (r < I_MEMW) { p0_transpose_item(args.in[I_WMEM], 512, WIN, 3072, scr, r, lane); continue; } r -= I_MEMW;
            p0_transpose_item(args.in[I_WOUT], 1024, WOUT, 0, scr, r, lane);
        }
        for (int m = gw; m < AROWS; m += NGW) {
            const float* src = m < NTOK_P ? args.in[I_XP] + (size_t)m * 1024 : m < NTOK ? args.in[I_XS] + (size_t)(m - NTOK_P) * 1024 : args.in[I_MEM] + (size_t)(m - NTOK) * 1024;
            rms_row_to_bf16(src, m < NTOK ? args.in[I_NORMG] : args.in[I_MEMNG], AALL + (size_t)m * 1024, lane);
        }
        for (int m = gw; m < 2 * SBAT * PAST; m += NGW) {
            const int which = m >= SBAT * PAST, r = which ? m - SBAT * PAST : m, b = r >> 10, t = r & 1023;
            const f32x4* s = (const f32x4*)(args.in[which ? I_CDV : I_CDK] + (size_t)r * 512) + 2 * lane; const f32x4 a = s[0], c = s[1];
            u32x4 o; o.x = pk2(a.x, a.y); o.y = pk2(a.z, a.w); o.z = pk2(c.x, c.y); o.w = pk2(c.z, c.w);
            *((u32x4*)((which ? VS : KS) + ((size_t)b * KSROWS + t) * 512) + lane) = o;
        }
        for (int m = gw; m < 2 * SBAT * 256; m += NGW) {
            const int which = m >= SBAT * 256, r = which ? m - SBAT * 256 : m;
            const f32x4 a = *((const f32x4*)(args.in[which ? I_CMV : I_CMK] + (size_t)r * 256) + lane);
            u32x2 o; o.x = pk2(a.x, a.y); o.y = pk2(a.z, a.w);
            *((u32x2*)((which ? MVA : MKA) + (size_t)(NMEMROW + r) * 256) + lane) = o;
        }
        if (vcu == 0 && tid < 256) { const int k = tid >> 6; const float* src = k == 0 ? args.in[I_GQ] : k == 1 ? args.in[I_GK] : k == 2 ? args.in[I_GMQ] : args.in[I_GMK];
            ((float*)(ws + WS_GAIN))[tid] = src[tid & 63]; }
        for (int idx = (vcu * 512 + tid); idx < SEQ * 8; idx += G * 512) {
            const int pos = idx >> 3, i = idx & 7; double f = args.inv2pi;
            for (int k = 0; k < i; ++k) f *= args.rope_r0;
            double rev = (double)pos * f; rev -= __builtin_rint(rev);
            const float fr = (float)rev; ROPE[idx] = (f32x2v){__builtin_amdgcn_cosf(fr), __builtin_amdgcn_sinf(fr)};
        }
#endif
        asm volatile("s_waitcnt vmcnt(0) lgkmcnt(0)" ::: "memory"); __syncthreads();
    }
    GRID_SYNC(0);

    if (IN(1)) {
        bf16_t* const WIN = (bf16_t*)(ws + WS_WIN); bf16_t* const AALL = (bf16_t*)(ws + WS_AALL);
#ifndef SKIP_P1

        {   const f32x2v* const ROPE = (const f32x2v*)(ws + WS_ROPE); LAS f32x2v* tr = (LAS f32x2v*)((LAS unsigned char*)lds + LDS_TR); LAS f32x2v* ta = (LAS f32x2v*)((LAS unsigned char*)lds + LDS_TA);
            for (int i = tid; i < 1024; i += 512) tr[i] = ROPE[i];
            ta[tid] = ROPE[(size_t)(tid >> 3) * 128 * 8 + (tid & 7)];
            if (tid < 256) ((LAS float*)((LAS unsigned char*)lds + LDS_GAIN))[tid] = ((const float*)(ws + WS_GAIN))[tid];
            asm volatile("s_waitcnt vmcnt(0) lgkmcnt(0)" ::: "memory"); __syncthreads(); }
        pg8::Gemm g{AALL, WIN, AROWS, 3584, 1024}; SchedIn S{G, bx};
        EpiIn E{ws, out, (LAS unsigned char*)lds};
        pg8::gemm_phase<EpiIn, SchedIn, true, true>((LAS unsigned char*)lds, g, S, E);
#ifdef REP_P1
        asm volatile("s_waitcnt vmcnt(0) lgkmcnt(0)" ::: "memory"); __syncthreads();
        pg8::gemm_phase<EpiIn, SchedIn, true, true>((LAS unsigned char*)lds, g, S, E);
#endif
#endif
        asm volatile("s_waitcnt vmcnt(0) lgkmcnt(0)" ::: "memory"); __syncthreads();
    }
    GRID_SYNC(1);

    if (IN(2)) {
        bf16_t* const QB = (bf16_t*)(ws + WS_QB); bf16_t* const KB = (bf16_t*)(ws + WS_KB); bf16_t* const VB = (bf16_t*)(ws + WS_VB); bf16_t* const KS = (bf16_t*)(ws + WS_KS); bf16_t* const VS = (bf16_t*)(ws + WS_VS); bf16_t* const MIX = (bf16_t*)(ws + WS_MIX); float* const LX = (float*)(ws + WS_LX); bf16_t* const MQ = (bf16_t*)(ws + WS_MQ); bf16_t* const MKA = (bf16_t*)(ws + WS_MKA); bf16_t* const MVA = (bf16_t*)(ws + WS_MVA); float* const HL = (float*)(ws + WS_HL); float* const AC = (float*)(ws + WS_AC); float* const SEGA = (float*)(ws + WS_SEGA); float* const SEGH = (float*)(ws + WS_SEGH);
        LAS float* wsf = (LAS float*)((LAS unsigned char*)lds + LDS_WSF) + wave * 64;
        float lam;
        { const float d1 = wave_sum(args.in[I_LQ1][lane] * args.in[I_LK1][lane]), d2 = wave_sum(args.in[I_LQ2][lane] * args.in[I_LK2][lane]); lam = expf(d1) - expf(d2) + LAMBDA_INIT; }
        const int r32 = lane & 31;
#ifndef SKIP_P2A
        const int qg = wave & 3, cw = wave >> 2;
        LAS float* xs = (LAS float*)lds + 16384 + qg * 4160;
        LAS float* xsm = (LAS float*)lds + 24576 + qg * 2112;
        for (int vv = vcu; vv < 256; vv += G) {
            const int xcd = vv >> 5, kk = vv & 31;
            { const int bh = xcd * 4, b = bh >> 2, h = bh & 3;
              att::attn_prologue<2, 128>(lds, (const unsigned char*)(KB + (size_t)b * SEQ * 512 + h * 128), (const unsigned char*)(VB + (size_t)b * SEQ * 512 + h * 128), 1024, 2 * kk + 2); }
#pragma nounroll
            for (int i = 0; i < 8; ++i) {
                const int bh = xcd * 4 + (i >> 1), b = bh >> 2, h = bh & 3;
                const int qb = (i & 1) ? 63 - kk : kk;
                const int tok0 = b * SEQ + qb * 128 + qg * 32;
                const unsigned char* const mk = (const unsigned char*)(MKA + (size_t)b * 256 * 256 + h * 64); const unsigned char* const mv = (const unsigned char*)(MVA + (size_t)b * 256 * 256 + h * 64);
                {   att::f32x16 O[4]; float l = 0.f;
#pragma unroll
                    for (int db = 0; db < 4; ++db) O[db] = att::f32x16{};
                    att::attn_loop<2, 128, true>(lds, QB + (size_t)(tok0 + r32) * 512 + h * 128, (const unsigned char*)(KB + (size_t)b * SEQ * 512 + h * 128), (const unsigned char*)(VB + (size_t)b * SEQ * 512 + h * 128),
                                           1024, 2 * qb + 2, 2, 0, 2 * qb + (qg >> 1), cw, O, l);
                    att::attn_prologue<1, 64>(lds, mk, mv, 512, 4);
                    att::diff_finish(O, l, cw, true, lam, wsf, xs, tok0, h, args.in[I_GSUB], MIX); }
                {   att::f32x16 O[2]; float l = 0.f; O[0] = att::f32x16{}; O[1] = att::f32x16{};
                    att::attn_loop<1, 64, true>(lds, MQ + (size_t)(tok0 + r32) * 256 + h * 64, mk, mv, 512, 4, 2, 2, cw, 0, O, l);
                    if (i < 7) { const int bh2 = xcd * 4 + ((i + 1) >> 1), b2 = bh2 >> 2, h2 = bh2 & 3, qb2 = ((i + 1) & 1) ? 63 - kk : kk;
                        att::attn_prologue<2, 128>(lds, (const unsigned char*)(KB + (size_t)b2 * SEQ * 512 + h2 * 128), (const unsigned char*)(VB + (size_t)b2 * SEQ * 512 + h2 * 128), 1024, 2 * qb2 + 2); }
                    att::mem_finish(O, l, cw, true, true, wsf, xsm, tok0, h, MIX); }
            }
        }
        for (int uu = vcu; uu < 128; uu += G) {
            const int b = uu >> 2, h = uu & 3, tok0 = NTOK_P + b * 32;
            {   att::f32x16 O[4]; float l = 0.f;
#pragma unroll
                for (int db = 0; db < 4; ++db) O[db] = att::f32x16{};
                att::attn_loop<2, 128>(lds, QB + (size_t)(tok0 + r32) * 512 + h * 128, (const unsigned char*)(KS + (size_t)b * KSROWS * 512 + h * 128), (const unsigned char*)(VS + (size_t)b * KSROWS * 512 + h * 128),
                                       1024, 17, 1, 1, qg, cw, O, l);
                att::tree_reduce4<4>(O, l, (LAS float*)lds, wave, lane);
                att::diff_finish(O, l, cw, qg == 0, lam, wsf, (LAS float*)lds, tok0, h, args.in[I_GSUB], MIX); }
            {   att::f32x16 O[2]; float l = 0.f; O[0] = att::f32x16{}; O[1] = att::f32x16{};
                att::attn_loop<1, 64>(lds, MQ + (size_t)(tok0 + r32) * 256 + h * 64, (const unsigned char*)(MKA + (size_t)(NB + b) * 256 * 256 + h * 64), (const unsigned char*)(MVA + (size_t)(NB + b) * 256 * 256 + h * 64),
                                      512, 4, 2, 1, cw == 0 ? qg : 7, 0, O, l);
                att::tree_reduce4<2>(O, l, (LAS float*)lds, wave, lane);
                att::mem_finish(O, l, 0, wave == 0, false, wsf, (LAS float*)lds, tok0, h, MIX); }
        }
#endif
#ifndef SKIP_P2L
        for (int uu = (G - 1 - vcu); uu < 640; uu += G) {
            const bool smp = uu >= 512; int b, n, row0, ntok, seg0;
            if (!smp) { b = uu >> 6; n = (uu >> 4) & 3; const int c = uu & 15; row0 = b * SEQ + c * 512; ntok = 512; seg0 = 8 * c; }
            else { const int r = uu - 512; b = r >> 2; n = r & 3; row0 = NTOK_P + b * 32; ntok = 32; seg0 = 0; }
            const int t0 = wave * 64, ch = n * 64 + lane;
            if (t0 < ntok) {
                const int ntw = (ntok - t0) < 64 ? (ntok - t0) : 64;
                const float* cw = args.in[I_CONVW]; const float cw0 = cw[ch], cw1 = cw[256 + ch], cw2 = cw[512 + ch], cw3 = cw[768 + ch], cb = args.in[I_CONVB][ch];
                float xm3, xm2, xm1;
                if (seg0 + wave > 0) { const float* p = LX + (size_t)(row0 + t0) * 256 + ch; xm3 = p[-3 * 256]; xm2 = p[-2 * 256]; xm1 = p[-256]; }
                else if (smp) { const float* p = args.in[I_SCONV] + (size_t)b * 3 * 256 + ch; xm3 = p[0]; xm2 = p[256]; xm1 = p[512]; }
                else { xm3 = 0.f; xm2 = 0.f; xm1 = 0.f; }
                LAS float* xc = (LAS float*)lds + wave * 4096;
                for (int tb = 0; tb < ntw; tb += 16) {
                    float xb[16];
#pragma unroll
                    for (int k = 0; k < 16; ++k) xb[k] = LX[(size_t)(row0 + t0 + tb + k) * 256 + ch];
#pragma unroll
                    for (int k = 0; k < 16; ++k) { const float x = xb[k]; xc[(tb + k) * 64 + lane] = cb + cw0 * xm3 + cw1 * xm2 + cw2 * xm1 + cw3 * x; xm3 = xm2; xm2 = xm1; xm1 = x; }
                }
                asm volatile("s_waitcnt lgkmcnt(0)" ::: "memory");
                f32x2v w2[64];
                { const float* pa = args.in[I_WA] + (size_t)n * 4096 + lane; const float* px = args.in[I_WX] + (size_t)n * 4096 + lane;
#pragma unroll
                  for (int i = 0; i < 64; ++i) w2[i] = (f32x2v){pa[i * 64], px[i * 64]}; }
                const float ba = args.in[I_BA][ch], bxx = args.in[I_BX][ch];
                const float sp = log1pf(expf(-args.in[I_LAMBDA][ch]));
                float hcur = smp ? args.in[I_SH][(size_t)b * 256 + ch] : 0.f, acur = 1.f;
                for (int t = 0; t < ntw; ++t) {
                    f32x2v g2 = {ba, bxx};
#pragma unroll
                    for (int i4 = 0; i4 < 16; ++i4) { const f32x4 xv = *(LAS const f32x4*)(xc + t * 64 + 4 * i4);
                        g2 = __builtin_elementwise_fma((f32x2v){xv.x, xv.x}, w2[4 * i4], g2); g2 = __builtin_elementwise_fma((f32x2v){xv.y, xv.y}, w2[4 * i4 + 1], g2);
                        g2 = __builtin_elementwise_fma((f32x2v){xv.z, xv.z}, w2[4 * i4 + 2], g2); g2 = __builtin_elementwise_fma((f32x2v){xv.w, xv.w}, w2[4 * i4 + 3], g2); }
                    const float xcj = xc[t * 64 + lane];
                    const float rg = sigmoidf_(g2.x), ig = sigmoidf_(g2.y);
                    const float la = -8.0f * rg * sp, a = fast_exp(la), y2 = 2.0f * la;
                    const float em = -y2 * (1.0f + y2 * (0.5f + y2 * (0.16666667f + y2 * (0.041666668f + y2 * 0.008333334f))));
                    const float bb = __builtin_amdgcn_sqrtf(em) * (ig * xcj);
                    hcur = a * hcur + bb; acur *= a;
                    const size_t row = (size_t)(row0 + t0 + t);
                    if (!smp) { HL[row * 256 + ch] = hcur; AC[row * 256 + ch] = acur; }
                    else { bf16_t* p = MIX + row * 1024 + 512 + ch; *p = (bf16_t)f2bf(hcur * bf2f(*p)); }
                }
                if (!smp) { const size_t si = ((size_t)b * 128 + seg0 + wave) * 256 + ch; SEGA[si] = acur; SEGH[si] = hcur; }
                else { out[O_HS + (size_t)b * 256 + ch] = hcur;
#pragma unroll
                    for (int k = 0; k < 3; ++k) out[O_CS + ((size_t)b * 3 + k) * 256 + ch] = LX[(size_t)(row0 + 29 + k) * 256 + ch]; }
            }
            asm volatile("s_waitcnt lgkmcnt(0)" ::: "memory"); __syncthreads();
        }
#endif
        asm volatile("s_waitcnt vmcnt(0) lgkmcnt(0)" ::: "memory"); __syncthreads();
    }
    GRID_SYNC(2);

    if (IN(3)) {
        bf16_t* const MIX = (bf16_t*)(ws + WS_MIX); float* const LX = (float*)(ws + WS_LX); float* const HL = (float*)(ws + WS_HL); float* const AC = (float*)(ws + WS_AC); float* const SEGA = (float*)(ws + WS_SEGA); float* const SEGH = (float*)(ws + WS_SEGH);
#ifndef SKIP_P3
        if (G >= 32 && vcu < 16) {
            bf16_t* const WOUT = (bf16_t*)(ws + WS_WOUT);
            pg8::Gemm g{MIX, WOUT, NTOK, 1024, 1024}; SchedOne S{NTOK_P / 256 + (vcu >> 2), vcu & 3};
            EpiOut E{args.in[I_XP], args.in[I_XS], out, (LAS unsigned char*)lds};
            pg8::gemm_phase<EpiOut, SchedOne, true, true>((LAS unsigned char*)lds, g, S, E);
        } else
        for (int uu = (G >= 32 ? vcu - 16 : vcu); uu < 256; uu += (G >= 32 ? G - 16 : G)) {
            const int b = uu >> 5, gI = uu & 31, ch = tid & 255, th = tid >> 8, s0 = 4 * gI + 2 * th;
            const float* sa = SEGA + (size_t)b * 128 * 256 + ch; const float* sh = SEGH + (size_t)b * 128 * 256 + ch;
            float H = 0.f;
            {   int s = 0;
                for (; s + 16 <= s0; s += 16) { float av[16], hv[16];
#pragma unroll
                    for (int k = 0; k < 16; ++k) { av[k] = sa[(s + k) * 256]; hv[k] = sh[(s + k) * 256]; }
#pragma unroll
                    for (int k = 0; k < 16; ++k) H = av[k] * H + hv[k]; }
                for (; s < s0; ++s) H = sa[s * 256] * H + sh[s * 256]; }
            for (int s = s0; s < s0 + 2; ++s) {
                const size_t rbase = (size_t)b * SEQ + 64 * s;
#pragma unroll 8
                for (int t = 0; t < 64; ++t) { const size_t row = rbase + t; const float hv = HL[row * 256 + ch] + AC[row * 256 + ch] * H;
                    bf16_t* p = MIX + row * 1024 + 512 + ch; *p = (bf16_t)f2bf(hv * bf2f(*p));
                    if (s == 127 && t == 63) out[O_HP + (size_t)b * 256 + ch] = hv; }
                H = sa[s * 256] * H + sh[s * 256];
            }
            if (gI == 31 && th == 0) {
#pragma unroll
                for (int k = 0; k < 3; ++k) out[O_CP + ((size_t)b * 3 + k) * 256 + ch] = LX[((size_t)b * SEQ + SEQ - 3 + k) * 256 + ch];
            }
        }
#endif
        asm volatile("s_waitcnt vmcnt(0) lgkmcnt(0)" ::: "memory"); __syncthreads();
    }
    GRID_SYNC(3);

    if (IN(4)) {
        bf16_t* const MIX = (bf16_t*)(ws + WS_MIX); bf16_t* const WOUT = (bf16_t*)(ws + WS_WOUT);
#ifndef SKIP_P4

        pg8::Gemm g{MIX, WOUT, NTOK, 1024, 1024}; SchedOut S{G, bx};
        EpiOut E{args.in[I_XP], args.in[I_XS], out, (LAS unsigned char*)lds};
        pg8::gemm_phase<EpiOut, SchedOut, true, true>((LAS unsigned char*)lds, g, S, E);
        if (G < 32) { asm volatile("s_waitcnt vmcnt(0) lgkmcnt(0)" ::: "memory"); __syncthreads();
            for (int k = bx; k < 16; k += G) { SchedOne S1{NTOK_P / 256 + (k >> 2), k & 3}; pg8::gemm_phase<EpiOut, SchedOne, true, true>((LAS unsigned char*)lds, g, S1, E); asm volatile("s_waitcnt vmcnt(0) lgkmcnt(0)" ::: "memory"); __syncthreads(); } }
#ifdef REP_P4
        asm volatile("s_waitcnt vmcnt(0) lgkmcnt(0)" ::: "memory"); __syncthreads();
        pg8::gemm_phase<EpiOut, SchedOut, true, true>((LAS unsigned char*)lds, g, S, E);
#endif
#endif
    }
#undef IN
#undef GRID_SYNC
}

extern "C" void kernel_launch(void* const* d_in, const int* in_sizes, int n_in, void* d_out, int out_size, void* d_ws, size_t ws_size, hipStream_t stream) {
    static int grid = 0;
    if (grid == 0) {
        if (n_in != 30 || (size_t)out_size != O_END || ws_size < WS_END) { fprintf(stderr, "kernel_launch: unexpected shapes (n_in %d out %d ws %zu)\n", n_in, out_size, ws_size); grid = -1; return; }
        int dev = 0, cus = 0, per_cu = 0;
        hipGetDevice(&dev); hipDeviceGetAttribute(&cus, hipDeviceAttributeMultiprocessorCount, dev);
        if (hipFuncSetAttribute((const void*)fwd_kernel, hipFuncAttributeMaxDynamicSharedMemorySize, LDS_BYTES) != hipSuccess) { fprintf(stderr, "kernel_launch: hipFuncSetAttribute failed\n"); grid = -1; return; }
        if (hipOccupancyMaxActiveBlocksPerMultiprocessor(&per_cu, (const void*)fwd_kernel, 512, LDS_BYTES) != hipSuccess || per_cu < 1) { fprintf(stderr, "kernel_launch: occupancy query says %d\n", per_cu); per_cu = 1; }
        (void)hipGetLastError();
        grid = cus;
    }
    if (grid < 0) return;
    Args a{};
    for (int i = 0; i < 30; ++i) a.in[i] = (const float*)d_in[i];
    a.out = (float*)d_out; a.ws = (unsigned char*)d_ws;
    a.rope_r0 = std::pow(500000.0, -1.0 / 8.0); a.inv2pi = 1.0 / (2.0 * M_PI);
#if MK_N_LAUNCHES == 1
    a.ph_lo = 0; a.ph_hi = 5;
    void* kargs[] = {&a};
    hipError_t e = hipLaunchCooperativeKernel((const void*)fwd_kernel, dim3(grid), dim3(512), kargs, LDS_BYTES, stream);
    if (e != hipSuccess) fprintf(stderr, "cooperative launch failed: %s (grid %d)\n", hipGetErrorString(e), grid);
#else
    for (int p = 0; p < 5; ++p) { a.ph_lo = p; a.ph_hi = p + 1; hipLaunchKernelGGL(fwd_kernel, dim3(grid), dim3(512), LDS_BYTES, stream, a); }
#endif
}
```

```cpp
#include <hip/hip_runtime.h>
#include <hip/hip_cooperative_groups.h>
#include <cstdio>
#include <cstdint>
#include <cmath>
namespace cg = cooperative_groups;
#ifndef MK_N_LAUNCHES
#define MK_N_LAUNCHES 1
#endif
namespace pg8 {
#define PG8_LAS __attribute__((address_space(3)))
typedef unsigned short bf16_t;
typedef short bf16x8 __attribute__((ext_vector_type(8)));
typedef float f32x4 __attribute__((ext_vector_type(4)));
typedef unsigned u32x4 __attribute__((ext_vector_type(4)));
constexpr int BM = 256, BK = 64, HALF = 128, HTB = HALF * BK * 2  , STAGE_BYTES = 8 * HTB, NXCD = 8, WGM = 8;

__host__ __device__ __forceinline__ int lds_byte(int r, int c) { const int st = (r >> 4) * 2 + (c >> 5), rr = r & 15, cc = c & 31, ob = rr * 64 + cc * 2; return st * 1024 + (ob ^ (((ob >> 9) & 1) << 5)); }
__host__ __device__ __forceinline__ void stage_rc(int b, int& R, int& C) { const int st = b / 1024, sb = b % 1024, swz = sb ^ (((sb >> 9) & 1) << 5); R = (st >> 1) * 16 + swz / 64; C = (st & 1) * 32 + (swz % 64) / 2; }
__host__ __device__ __forceinline__ int perm32(int rho) { const int n = rho >> 4, i = rho & 15; return 8 * (i >> 2) + 4 * n + (i & 3); }

struct Unit { int pm, pn; };
struct Gemm { const bf16_t* A; const bf16_t* Bt; int M, N, K; };

struct StaticOrder {
    int nM, nN, nwg, G, c;
    __host__ __device__ void init(int M, int N, int G_, int c_) { nM = M / BM; nN = N / BM; nwg = nM * nN; G = G_; c = c_; }
    __host__ __device__ bool next(int i, Unit& u) const {
        const long L = (long)i * G + c; if (L >= nwg) return false;
        int wgid = (int)L; { const int q = nwg / NXCD, r = nwg % NXCD, xcd = wgid % NXCD, off = wgid / NXCD; wgid = (xcd < r ? xcd * (q + 1) : r * (q + 1) + (xcd - r) * q) + off; }
        const int nig = WGM * nN, gid = wgid / nig, fm = gid * WGM, gsz = (nM - fm) < WGM ? (nM - fm) : WGM;
        u.pm = fm + ((wgid % nig) % gsz); u.pn = (wgid % nig) / gsz; return true;
    }
    __device__ __forceinline__ void a_ready(const Unit&) const {}
    __device__ __forceinline__ void done(const Unit&) const {}
};

__device__ __forceinline__ unsigned cvt_pk_bf16(float lo, float hi) { unsigned r; asm volatile("v_cvt_pk_bf16_f32 %0, %1, %2" : "=v"(r) : "v"(lo), "v"(hi)); return r; }
typedef float f32x2 __attribute__((ext_vector_type(2)));
template <class Epi, class Sched, bool ALIGN_EPI = false, bool SP2 = false>
__device__ __forceinline__ void gemm_phase(PG8_LAS unsigned char* lds, const Gemm g, const Sched& S, const Epi& E) {
    const int tid = threadIdx.x, wid = __builtin_amdgcn_readfirstlane(tid >> 6), lane = tid & 63, wr = wid >> 2, wc = wid & 3, fr = lane & 15, fq = lane >> 4;
    const int K = g.K, nt = K / BK;
    unsigned voffA[2], voffB[2];
#pragma unroll
    for (int i = 0; i < 2; ++i) { int R, C; stage_rc(tid * 16 + i * 8192, R, C); const int Rb = Epi::PERM ? ((R & ~31) + perm32(R & 31)) : R;
        voffA[i] = (unsigned)(R * K + C) * 2u; voffB[i] = (unsigned)(Rb * K + C) * 2u; }
    const size_t kstep = (size_t)(BK * 2);
    const size_t hstep = (size_t)HALF * K * 2;
    const size_t tstep = 2 * hstep;
    const unsigned ldsw = (unsigned)wid * 1024u;
    const int aoff = lds_byte(wr * 64 + fr, fq * 8), boff = lds_byte(wc * 32 + fr, fq * 8);
#define PG8_SA(b, h) (((b) * 2 + (h)) * HTB)
#define PG8_SB(b, h) ((4 + (b) * 2 + (h)) * HTB)
#define PG8_STAGE(bufoff, gbase, voff) do { _Pragma("unroll") for (int _i = 0; _i < 2; ++_i) \
        __builtin_amdgcn_global_load_lds((const unsigned*)((const char*)(gbase) + (voff)[_i]), (PG8_LAS unsigned*)(lds + (bufoff) + ldsw + _i * 8192), 16, 0, 0); } while (0)
#define PG8_LDA(dst, b, h) do { _Pragma("unroll") for (int m = 0; m < 4; ++m) _Pragma("unroll") for (int k = 0; k < 2; ++k) dst[m][k] = *(const PG8_LAS bf16x8*)(lds + PG8_SA(b, h) + aoff + m * 2048 + k * 1024); } while (0)
#define PG8_LDB(dst, b, h) do { _Pragma("unroll") for (int n = 0; n < 2; ++n) _Pragma("unroll") for (int k = 0; k < 2; ++k) dst[n][k] = *(const PG8_LAS bf16x8*)(lds + PG8_SB(b, h) + boff + n * 2048 + k * 1024); } while (0)
#define PG8_MMA(ai, bj, At, Bt) do { __builtin_amdgcn_s_setprio(1); _Pragma("unroll") for (int m = 0; m < 4; ++m) _Pragma("unroll") for (int n = 0; n < 2; ++n) _Pragma("unroll") for (int k = 0; k < 2; ++k) \
        acc[ai][bj][m][n] = __builtin_amdgcn_mfma_f32_16x16x32_bf16(Bt[n][k], At[m][k], acc[ai][bj][m][n], 0, 0, 0); __builtin_amdgcn_s_setprio(0); } while (0)
#define PG8_WAIT_V(n) asm volatile("s_waitcnt vmcnt(" #n ")" ::: "memory")
#define PG8_WAIT_L(n) asm volatile("s_waitcnt lgkmcnt(" #n ")" ::: "memory")
#define PG8_BAR __builtin_amdgcn_s_barrier()
#define PG8_SCHED __builtin_amdgcn_sched_barrier(0)
    Unit cur, nxt; int ui = 0;
    if (!S.next(0, cur)) return;
    f32x4 acc[2][2][4][2];
    E.init(acc, cur, wr, wc, fr, fq);
    bf16x8 At[4][2], B0[2][2], B1[2][2];
    const char* cA = (const char*)g.A + (size_t)cur.pm * tstep; const char* cB = (const char*)g.Bt + (size_t)cur.pn * tstep;
    S.a_ready(cur);
    if constexpr (SP2) {
        PG8_STAGE(PG8_SB(0, 0), cB, voffB); PG8_STAGE(PG8_SB(0, 1), cB + hstep, voffB); PG8_STAGE(PG8_SA(0, 0), cA, voffA); PG8_STAGE(PG8_SA(0, 1), cA + hstep, voffA);
        if (wr == 1) PG8_BAR;
        PG8_WAIT_V(2); PG8_BAR;
        PG8_STAGE(PG8_SB(1, 0), cB + kstep, voffB); PG8_STAGE(PG8_SA(1, 0), cA + kstep, voffA); PG8_STAGE(PG8_SB(1, 1), cB + hstep + kstep, voffB);
        PG8_WAIT_V(6); PG8_BAR;
    } else {
        PG8_STAGE(PG8_SB(0, 0), cB, voffB); PG8_STAGE(PG8_SA(0, 0), cA, voffA); PG8_STAGE(PG8_SB(0, 1), cB + hstep, voffB); PG8_STAGE(PG8_SA(0, 1), cA + hstep, voffA);
        if (wr == 1) PG8_BAR;
        PG8_WAIT_V(4); PG8_BAR;
        PG8_STAGE(PG8_SB(1, 0), cB + kstep, voffB); PG8_STAGE(PG8_SA(1, 0), cA + kstep, voffA); PG8_STAGE(PG8_SB(1, 1), cB + hstep + kstep, voffB);
        PG8_WAIT_V(6); PG8_BAR;
    }
    for (;;) {
        const bool has_next = S.next(ui + 1, nxt);
        const char* nA = has_next ? (const char*)g.A + (size_t)nxt.pm * tstep : cA; const char* nB = has_next ? (const char*)g.Bt + (size_t)nxt.pn * tstep : cB;
        for (int t = 0; t < nt; t += 2) {
            const bool last = (t == nt - 2);
            const char* a1 = cA + (size_t)(t + 1) * kstep;
            const char* a2 = last ? nA : cA + (size_t)(t + 2) * kstep; const char* b2 = last ? nB : cB + (size_t)(t + 2) * kstep;
            const char* a3 = a2 + kstep; const char* b3 = b2 + kstep;
            if (last && has_next) S.a_ready(nxt);
            if constexpr (SP2) {
            PG8_LDB(B0, 0, 0); PG8_LDB(B1, 0, 1); PG8_SCHED; PG8_LDA(At, 0, 0); PG8_STAGE(PG8_SA(1, 1), a1 + hstep, voffA);
            PG8_WAIT_V(8); PG8_WAIT_L(0); PG8_BAR; PG8_MMA(0, 0, At, B0); PG8_MMA(0, 1, At, B1); PG8_BAR; PG8_SCHED;
            PG8_LDA(At, 0, 1); PG8_STAGE(PG8_SB(0, 0), b2, voffB); PG8_STAGE(PG8_SB(0, 1), b2 + hstep, voffB); PG8_STAGE(PG8_SA(0, 0), a2, voffA);
            PG8_WAIT_V(8); PG8_WAIT_L(0); PG8_BAR; PG8_MMA(1, 0, At, B0); PG8_MMA(1, 1, At, B1); PG8_BAR; PG8_SCHED;
            PG8_LDB(B0, 1, 0); PG8_LDB(B1, 1, 1); PG8_SCHED; PG8_LDA(At, 1, 0); PG8_STAGE(PG8_SA(0, 1), a2 + hstep, voffA);
            PG8_WAIT_V(8); PG8_WAIT_L(0); PG8_BAR; PG8_MMA(0, 0, At, B0); PG8_MMA(0, 1, At, B1); PG8_BAR; PG8_SCHED;
            PG8_LDA(At, 1, 1); PG8_STAGE(PG8_SB(1, 0), b3, voffB); PG8_STAGE(PG8_SB(1, 1), b3 + hstep, voffB); PG8_STAGE(PG8_SA(1, 0), a3, voffA);
            PG8_WAIT_V(8); PG8_WAIT_L(0); PG8_BAR; PG8_MMA(1, 0, At, B0); PG8_MMA(1, 1, At, B1); PG8_BAR; PG8_SCHED;
            } else {
            PG8_LDB(B0, 0, 0); PG8_SCHED; PG8_LDA(At, 0, 0); PG8_STAGE(PG8_SA(1, 1), a1 + hstep, voffA);
            PG8_WAIT_L(8); PG8_BAR; PG8_WAIT_L(0); PG8_MMA(0, 0, At, B0); PG8_BAR; PG8_SCHED;
            PG8_LDB(B1, 0, 1); PG8_STAGE(PG8_SB(0, 0), b2, voffB);
            PG8_BAR; PG8_WAIT_L(0); PG8_MMA(0, 1, At, B1); PG8_BAR;
            PG8_LDA(At, 0, 1); PG8_STAGE(PG8_SA(0, 0), a2, voffA);
            PG8_BAR; PG8_WAIT_L(0); PG8_MMA(1, 0, At, B0); PG8_BAR; PG8_SCHED;
            PG8_STAGE(PG8_SB(0, 1), b2 + hstep, voffB);
            PG8_WAIT_V(6); PG8_BAR; PG8_MMA(1, 1, At, B1); PG8_BAR;
            PG8_LDB(B0, 1, 0); PG8_SCHED; PG8_LDA(At, 1, 0); PG8_STAGE(PG8_SA(0, 1), a2 + hstep, voffA);
            PG8_WAIT_L(8); PG8_BAR; PG8_WAIT_L(0); PG8_MMA(0, 0, At, B0); PG8_BAR; PG8_SCHED;
            PG8_LDB(B1, 1, 1); PG8_STAGE(PG8_SB(1, 0), b3, voffB);
            PG8_BAR; PG8_WAIT_L(0); PG8_MMA(0, 1, At, B1); PG8_BAR;
            PG8_LDA(At, 1, 1); PG8_STAGE(PG8_SA(1, 0), a3, voffA);
            PG8_BAR; PG8_WAIT_L(0); PG8_MMA(1, 0, At, B0); PG8_BAR; PG8_SCHED;
            PG8_STAGE(PG8_SB(1, 1), b3 + hstep, voffB);
            PG8_WAIT_V(6); PG8_BAR; PG8_MMA(1, 1, At, B1); PG8_BAR;
            }
        }
        if constexpr (ALIGN_EPI) { if (wr == 0) PG8_BAR; }
        if constexpr (!Epi::AFTER_DRAIN) { E(acc, cur, wr, wc, fr, fq); S.done(cur); }
        if (!has_next) break;
        E.init(acc, nxt, wr, wc, fr, fq);
        cur = nxt; cA = nA; cB = nB; ++ui;
        if constexpr (ALIGN_EPI) { if (wr == 1) PG8_BAR; }
    }
    PG8_WAIT_V(0);
    if constexpr (!ALIGN_EPI) { if (wr == 0) PG8_BAR; }
    PG8_BAR;
    if constexpr (Epi::AFTER_DRAIN) { E.fused(acc, cur, wr, wc, fr, fq, lds, wid, lane); S.done(cur); }
#undef PG8_SA
#undef PG8_SB
#undef PG8_STAGE
#undef PG8_LDA
#undef PG8_LDB
#undef PG8_MMA
#undef PG8_WAIT_V
#undef PG8_WAIT_L
#undef PG8_BAR
#undef PG8_SCHED
}
}

constexpr int NB = 8, SEQ = 8192, SBAT = 32, STOK = 32, PAST = 1024;
constexpr int NTOK_P = NB * SEQ;
constexpr int NTOK_S = SBAT * STOK;
constexpr int NTOK = NTOK_P + NTOK_S;
constexpr int NMEMROW = NB * 256;
constexpr int AROWS = NTOK + NMEMROW;
constexpr int KSROWS = 1088;
constexpr float EPSN = 1e-6f;
constexpr float C2 = 0.125f * 1.4426950408889634f;
constexpr float ONE_M_LINIT = 0.8f, LAMBDA_INIT = 0.2f;
constexpr size_t O_YP = 0;
constexpr size_t O_YS = O_YP + (size_t)NTOK_P * 1024;
constexpr size_t O_KP = O_YS + (size_t)NTOK_S * 1024;
constexpr size_t O_VP = O_KP + (size_t)NTOK_P * 512;
constexpr size_t O_MK = O_VP + (size_t)NTOK_P * 512;
constexpr size_t O_MV = O_MK + (size_t)NMEMROW * 256;
constexpr size_t O_CP = O_MV + (size_t)NMEMROW * 256;
constexpr size_t O_HP = O_CP + 8 * 3 * 256;
constexpr size_t O_KS = O_HP + 8 * 256;
constexpr size_t O_VS = O_KS + (size_t)NTOK_S * 512;
constexpr size_t O_CS = O_VS + (size_t)NTOK_S * 512;
constexpr size_t O_HS = O_CS + 32 * 3 * 256;
constexpr size_t O_END = O_HS + 32 * 256;
constexpr size_t MiB = 1u << 20;
constexpr size_t WS_WIN = 0, WS_WOUT = 8 * MiB, WS_ROPE = 10 * MiB, WS_GAIN = 10 * MiB + 768 * 1024, WS_BAR = 10 * MiB + 800 * 1024, WS_SEGA = 11 * MiB, WS_SEGH = 12 * MiB, WS_AALL = 16 * MiB,
                 WS_QB = 152 * MiB, WS_KB = 218 * MiB, WS_VB = 282 * MiB, WS_KS = 346 * MiB, WS_VS = 382 * MiB, WS_MIX = 418 * MiB,
                 WS_LX = 548 * MiB, WS_MQ = 614 * MiB, WS_MKA = 648 * MiB, WS_MVA = 654 * MiB, WS_HL = 660 * MiB, WS_AC = 724 * MiB, WS_END = 788 * MiB;
#ifndef STAG_P1
#define STAG_P1 2000u
#endif
#ifndef STAG_P4
#define STAG_P4 1400u
#endif
constexpr int LDS_BYTES = 163840;
constexpr int LDS_TR = 131072, LDS_TA = 139264, LDS_GAIN = 143360, LDS_STG = 144384;
constexpr int LDS_WSF = 133120;
constexpr int RED_SLOT_F = 33280 / 4;

typedef unsigned short bf16_t;
typedef float f32x4 __attribute__((ext_vector_type(4)));
typedef float f32x2v __attribute__((ext_vector_type(2)));
typedef unsigned u32x4 __attribute__((ext_vector_type(4)));
typedef unsigned u32x2 __attribute__((ext_vector_type(2)));
#define LAS __attribute__((address_space(3)))

__device__ __forceinline__ unsigned f2bf(float f) { unsigned u = __builtin_bit_cast(unsigned, f); return (u + 0x7fffu + ((u >> 16) & 1u)) >> 16; }
__device__ __forceinline__ unsigned pk2(float lo, float hi) { return f2bf(lo) | (f2bf(hi) << 16); }
__device__ __forceinline__ unsigned hw_pk2(float lo, float hi) { typedef float f2_t __attribute__((ext_vector_type(2))); typedef __bf16 b2_t __attribute__((ext_vector_type(2)));
    f2_t v = {lo, hi}; b2_t b = __builtin_convertvector(v, b2_t); return __builtin_bit_cast(unsigned, b); }
__device__ __forceinline__ float bf2f(unsigned short b) { return __builtin_bit_cast(float, (unsigned)b << 16); }
__device__ __forceinline__ float fast_exp(float x) { return __builtin_amdgcn_exp2f(x * 1.4426950408889634f); }
__device__ __forceinline__ float sigmoidf_(float x) { return __builtin_amdgcn_rcpf(1.0f + fast_exp(-x)); }
__device__ __forceinline__ float siluf_(float x) { return x * sigmoidf_(x); }
template <int M> __device__ __forceinline__ float lane_xor(float v) { return __builtin_bit_cast(float, __builtin_amdgcn_ds_swizzle(__builtin_bit_cast(int, v), (M << 10) | 0x1f)); }
__device__ __forceinline__ float sum_xor32(float v) { const unsigned u = __builtin_bit_cast(unsigned, v); auto rr = __builtin_amdgcn_permlane32_swap(u, u, false, false);
    return __builtin_bit_cast(float, (unsigned)rr[0]) + __builtin_bit_cast(float, (unsigned)rr[1]); }
__device__ __forceinline__ float sum32(float v) { v += lane_xor<1>(v); v += lane_xor<2>(v); v += lane_xor<4>(v); v += lane_xor<8>(v); v += lane_xor<16>(v); return v; }
__device__ __forceinline__ float wave_sum(float v) { return sum_xor32(sum32(v)); }
__device__ __forceinline__ void st_bf16x8(bf16_t* p, const float (&v)[8]) {
    u32x4 w; w.x = hw_pk2(v[0], v[1]); w.y = hw_pk2(v[2], v[3]); w.z = hw_pk2(v[4], v[5]); w.w = hw_pk2(v[6], v[7]); *(u32x4*)p = w;
}
__device__ __forceinline__ void st_f32x8(float* p, const float (&v)[8]) {
    *(f32x4*)p = (f32x4){v[0], v[1], v[2], v[3]}; *(f32x4*)(p + 4) = (f32x4){v[4], v[5], v[6], v[7]};
}

__device__ __forceinline__ void stage_store_f32(LAS float* st, int fr, int fq, const float (&v)[8], float* gbase, size_t pitch) {
    *(LAS f32x4*)(st + fr * 36 + 8 * fq) = (f32x4){v[0], v[1], v[2], v[3]}; *(LAS f32x4*)(st + fr * 36 + 8 * fq + 4) = (f32x4){v[4], v[5], v[6], v[7]};
    asm volatile("s_waitcnt lgkmcnt(0)" ::: "memory");
    int lane = fr + 16 * fq; asm volatile("" : "+v"(lane));
    const int tr = lane >> 3, tc = 4 * (lane & 7);
    const f32x4 t0 = *(LAS const f32x4*)(st + tr * 36 + tc), t1 = *(LAS const f32x4*)(st + (8 + tr) * 36 + tc);
    asm volatile("s_waitcnt lgkmcnt(0)" ::: "memory");
    *(f32x4*)(gbase + (size_t)tr * pitch + tc) = t0; *(f32x4*)(gbase + (size_t)(8 + tr) * pitch + tc) = t1;
}

struct SchedIn {
    int G, c;
    __device__ bool next(int i, pg8::Unit& u) const {
        const long L = (long)i * G + c; constexpr int nM = NTOK / 256, nN = 12, nwg = nM * nN;
        if (L >= nwg + 16) return false;
        if (L >= nwg) { const int r = (int)L - nwg; u.pm = nM + (r >> 1); u.pn = 12 + (r & 1); return true; }
        int wgid = (int)L; { const int q = nwg / 8, xcd = wgid % 8, off = wgid / 8; wgid = xcd * q + off; }
        const int nig = 8 * nN, gid = wgid / nig, fm = gid * 8, gsz = (nM - fm) < 8 ? (nM - fm) : 8;
        u.pm = fm + ((wgid % nig) % gsz); u.pn = (wgid % nig) / gsz; return true;
    }
    __device__ __forceinline__ void a_ready(const pg8::Unit&) const {}
    __device__ __forceinline__ void done(const pg8::Unit&) const {}
};
struct SchedOut {
    int G, c;
    __device__ bool next(int i, pg8::Unit& u) const {
        const long L = (long)i * G + c; constexpr int nM = NTOK_P / 256, nN = 4, nwg = nM * nN;
        if (L >= nwg) return false;
        int wgid = (int)L; { const int q = nwg / 8, xcd = wgid % 8, off = wgid / 8; wgid = xcd * q + off; }
        const int nig = 8 * nN, gid = wgid / nig, fm = gid * 8, gsz = (nM - fm) < 8 ? (nM - fm) : 8;
        u.pm = fm + ((wgid % nig) % gsz); u.pn = (wgid % nig) / gsz; return true;
    }
    __device__ __forceinline__ void a_ready(const pg8::Unit&) const {}
    __device__ __forceinline__ void done(const pg8::Unit&) const {}
};

struct SchedOne {
    int pm, pn;
    __device__ bool next(int i, pg8::Unit& u) const { if (i > 0) return false; u.pm = pm; u.pn = pn; return true; }
    __device__ __forceinline__ void a_ready(const pg8::Unit&) const {}
    __device__ __forceinline__ void done(const pg8::Unit&) const {}
};
struct EpiIn {
    static constexpr bool PERM = true, AFTER_DRAIN = false;
    __device__ __forceinline__ void init(f32x4 (&acc)[2][2][4][2], const pg8::Unit&, int, int, int, int) const {
#pragma unroll
        for (int a = 0; a < 2; ++a)
#pragma unroll
            for (int b = 0; b < 2; ++b)
#pragma unroll
                for (int m = 0; m < 4; ++m)
#pragma unroll
                    for (int n = 0; n < 2; ++n) acc[a][b][m][n] = (f32x4){0.f, 0.f, 0.f, 0.f};
    }
    unsigned char* ws; float* out; LAS unsigned char* ldsb;
    __device__ __forceinline__ void operator()(const f32x4 (&acc)[2][2][4][2], const pg8::Unit& u, int wr, int wc, int fr, int fq) const {
        bf16_t* const Qb = (bf16_t*)(ws + WS_QB); bf16_t* const Kb = (bf16_t*)(ws + WS_KB); bf16_t* const Vb = (bf16_t*)(ws + WS_VB); bf16_t* const KS = (bf16_t*)(ws + WS_KS); bf16_t* const VS = (bf16_t*)(ws + WS_VS);
        bf16_t* const MIX = (bf16_t*)(ws + WS_MIX); bf16_t* const MQ = (bf16_t*)(ws + WS_MQ); bf16_t* const MKA = (bf16_t*)(ws + WS_MKA); bf16_t* const MVA = (bf16_t*)(ws + WS_MVA);
        float* const LX = (float*)(ws + WS_LX);
        const int pn = u.pn;
        LAS float* const stg = (LAS float*)(ldsb + LDS_STG) + (wr * 4 + wc) * 576;
        const int cl0 = 64 * wc + 8 * fq;
        const int rb = u.pm * 256 + wr * 64 + fr;
        LAS const float* g = nullptr;
        { LAS const float* const gains = (LAS const float*)(ldsb + LDS_GAIN); if (pn < 2) g = gains; else if (pn < 4) g = gains + 64; else if (pn == 10) g = gains + 128; else if (pn == 12) g = gains + 192; }
        float gv[2][8];
#pragma unroll
        for (int bj = 0; bj < 2; ++bj)
#pragma unroll
            for (int k = 0; k < 8; ++k) gv[bj][k] = g ? g[32 * bj + 8 * fq + k] : 1.f;
#pragma unroll
        for (int ai = 0; ai < 2; ++ai)
#pragma unroll
            for (int m = 0; m < 4; ++m) {
                const int row = rb + ai * 128 + m * 16;
                float v[2][8];
#pragma unroll
                for (int bj = 0; bj < 2; ++bj)
#pragma unroll
                    for (int n = 0; n < 2; ++n)
#pragma unroll
                        for (int e = 0; e < 4; ++e) v[bj][4 * n + e] = acc[ai][bj][m][n][e];
                if (g) {
                    float ss = 0.f;
#pragma unroll
                    for (int bj = 0; bj < 2; ++bj)
#pragma unroll
                        for (int k = 0; k < 8; ++k) ss += v[bj][k] * v[bj][k];
                    ss += lane_xor<16>(ss); ss = sum_xor32(ss);
                    const float rs = __builtin_amdgcn_rsqf(ss * (1.0f / 64.0f) + EPSN);
#pragma unroll
                    for (int bj = 0; bj < 2; ++bj)
#pragma unroll
                        for (int k = 0; k < 8; ++k) v[bj][k] *= rs * gv[bj][k];
                    if (pn < 4) {
                        const int pos = row < NTOK_P ? (row & (SEQ - 1)) : (PAST + (row & 31));
                        float pv[8];
#pragma unroll
                        for (int k = 0; k < 8; ++k) pv[k] = lane_xor<16>(v[0][k]);
                        if (fq < 2) {
                            LAS const f32x2v* tr = (LAS const f32x2v*)(ldsb + LDS_TR) + (pos & 127) * 8; LAS const f32x2v* ta = (LAS const f32x2v*)(ldsb + LDS_TA) + (pos >> 7) * 8;
#pragma unroll
                            for (int k = 0; k < 8; ++k) { const f32x2v R = tr[k], A = ta[k]; const float cc = A.x * R.x - A.y * R.y, sn = A.y * R.x + A.x * R.y;
                                v[0][k] = fq == 0 ? (v[0][k] * cc - pv[k] * sn) : (v[0][k] * cc + pv[k] * sn); }
                        }
                    }
                }
                if (pn < 2) {
#pragma unroll
                    for (int bj = 0; bj < 2; ++bj) { float o[8];
#pragma unroll
                        for (int k = 0; k < 8; ++k) o[k] = v[bj][k] * C2;
                        st_bf16x8(Qb + (size_t)row * 512 + 256 * pn + cl0 + 32 * bj, o); }
                } else if (pn < 6) {
                    const bool isk = pn < 4; const int col = 256 * (pn - (isk ? 2 : 4)) + cl0;
                    float* of; bf16_t* ob;
                    if (row < NTOK_P) { of = out + (isk ? O_KP : O_VP) + (size_t)row * 512 + col; ob = (isk ? Kb : Vb) + (size_t)row * 512 + col; }
                    else { const int rs_ = row - NTOK_P; of = out + (isk ? O_KS : O_VS) + (size_t)rs_ * 512 + col;
                           ob = (isk ? KS : VS) + ((size_t)(rs_ >> 5) * KSROWS + PAST + (rs_ & 31)) * 512 + col; }
                    float* const gb = of - (size_t)fr * 512 - 8 * fq;
#pragma unroll
                    for (int bj = 0; bj < 2; ++bj) { stage_store_f32(stg, fr, fq, v[bj], gb + 32 * bj, 512); st_bf16x8(ob + 32 * bj, v[bj]); }
                } else if (pn == 8) {
                    float* const gb = LX + (size_t)(row - fr) * 256 + 64 * wc;
#pragma unroll
                    for (int bj = 0; bj < 2; ++bj) stage_store_f32(stg, fr, fq, v[bj], gb + 32 * bj, 256);
                } else if (pn == 10) {
#pragma unroll
                    for (int bj = 0; bj < 2; ++bj) { float o[8];
#pragma unroll
                        for (int k = 0; k < 8; ++k) o[k] = v[bj][k] * C2;
                        st_bf16x8(MQ + (size_t)row * 256 + cl0 + 32 * bj, o); }
                } else if (pn >= 12) {
                    const int rm = row - NTOK;
#pragma unroll
                    for (int bj = 0; bj < 2; ++bj) { st_f32x8(out + (pn == 12 ? O_MK : O_MV) + (size_t)rm * 256 + cl0 + 32 * bj, v[bj]);
                        st_bf16x8((pn == 12 ? MKA : MVA) + (size_t)rm * 256 + cl0 + 32 * bj, v[bj]); }
                } else {
                    const int colb = pn == 6 ? 0 : pn == 7 ? 256 : pn == 9 ? 512 : 768;
#pragma unroll
                    for (int bj = 0; bj < 2; ++bj) { float o[8];
#pragma unroll
                        for (int k = 0; k < 8; ++k) o[k] = siluf_(v[bj][k]);
                        st_bf16x8(MIX + (size_t)row * 1024 + colb + cl0 + 32 * bj, o); }
                }
            }
    }
};
struct EpiOut {
    static constexpr bool PERM = true, AFTER_DRAIN = false;
    const float *xp, *xs; float* out; LAS unsigned char* ldsb;
    __device__ __forceinline__ void init(f32x4 (&acc)[2][2][4][2], const pg8::Unit& u, int wr, int wc, int fr, int fq) const {
        const int lane = fr + 16 * fq; LAS float* st = (LAS float*)(ldsb + LDS_TR) + (wr * 4 + wc) * 576;
        const int tr = lane >> 3, tc = 4 * (lane & 7);
#pragma unroll
        for (int ai = 0; ai < 2; ++ai)
#pragma unroll
            for (int m = 0; m < 4; ++m)
#pragma unroll
                for (int bj = 0; bj < 2; ++bj) {
                    int trr = tr; asm volatile("" : "+v"(trr));
                    const int row0 = u.pm * 256 + ai * 128 + wr * 64 + m * 16, col = 256 * u.pn + 64 * wc + 32 * bj + tc;
#pragma unroll
                    for (int j2 = 0; j2 < 2; ++j2) { const int row = row0 + 8 * j2 + trr;
                        acc[ai][bj][m][j2] = *(const f32x4*)((row < NTOK_P ? xp + (size_t)row * 1024 : xs + (size_t)(row - NTOK_P) * 1024) + col); }
                }
#pragma unroll
        for (int ai = 0; ai < 2; ++ai)
#pragma unroll
            for (int m = 0; m < 4; ++m)
#pragma unroll
                for (int bj = 0; bj < 2; ++bj) {
#pragma unroll
                    for (int j2 = 0; j2 < 2; ++j2) *(LAS f32x4*)(st + (8 * j2 + tr) * 36 + tc) = acc[ai][bj][m][j2];
                    asm volatile("s_waitcnt lgkmcnt(0)" ::: "memory");
#pragma unroll
                    for (int n = 0; n < 2; ++n) acc[ai][bj][m][n] = *(LAS const f32x4*)(st + fr * 36 + 8 * fq + 4 * n);
                    asm volatile("s_waitcnt lgkmcnt(0)" ::: "memory");
                }
    }
    __device__ __forceinline__ void operator()(const f32x4 (&acc)[2][2][4][2], const pg8::Unit& u, int wr, int wc, int fr, int fq) const {
        const int lane = fr + 16 * fq; LAS float* st = (LAS float*)(ldsb + LDS_TR) + (wr * 4 + wc) * 576;
        const int tr = lane >> 3, tc = 4 * (lane & 7);
#pragma unroll
        for (int ai = 0; ai < 2; ++ai)
#pragma unroll
            for (int m = 0; m < 4; ++m)
#pragma unroll
                for (int bj = 0; bj < 2; ++bj) {
#pragma unroll
                    for (int n = 0; n < 2; ++n) *(LAS f32x4*)(st + fr * 36 + 8 * fq + 4 * n) = acc[ai][bj][m][n];
                    asm volatile("s_waitcnt lgkmcnt(0)" ::: "memory");
                    int trr = tr; asm volatile("" : "+v"(trr));
                    const int row0 = u.pm * 256 + ai * 128 + wr * 64 + m * 16, col = 256 * u.pn + 64 * wc + 32 * bj + tc;
                    f32x4 t[2];
#pragma unroll
                    for (int j2 = 0; j2 < 2; ++j2) t[j2] = *(LAS const f32x4*)(st + (8 * j2 + tr) * 36 + tc);
                    asm volatile("s_waitcnt lgkmcnt(0)" ::: "memory");
#pragma unroll
                    for (int j2 = 0; j2 < 2; ++j2) *(f32x4*)(out + (size_t)(row0 + 8 * j2 + trr) * 1024 + col) = t[j2];
                }
    }
};

namespace att {
typedef short bf16x8 __attribute__((ext_vector_type(8)));
typedef short s16x4 __attribute__((ext_vector_type(4)));
typedef float f32x16 __attribute__((ext_vector_type(16)));
typedef float f32x2_t __attribute__((ext_vector_type(2)));
typedef __bf16 bf16x2_t __attribute__((ext_vector_type(2)));
__device__ __forceinline__ unsigned cvtpk(float lo, float hi) { f32x2_t v = {lo, hi}; bf16x2_t b = __builtin_convertvector(v, bf16x2_t); return __builtin_bit_cast(unsigned, b); }
__device__ __forceinline__ void glds16(const void* gsrc, unsigned lds_dst) { unsigned keep;
    asm volatile("s_mov_b32 %0, m0\n\ts_mov_b32 m0, %2\n\ts_nop 0\n\tglobal_load_lds_dwordx4 %1, off\n\ts_mov_b32 m0, %0" : "=&s"(keep) : "v"(gsrc), "s"(lds_dst) : "memory"); }
#define ATT_WAIT_BAR() asm volatile("s_waitcnt vmcnt(0) lgkmcnt(0)\n\ts_barrier" ::: "memory")
#ifndef ATT_PRIO
#define ATT_PRIO(x) do {} while (0)
#endif
#define ATT_LBAR() asm volatile("s_waitcnt lgkmcnt(0)\n\ts_barrier" ::: "memory")
__device__ __forceinline__ s16x4 vtr(LAS const unsigned char* p) { typedef short v4i16_t __attribute__((ext_vector_type(4)));
    return __builtin_bit_cast(s16x4, __builtin_amdgcn_ds_read_tr16_b64_v4i16((LAS v4i16_t*)p)); }
__device__ __forceinline__ int crow(int r, int hh) { return (r & 3) + 8 * (r >> 2) + 4 * hh; }

template <int NC, int DV>
__device__ __forceinline__ void attn_loop(unsigned char* ldsg, const bf16_t* Qrow, const unsigned char* Kg, const unsigned char* Vg, int kvstride, int NT, int last_nh, int mode, int wpar, int c,
                                          f32x16 (&O)[DV / 32], float& l) {
    constexpr int KROW = NC * 128, VROW = DV * 2, KT = 64 * KROW, VT = 64 * VROW, BUF = KT + VT, KPW = KT / 8192, VPW = VT / 8192, PPW = KPW + VPW;
    const int tid = threadIdx.x, lane = tid & 63, r32 = lane & 31, hh = lane >> 5; const int w = __builtin_amdgcn_readfirstlane(tid >> 6);
    LAS const unsigned char* lds3 = (LAS const unsigned char*)ldsg; const unsigned lds0 = (unsigned)(uintptr_t)ldsg;
    unsigned ksrc[KPW], vsrc[VPW];
#pragma unroll
    for (int i = 0; i < KPW; ++i) { const int pos = 64 * (KPW * w + i) + lane; constexpr int CPR = KROW / 16; const int row = pos / CPR, cp = pos % CPR;
        const int cc = cp ^ (KROW == 256 ? (row & 15) : ((row >> 1) & 7)); ksrc[i] = (unsigned)(row * kvstride + cc * 16); }
#pragma unroll
    for (int i = 0; i < VPW; ++i) { const int pos = 64 * (VPW * w + i) + lane; constexpr int CPR = VROW / 16; const int row = pos / CPR, cp = pos % CPR;
        const int cc = cp ^ (VROW == 256 ? 4 * (row & 3) : 4 * ((row >> 1) & 1)); vsrc[i] = (unsigned)(row * kvstride + cc * 16); }
#define ATT_ISSUE(j) do { const size_t tb_ = (size_t)(j) * 64 * (size_t)kvstride; const unsigned sb_ = lds0 + ((j) & 3) * BUF; \
        _Pragma("unroll") for (int i_ = 0; i_ < KPW; ++i_) glds16(Kg + tb_ + ksrc[i_], (unsigned)__builtin_amdgcn_readfirstlane(sb_ + 1024 * (KPW * w + i_))); \
        _Pragma("unroll") for (int i_ = 0; i_ < VPW; ++i_) glds16(Vg + tb_ + vsrc[i_], (unsigned)__builtin_amdgcn_readfirstlane(sb_ + KT + 1024 * (VPW * w + i_))); } while (0)
    bf16x8 q[4];
#pragma unroll
    for (int ks = 0; ks < 4; ++ks) q[ks] = *(const bf16x8*)(Qrow + c * 64 + ks * 16 + hh * 8);
    ATT_ISSUE(0); if (NT > 1) ATT_ISSUE(1); if (NT > 2) ATT_ISSUE(2);
    asm volatile("" : "+v"(q[0]), "+v"(q[1]), "+v"(q[2]), "+v"(q[3]) :: "memory");
    const int kx = KROW == 256 ? (r32 & 15) : ((r32 >> 1) & 7);
    const int kb = r32 * KROW + ((hh ^ (kx & 1)) << 4), kxh = (kx & ~1) << 4, cb = c << 7;
    const int L = lane & 15, gp = (lane >> 4) & 1, sw = VROW == 256 ? ((L >> 2) & 3) : ((L >> 3) & 1);
    int vo[DV / 32];
#pragma unroll
    for (int db = 0; db < DV / 32; ++db) vo[db] = (4 * hh + (L >> 2)) * VROW + ((((db ^ sw) << 2) + 2 * gp + ((L & 3) >> 1)) << 4) + 8 * (L & 1);
#pragma nounroll
    for (int j = 0; j < NT; ++j) {
        {   const int rem = NT - 1 - j;
            if (rem >= 2) { if constexpr (PPW == 4) asm volatile("s_waitcnt vmcnt(8) lgkmcnt(0)\n\ts_barrier" ::: "memory"); else asm volatile("s_waitcnt vmcnt(4) lgkmcnt(0)\n\ts_barrier" ::: "memory"); }
            else if (rem == 1) { if constexpr (PPW == 4) asm volatile("s_waitcnt vmcnt(4) lgkmcnt(0)\n\ts_barrier" ::: "memory"); else asm volatile("s_waitcnt vmcnt(2) lgkmcnt(0)\n\ts_barrier" ::: "memory"); }
            else asm volatile("s_waitcnt vmcnt(0) lgkmcnt(0)\n\ts_barrier" ::: "memory"); }
        if (j + 3 < NT) ATT_ISSUE(j + 3);
        const bool active = mode == 0 ? (j <= wpar) : mode == 1 ? ((j & 3) == wpar) : ((j >> 1) == wpar);
        if (active) {
            const int nh = (j == NT - 1) ? last_nh : 2;
            LAS const unsigned char* Kt = lds3 + (j & 3) * BUF; LAS const unsigned char* Vt = Kt + KT;
#pragma unroll
            for (int kh = 0; kh < 2; ++kh) {
                if (kh < nh) {
                    f32x16 X = {};
                    ATT_PRIO(1);
#pragma unroll
                    for (int ks = 0; ks < 4; ++ks) {
                        const int co = kb + ((cb + (ks << 5)) ^ kxh) + kh * 32 * KROW;
                        const bf16x8 a0 = *(LAS const bf16x8*)(Kt + co);
                        X = __builtin_amdgcn_mfma_f32_32x32x16_bf16(a0, q[ks], X, 0, 0, 0);
                    }
                    ATT_PRIO(0);
                    float s = 0.f; u32x4 pk[2];
#pragma unroll
                    for (int r = 0; r < 16; ++r) { X[r] = __builtin_amdgcn_exp2f(X[r]); s += X[r]; }
#pragma unroll
                    for (int s2 = 0; s2 < 2; ++s2) pk[s2] = (u32x4){cvtpk(X[8 * s2], X[8 * s2 + 1]), cvtpk(X[8 * s2 + 2], X[8 * s2 + 3]), cvtpk(X[8 * s2 + 4], X[8 * s2 + 5]), cvtpk(X[8 * s2 + 6], X[8 * s2 + 7])};
                    l += s;
                    ATT_PRIO(1);
#pragma unroll
                    for (int s2 = 0; s2 < 2; ++s2) {
                        const bf16x8 pa = __builtin_bit_cast(bf16x8, pk[s2]);
#pragma unroll
                        for (int db = 0; db < DV / 32; ++db) {
                            const s16x4 lo = vtr(Vt + vo[db] + (32 * kh + 16 * s2) * VROW), hi = vtr(Vt + vo[db] + (32 * kh + 16 * s2 + 8) * VROW);
                            const bf16x8 vb = (bf16x8){lo[0], lo[1], lo[2], lo[3], hi[0], hi[1], hi[2], hi[3]};
                            O[db] = __builtin_amdgcn_mfma_f32_32x32x16_bf16(pa, vb, O[db], 0, 0, 0);
                        }
                    }
                    ATT_PRIO(0);
                }
            }
        }
    }
    ATT_WAIT_BAR();
#undef ATT_ISSUE
}

template <int NDB>
__device__ __forceinline__ void tree_reduce4(f32x16 (&O)[NDB], float& l, LAS float* red, int w, int lane) {
    constexpr int SLOTF = (NDB * 16 + 1) * 64; const int grp = w >> 2, idx = w & 3;
#pragma unroll
    for (int step = 2; step >= 1; step >>= 1) {
        if (idx >= step && idx < 2 * step) { LAS float* s = red + (grp * 2 + idx - step) * SLOTF + lane;
#pragma unroll
            for (int db = 0; db < NDB; ++db) {
#pragma unroll
                for (int r = 0; r < 16; ++r) s[64 * (db * 16 + r)] = O[db][r];
                asm volatile("" ::: "memory"); }
            s[64 * NDB * 16] = l; }
        ATT_LBAR();
        if (idx < step) { LAS const float* s = red + (grp * 2 + idx) * SLOTF + lane;
#pragma unroll
            for (int db = 0; db < NDB; ++db) {
#pragma unroll
                for (int r = 0; r < 16; ++r) O[db][r] += s[64 * (db * 16 + r)];
                asm volatile("s_waitcnt lgkmcnt(0)" ::: "memory"); }
            l += s[64 * NDB * 16]; }
        ATT_LBAR();
    }
}
__device__ __forceinline__ void diff_finish(f32x16 (&O)[4], float l, int c, bool doit, float lam, LAS float* wsf, LAS float* xs, int tok0, int h, const float* gsub, bf16_t* MIX) {
    int lane = threadIdx.x & 63; asm volatile("" : "+v"(lane), "+v"(tok0));
    const int r32 = lane & 31, hh = lane >> 5;
    const float ls = sum_xor32(l);
    if (hh == 0) wsf[r32] = (c == 0 ? 1.0f : lam) / ls;
    asm volatile("s_waitcnt lgkmcnt(0)" ::: "memory");
    if (doit && c == 1) {
#pragma unroll
        for (int r = 0; r < 16; ++r) { const float a = wsf[crow(r, hh)];
#pragma unroll
            for (int db = 0; db < 4; ++db) xs[64 * (db * 16 + r) + lane] = O[db][r] * a; }
    }
    ATT_LBAR();
    if (doit && c == 0) {
        float gs[4];
#pragma unroll
        for (int db = 0; db < 4; ++db) gs[db] = gsub[32 * db + r32] * ONE_M_LINIT;
#pragma unroll
        for (int r0 = 0; r0 < 16; r0 += 8) {
            unsigned short gt[8][4];
#pragma unroll
            for (int r = 0; r < 8; ++r) { const bf16_t* p = MIX + (size_t)(tok0 + crow(r0 + r, hh)) * 1024 + h * 128 + r32;
#pragma unroll
                for (int db = 0; db < 4; ++db) gt[r][db] = p[32 * db]; }
#pragma unroll
            for (int r = 0; r < 8; ++r) {
                const int qr = crow(r0 + r, hh); const float a = wsf[qr];
                float o[4], ss = 0.f;
#pragma unroll
                for (int db = 0; db < 4; ++db) { o[db] = O[db][r0 + r] * a - xs[64 * (db * 16 + r0 + r) + lane]; ss += o[db] * o[db]; }
                ss = sum32(ss);
                const float rs = __builtin_amdgcn_rsqf(ss * (1.0f / 128.0f) + EPSN);
                bf16_t* p = MIX + (size_t)(tok0 + qr) * 1024 + h * 128 + r32;
#pragma unroll
                for (int db = 0; db < 4; ++db) p[32 * db] = (bf16_t)f2bf(o[db] * rs * gs[db] * bf2f(gt[r][db]));
            }
            asm volatile("" ::: "memory");
        }
    }
    ATT_LBAR();
}
__device__ __forceinline__ void mem_finish(f32x16 (&O)[2], float l, int part, bool doit, bool pair, LAS float* wsf, LAS float* xs, int tok0, int h, bf16_t* MIX) {
    int lane = threadIdx.x & 63; asm volatile("" : "+v"(lane), "+v"(tok0));
    const int r32 = lane & 31, hh = lane >> 5;
    const float ls = sum_xor32(l);
    if (doit && part == 1) {
#pragma unroll
        for (int db = 0; db < 2; ++db)
#pragma unroll
            for (int r = 0; r < 16; ++r) xs[64 * (db * 16 + r) + lane] = O[db][r];
        xs[64 * 32 + lane] = ls;
    }
    ATT_LBAR();
    if (doit && part == 0) {
        const float lt = ls + (pair ? xs[64 * 32 + lane] : 0.f);
        if (hh == 0) wsf[r32] = 1.0f / lt;
        asm volatile("s_waitcnt lgkmcnt(0)" ::: "memory");
        unsigned short gt[16][2];
#pragma unroll
        for (int r = 0; r < 16; ++r) { const bf16_t* p = MIX + (size_t)(tok0 + crow(r, hh)) * 1024 + 768 + h * 64 + r32; gt[r][0] = p[0]; gt[r][1] = p[32]; }
#pragma unroll
        for (int r = 0; r < 16; ++r) {
            const int qr = crow(r, hh); const float a = wsf[qr];
            bf16_t* p = MIX + (size_t)(tok0 + qr) * 1024 + 768 + h * 64 + r32;
#pragma unroll
            for (int db = 0; db < 2; ++db) p[32 * db] = (bf16_t)f2bf((O[db][r] + (pair ? xs[64 * (db * 16 + r) + lane] : 0.f)) * a * bf2f(gt[r][db]));
        }
    }
    ATT_LBAR();
}
}

struct Args { const float* in[30]; float* out; unsigned char* ws; double rope_r0; double inv2pi; int ph_lo, ph_hi; };
enum { I_XP = 0, I_XS, I_MEM, I_CDK, I_CDV, I_CMK, I_CMV, I_SCONV, I_SH, I_NORMG, I_WIN, I_GQ, I_GK, I_LQ1, I_LK1, I_LQ2, I_LK2, I_GSUB, I_CONVW, I_CONVB, I_WA, I_BA, I_WX, I_BX,
       I_LAMBDA, I_MEMNG, I_WMEM, I_GMQ, I_GMK, I_WOUT };

__device__ __forceinline__ void p0_transpose_item(const float* W, int N, bf16_t* WT, int row_off, LAS float* scr, int item, int lane) {
    const int nblk = N / 32, kb = item / nblk, nb = item % nblk, k0 = 64 * kb, n0 = 32 * nb;
#pragma unroll 8
    for (int i = 0; i < 32; ++i) { const int kk = 2 * i + (lane >> 5); scr[kk * 33 + (lane & 31)] = W[(size_t)(k0 + kk) * N + n0 + (lane & 31)]; }
    asm volatile("s_waitcnt lgkmcnt(0)" ::: "memory");
    const int cl = n0 & 255, p0 = (n0 & ~255) + 128 * ((cl >> 5) & 1) + 32 * (cl >> 6);
    const int c = lane & 7;
#pragma unroll
    for (int j = 0; j < 4; ++j) { const int n = (lane >> 3) + 8 * j; const LAS float* s = scr + (8 * c) * 33 + n;
        u32x4 o; o.x = pk2(s[0 * 33], s[1 * 33]); o.y = pk2(s[2 * 33], s[3 * 33]); o.z = pk2(s[4 * 33], s[5 * 33]); o.w = pk2(s[6 * 33], s[7 * 33]);
        *(u32x4*)(WT + (size_t)(row_off + p0 + n) * 1024 + k0 + 8 * c) = o; }
    asm volatile("s_waitcnt lgkmcnt(0)" ::: "memory");
}
__device__ __forceinline__ void rms_row_to_bf16(const float* xrow, const float* g, bf16_t* orow, int lane) {
    const f32x4* xr = (const f32x4*)xrow + lane; const f32x4* gr = (const f32x4*)g + lane;
    f32x4 v[4]; float s = 0.f;
#pragma unroll
    for (int j = 0; j < 4; ++j) { v[j] = xr[64 * j]; s += (v[j].x * v[j].x + v[j].y * v[j].y) + (v[j].z * v[j].z + v[j].w * v[j].w); }
    const float rs = __builtin_amdgcn_rsqf(wave_sum(s) * (1.f / 1024.f) + EPSN);
    unsigned long long* o8 = (unsigned long long*)orow + lane;
#pragma unroll
    for (int j = 0; j < 4; ++j) { const f32x4 gg = gr[64 * j]; const f32x4 t = v[j] * gg * rs;
        o8[64 * j] = (unsigned long long)pk2(t.x, t.y) | ((unsigned long long)pk2(t.z, t.w) << 32); }
}

#define XB_TMO      128
#define XB_XCNT(j)  (256  + 64 * (j))
#define XB_XSUB(j)  (1280 + 64 * (j))
#define XB_XGEN(j)  (2304 + 64 * (j))
#define XB_TOP      3328
#define XB_TOPGEN   3392
#define XCD_BAR_WORDS 3456
#define XB_SPIN_CAP (1u << 18)

__device__ __forceinline__ unsigned xb_ld(unsigned* p)              { return __hip_atomic_load(p, __ATOMIC_RELAXED, __HIP_MEMORY_SCOPE_AGENT); }
__device__ __forceinline__ unsigned xb_add(unsigned* p, unsigned v) { return __hip_atomic_fetch_add(p, v, __ATOMIC_RELAXED, __HIP_MEMORY_SCOPE_AGENT); }
__device__ __forceinline__ unsigned xb_xcc_id() { return (unsigned)__builtin_amdgcn_s_getreg((3 << 11) | 20) & 0xFu; }
#define XB_SPIN(cond, bar) do { unsigned _sp = 0; while (cond) { __builtin_amdgcn_s_sleep(1); \
    if ((++_sp & 255u) == 0u) { if (xb_ld(&(bar)[XB_TMO])) break; if (_sp > XB_SPIN_CAP) { atomicAdd(&(bar)[XB_TMO], 1u); break; } } } } while (0)

struct XcdBarrier {
    unsigned* bar; unsigned x;
    volatile LAS unsigned* st;
};

__device__ __forceinline__ XcdBarrier xcd_barrier_post(unsigned* bar, volatile LAS unsigned* st) {
    XcdBarrier b; b.bar = bar; b.x = xb_xcc_id(); b.st = st;
    if (threadIdx.x == 0) (void)xb_add(&bar[XB_XCNT(b.x)], 1u);
    return b;
}
__device__ __forceinline__ void xcd_barrier_complete(unsigned* bar, unsigned x, unsigned& nloc, unsigned& nx) {
    const unsigned G = gridDim.x * gridDim.y * gridDim.z;
    unsigned sum, cnt, mine, sp = 0u;
    for (;;) {
        sum = 0u; cnt = 0u; mine = 0u;
#pragma unroll
        for (unsigned j = 0; j < 16; ++j) { const unsigned c = xb_ld(&bar[XB_XCNT(j)]); sum += c; cnt += (c > 0u) ? 1u : 0u; mine = (j == x) ? c : mine; }
        if (sum == G) break;
        __builtin_amdgcn_s_sleep(1);
        if ((++sp & 255u) == 0u) { if (xb_ld(&bar[XB_TMO])) break; if (sp > XB_SPIN_CAP) { atomicAdd(&bar[XB_TMO], 1u); break; } }
    }
    nloc = mine > 0u ? mine : 1u; nx = cnt > 0u ? cnt : 1u;
}

__device__ __forceinline__ void xcd_barrier(const XcdBarrier& b) {
    asm volatile("s_waitcnt vmcnt(0)" ::: "memory");
    __syncthreads();
    if (threadIdx.x == 0) {
        unsigned* bar = b.bar;
        __builtin_amdgcn_s_waitcnt(0);
        unsigned nloc = b.st[0], nx = b.st[1];
        if (nloc == 0u) { xcd_barrier_complete(bar, b.x, nloc, nx); b.st[0] = nloc; b.st[1] = nx; }
        const unsigned old = xb_add(&bar[XB_XSUB(b.x)], 1u);
        const unsigned gen = old / nloc;
        if (old + 1u == (gen + 1u) * nloc) {
            __builtin_amdgcn_fence(__ATOMIC_RELEASE, "agent");
            asm volatile("s_waitcnt vmcnt(0)" ::: "memory");
            const unsigned og = xb_add(&bar[XB_TOP], 1u);
            const unsigned tg = og / nx;
            if (og + 1u == (tg + 1u) * nx) xb_add(&bar[XB_TOPGEN], 1u);
            else XB_SPIN(xb_ld(&bar[XB_TOPGEN]) == tg, bar);
            __builtin_amdgcn_fence(__ATOMIC_ACQUIRE, "agent");
            xb_add(&bar[XB_XGEN(b.x)], 1u);
            asm volatile("s_waitcnt vmcnt(0)" ::: "memory");
        } else {
            XB_SPIN(xb_ld(&bar[XB_XGEN(b.x)]) == gen, bar);
            __builtin_amdgcn_fence(__ATOMIC_ACQUIRE, "agent");
            asm volatile("s_waitcnt vmcnt(0)" ::: "memory");
        }
    }
    __syncthreads();
}

__device__ __forceinline__ void grid_bar(unsigned* ctr, unsigned target) {
    asm volatile("s_waitcnt vmcnt(0) lgkmcnt(0)" ::: "memory");
    __syncthreads();
    if (threadIdx.x == 0) {
        __builtin_amdgcn_fence(__ATOMIC_RELEASE, "agent");
        asm volatile("s_waitcnt vmcnt(0)" ::: "memory");
        __hip_atomic_fetch_add(ctr, 1u, __ATOMIC_RELAXED, __HIP_MEMORY_SCOPE_AGENT);
        while (__hip_atomic_load(ctr, __ATOMIC_RELAXED, __HIP_MEMORY_SCOPE_AGENT) < target) __builtin_amdgcn_s_sleep(2);
        __builtin_amdgcn_fence(__ATOMIC_ACQUIRE, "agent");
        asm volatile("s_waitcnt vmcnt(0)" ::: "memory");
    }
    __syncthreads();
}

__device__ __forceinline__ void stagger(bool late, unsigned ticks) {
    if (late) { const unsigned long long t0 = __builtin_amdgcn_s_memrealtime(); while (__builtin_amdgcn_s_memrealtime() - t0 < ticks) __builtin_amdgcn_s_sleep(20); }
}

__global__ void __launch_bounds__(512, 2) fwd_kernel(Args args) {
    extern __shared__ __attribute__((aligned(16))) unsigned char lds[];
    const int tid = threadIdx.x, lane = tid & 63; const int wave = __builtin_amdgcn_readfirstlane(tid >> 6);
    const int G = gridDim.x, bx = blockIdx.x;
    const int vcu = (G % 8 == 0) ? (bx % 8) * (G / 8) + bx / 8 : bx;
    unsigned char* ws = args.ws; float* out = args.out;
    const int lo = args.ph_lo, hi = args.ph_hi;
#define IN(k) (lo <= (k) && (k) < hi)
#define GRID_SYNC(k) do { if (IN(k) && IN((k) + 1)) xcd_barrier(xbar); } while (0)
    XcdBarrier xbar; xbar.bar = (unsigned*)(ws + WS_BAR); xbar.x = 0; xbar.st = (volatile LAS unsigned*)((LAS unsigned char*)lds + LDS_BYTES - 16);
    if (hi - lo > 1) {
        if (bx == 0) for (int i = tid; i < XCD_BAR_WORDS; i += 512) __hip_atomic_store((unsigned*)(ws + WS_BAR) + i, 0u, __ATOMIC_RELAXED, __HIP_MEMORY_SCOPE_AGENT);
        if (tid < 2) xbar.st[tid] = 0u;
        cg::this_grid().sync();
        xbar = xcd_barrier_post((unsigned*)(ws + WS_BAR), xbar.st);
    }

    if (IN(0)) {
        bf16_t* const WIN = (bf16_t*)(ws + WS_WIN); bf16_t* const WOUT = (bf16_t*)(ws + WS_WOUT); f32x2v* const ROPE = (f32x2v*)(ws + WS_ROPE); bf16_t* const AALL = (bf16_t*)(ws + WS_AALL); bf16_t* const KS = (bf16_t*)(ws + WS_KS); bf16_t* const VS = (bf16_t*)(ws + WS_VS); bf16_t* const MKA = (bf16_t*)(ws + WS_MKA); bf16_t* const MVA = (bf16_t*)(ws + WS_MVA);
#ifndef SKIP_P0
        LAS float* scr = (LAS float*)((LAS unsigned char*)lds + wave * 16384);
        const int gw = vcu * 8 + wave, NGW = G * 8;
        constexpr int I_IN = 16 * 96, I_MEMW = 16 * 16, I_OUTW = 16 * 32;
        for (int it = gw; it < I_IN + I_MEMW + I_OUTW; it += NGW) {
            int r = it;
            if (r < I_IN) { p0_transpose_item(args.in[I_WIN], 3072, WIN, 0, scr, r, lane); continue; } r -= I_IN;
            if (r < I_MEMW) { p0_transpose_item(args.in[I_WMEM], 512, WIN, 3072, scr, r, lane); continue; } r -= I_MEMW;
            p0_transpose_item(args.in[I_WOUT], 1024, WOUT, 0, scr, r, lane);
        }
        for (int m = gw; m < AROWS; m += NGW) {
            const float* src = m < NTOK_P ? args.in[I_XP] + (size_t)m * 1024 : m < NTOK ? args.in[I_XS] + (size_t)(m - NTOK_P) * 1024 : args.in[I_MEM] + (size_t)(m - NTOK) * 1024;
            rms_row_to_bf16(src, m < NTOK ? args.in[I_NORMG] : args.in[I_MEMNG], AALL + (size_t)m * 1024, lane);
        }
        for (int m = gw; m < 2 * SBAT * PAST; m += NGW) {
            const int which = m >= SBAT * PAST, r = which ? m - SBAT * PAST : m, b = r >> 10, t = r & 1023;
            const f32x4* s = (const f32x4*)(args.in[which ? I_CDV : I_CDK] + (size_t)r * 512) + 2 * lane; const f32x4 a = s[0], c = s[1];
            u32x4 o; o.x = pk2(a.x, a.y); o.y = pk2(a.z, a.w); o.z = pk2(c.x, c.y); o.w = pk2(c.z, c.w);
            *((u32x4*)((which ? VS : KS) + ((size_t)b * KSROWS + t) * 512) + lane) = o;
        }
        for (int m = gw; m < 2 * SBAT * 256; m += NGW) {
            const int which = m >= SBAT * 256, r = which ? m - SBAT * 256 : m;
            const f32x4 a = *((const f32x4*)(args.in[which ? I_CMV : I_CMK] + (size_t)r * 256) + lane);
            u32x2 o; o.x = pk2(a.x, a.y); o.y = pk2(a.z, a.w);
            *((u32x2*)((which ? MVA : MKA) + (size_t)(NMEMROW + r) * 256) + lane) = o;
        }
        if (vcu == 0 && tid < 256) { const int k = tid >> 6; const float* src = k == 0 ? args.in[I_GQ] : k == 1 ? args.in[I_GK] : k == 2 ? args.in[I_GMQ] : args.in[I_GMK];
            ((float*)(ws + WS_GAIN))[tid] = src[tid & 63]; }
        for (int idx = (vcu * 512 + tid); idx < SEQ * 8; idx += G * 512) {
            const int pos = idx >> 3, i = idx & 7; double f = args.inv2pi;
            for (int k = 0; k < i; ++k) f *= args.rope_r0;
            double rev = (double)pos * f; rev -= __builtin_rint(rev);
            const float fr = (float)rev; ROPE[idx] = (f32x2v){__builtin_amdgcn_cosf(fr), __builtin_amdgcn_sinf(fr)};
        }
#endif
        asm volatile("s_waitcnt vmcnt(0) lgkmcnt(0)" ::: "memory"); __syncthreads();
    }
    GRID_SYNC(0);

    if (IN(1)) {
        bf16_t* const WIN = (bf16_t*)(ws + WS_WIN); bf16_t* const AALL = (bf16_t*)(ws + WS_AALL);
#ifndef SKIP_P1

        {   const f32x2v* const ROPE = (const f32x2v*)(ws + WS_ROPE); LAS f32x2v* tr = (LAS f32x2v*)((LAS unsigned char*)lds + LDS_TR); LAS f32x2v* ta = (LAS f32x2v*)((LAS unsigned char*)lds + LDS_TA);
            for (int i = tid; i < 1024; i += 512) tr[i] = ROPE[i];
            ta[tid] = ROPE[(size_t)(tid >> 3) * 128 * 8 + (tid & 7)];
            if (tid < 256) ((LAS float*)((LAS unsigned char*)lds + LDS_GAIN))[tid] = ((const float*)(ws + WS_GAIN))[tid];
            asm volatile("s_waitcnt vmcnt(0) lgkmcnt(0)" ::: "memory"); __syncthreads(); }
        pg8::Gemm g{AALL, WIN, AROWS, 3584, 1024}; SchedIn S{G, bx};
        EpiIn E{ws, out, (LAS unsigned char*)lds};
        pg8::gemm_phase<EpiIn, SchedIn, true, true>((LAS unsigned char*)lds, g, S, E);
#ifdef REP_P1
        asm volatile("s_waitcnt vmcnt(0) lgkmcnt(0)" ::: "memory"); __syncthreads();
        pg8::gemm_phase<EpiIn, SchedIn, true, true>((LAS unsigned char*)lds, g, S, E);
#endif
#endif
        asm volatile("s_waitcnt vmcnt(0) lgkmcnt(0)" ::: "memory"); __syncthreads();
    }
    GRID_SYNC(1);

    if (IN(2)) {
        bf16_t* const QB = (bf16_t*)(ws + WS_QB); bf16_t* const KB = (bf16_t*)(ws + WS_KB); bf16_t* const VB = (bf16_t*)(ws + WS_VB); bf16_t* const KS = (bf16_t*)(ws + WS_KS); bf16_t* const VS = (bf16_t*)(ws + WS_VS); bf16_t* const MIX = (bf16_t*)(ws + WS_MIX); float* const LX = (float*)(ws + WS_LX); bf16_t* const MQ = (bf16_t*)(ws + WS_MQ); bf16_t* const MKA = (bf16_t*)(ws + WS_MKA); bf16_t* const MVA = (bf16_t*)(ws + WS_MVA); float* const HL = (float*)(ws + WS_HL); float* const AC = (float*)(ws + WS_AC); float* const SEGA = (float*)(ws + WS_SEGA); float* const SEGH = (float*)(ws + WS_SEGH);
        LAS float* wsf = (LAS float*)((LAS unsigned char*)lds + LDS_WSF) + wave * 64;
        float lam;
        { const float d1 = wave_sum(args.in[I_LQ1][lane] * args.in[I_LK1][lane]), d2 = wave_sum(args.in[I_LQ2][lane] * args.in[I_LK2][lane]); lam = expf(d1) - expf(d2) + LAMBDA_INIT; }
        const int r32 = lane & 31;
#ifndef SKIP_P2A
        const int qg = wave & 3, cw = wave >> 2;
        LAS float* xs = (LAS float*)lds + qg * 4160;
        for (int vv = vcu; vv < 256; vv += G) {
            const int xcd = vv >> 5, kk = vv & 31;
#pragma nounroll
            for (int i = 0; i < 8; ++i) {
                const int bh = xcd * 4 + (i >> 1), b = bh >> 2, h = bh & 3;
                const int qb = (i & 1) ? 63 - kk : kk;
                const int tok0 = b * SEQ + qb * 128 + qg * 32;
                {   att::f32x16 O[4]; float l = 0.f;
#pragma unroll
                    for (int db = 0; db < 4; ++db) O[db] = att::f32x16{};
                    att::attn_loop<2, 128>(lds, QB + (size_t)(tok0 + r32) * 512 + h * 128, (const unsigned char*)(KB + (size_t)b * SEQ * 512 + h * 128), (const unsigned char*)(VB + (size_t)b * SEQ * 512 + h * 128),
                                           1024, 2 * qb + 2, 2, 0, 2 * qb + (qg >> 1), cw, O, l);
#ifdef REP_ATT
                    att::attn_loop<2, 128>(lds, QB + (size_t)(tok0 + r32) * 512 + h * 128, (const unsigned char*)(KB + (size_t)b * SEQ * 512 + h * 128), (const unsigned char*)(VB + (size_t)b * SEQ * 512 + h * 128),
                                           1024, 2 * qb + 2, 2, 0, 2 * qb + (qg >> 1), cw, O, l);
#endif
                    att::diff_finish(O, l, cw, true, lam, wsf, xs, tok0, h, args.in[I_GSUB], MIX); }
                if (i & 1) {
                    const int tokm = b * SEQ + (cw ? 63 - kk : kk) * 128 + qg * 32;
                    att::f32x16 O[2]; float l = 0.f; O[0] = att::f32x16{}; O[1] = att::f32x16{};
                    att::attn_loop<1, 64>(lds, MQ + (size_t)(tokm + r32) * 256 + h * 64, (const unsigned char*)(MKA + (size_t)b * 256 * 256 + h * 64), (const unsigned char*)(MVA + (size_t)b * 256 * 256 + h * 64),
                                          512, 4, 2, 0, 4, 0, O, l);
                    att::mem_finish(O, l, 0, true, false, wsf, xs, tokm, h, MIX); }
            }
        }
        for (int uu = vcu; uu < 128; uu += G) {
            const int b = uu >> 2, h = uu & 3, tok0 = NTOK_P + b * 32;
            {   att::f32x16 O[4]; float l = 0.f;
#pragma unroll
                for (int db = 0; db < 4; ++db) O[db] = att::f32x16{};
                att::attn_loop<2, 128>(lds, QB + (size_t)(tok0 + r32) * 512 + h * 128, (const unsigned char*)(KS + (size_t)b * KSROWS * 512 + h * 128), (const unsigned char*)(VS + (size_t)b * KSROWS * 512 + h * 128),
                                       1024, 17, 1, 1, qg, cw, O, l);
                att::tree_reduce4<4>(O, l, (LAS float*)lds, wave, lane);
                att::diff_finish(O, l, cw, qg == 0, lam, wsf, (LAS float*)lds, tok0, h, args.in[I_GSUB], MIX); }
            {   att::f32x16 O[2]; float l = 0.f; O[0] = att::f32x16{}; O[1] = att::f32x16{};
                att::attn_loop<1, 64>(lds, MQ + (size_t)(tok0 + r32) * 256 + h * 64, (const unsigned char*)(MKA + (size_t)(NB + b) * 256 * 256 + h * 64), (const unsigned char*)(MVA + (size_t)(NB + b) * 256 * 256 + h * 64),
                                      512, 4, 2, 1, cw == 0 ? qg : 7, 0, O, l);
                att::tree_reduce4<2>(O, l, (LAS float*)lds, wave, lane);
                att::mem_finish(O, l, 0, wave == 0, false, wsf, (LAS float*)lds, tok0, h, MIX); }
        }
#endif
#ifndef SKIP_P2L
        for (int uu = (G - 1 - vcu); uu < 640; uu += G) {
            const bool smp = uu >= 512; int b, n, row0, ntok, seg0;
            if (!smp) { b = uu >> 6; n = (uu >> 4) & 3; const int c = uu & 15; row0 = b * SEQ + c * 512; ntok = 512; seg0 = 8 * c; }
            else { const int r = uu - 512; b = r >> 2; n = r & 3; row0 = NTOK_P + b * 32; ntok = 32; seg0 = 0; }
            const int t0 = wave * 64, ch = n * 64 + lane;
            if (t0 < ntok) {
                const int ntw = (ntok - t0) < 64 ? (ntok - t0) : 64;
                const float* cw = args.in[I_CONVW]; const float cw0 = cw[ch], cw1 = cw[256 + ch], cw2 = cw[512 + ch], cw3 = cw[768 + ch], cb = args.in[I_CONVB][ch];
                float xm3, xm2, xm1;
                if (seg0 + wave > 0) { const float* p = LX + (size_t)(row0 + t0) * 256 + ch; xm3 = p[-3 * 256]; xm2 = p[-2 * 256]; xm1 = p[-256]; }
                else if (smp) { const float* p = args.in[I_SCONV] + (size_t)b * 3 * 256 + ch; xm3 = p[0]; xm2 = p[256]; xm1 = p[512]; }
                else { xm3 = 0.f; xm2 = 0.f; xm1 = 0.f; }
                LAS float* xc = (LAS float*)lds + wave * 4096;
                for (int tb = 0; tb < ntw; tb += 16) {
                    float xb[16];
#pragma unroll
                    for (int k = 0; k < 16; ++k) xb[k] = LX[(size_t)(row0 + t0 + tb + k) * 256 + ch];
#pragma unroll
                    for (int k = 0; k < 16; ++k) { const float x = xb[k]; xc[(tb + k) * 64 + lane] = cb + cw0 * xm3 + cw1 * xm2 + cw2 * xm1 + cw3 * x; xm3 = xm2; xm2 = xm1; xm1 = x; }
                }
                asm volatile("s_waitcnt lgkmcnt(0)" ::: "memory");
                f32x2v w2[64];
                { const float* pa = args.in[I_WA] + (size_t)n * 4096 + lane; const float* px = args.in[I_WX] + (size_t)n * 4096 + lane;
#pragma unroll
                  for (int i = 0; i < 64; ++i) w2[i] = (f32x2v){pa[i * 64], px[i * 64]}; }
                const float ba = args.in[I_BA][ch], bxx = args.in[I_BX][ch];
                const float sp = log1pf(expf(-args.in[I_LAMBDA][ch]));
                float hcur = smp ? args.in[I_SH][(size_t)b * 256 + ch] : 0.f, acur = 1.f;
                for (int t = 0; t < ntw; ++t) {
                    f32x2v g2 = {ba, bxx};
#pragma unroll
                    for (int i4 = 0; i4 < 16; ++i4) { const f32x4 xv = *(LAS const f32x4*)(xc + t * 64 + 4 * i4);
                        g2 = __builtin_elementwise_fma((f32x2v){xv.x, xv.x}, w2[4 * i4], g2); g2 = __builtin_elementwise_fma((f32x2v){xv.y, xv.y}, w2[4 * i4 + 1], g2);
                        g2 = __builtin_elementwise_fma((f32x2v){xv.z, xv.z}, w2[4 * i4 + 2], g2); g2 = __builtin_elementwise_fma((f32x2v){xv.w, xv.w}, w2[4 * i4 + 3], g2); }
                    const float xcj = xc[t * 64 + lane];
                    const float rg = sigmoidf_(g2.x), ig = sigmoidf_(g2.y);
                    const float la = -8.0f * rg * sp, a = fast_exp(la), y2 = 2.0f * la;
                    const float em = -y2 * (1.0f + y2 * (0.5f + y2 * (0.16666667f + y2 * (0.041666668f + y2 * 0.008333334f))));
                    const float bb = __builtin_amdgcn_sqrtf(em) * (ig * xcj);
                    hcur = a * hcur + bb; acur *= a;
                    const size_t row = (size_t)(row0 + t0 + t);
                    if (!smp) { HL[row * 256 + ch] = hcur; AC[row * 256 + ch] = acur; }
                    else { bf16_t* p = MIX + row * 1024 + 512 + ch; *p = (bf16_t)f2bf(hcur * bf2f(*p)); }
                }
                if (!smp) { const size_t si = ((size_t)b * 128 + seg0 + wave) * 256 + ch; SEGA[si] = acur; SEGH[si] = hcur; }
                else { out[O_HS + (size_t)b * 256 + ch] = hcur;
#pragma unroll
                    for (int k = 0; k < 3; ++k) out[O_CS + ((size_t)b * 3 + k) * 256 + ch] = LX[(size_t)(row0 + 29 + k) * 256 + ch]; }
            }
            asm volatile("s_waitcnt lgkmcnt(0)" ::: "memory"); __syncthreads();
        }
#endif
        asm volatile("s_waitcnt vmcnt(0) lgkmcnt(0)" ::: "memory"); __syncthreads();
    }
    GRID_SYNC(2);

    if (IN(3)) {
        bf16_t* const MIX = (bf16_t*)(ws + WS_MIX); float* const LX = (float*)(ws + WS_LX); float* const HL = (float*)(ws + WS_HL); float* const AC = (float*)(ws + WS_AC); float* const SEGA = (float*)(ws + WS_SEGA); float* const SEGH = (float*)(ws + WS_SEGH);
#ifndef SKIP_P3
        if (G >= 32 && vcu < 16) {
            bf16_t* const WOUT = (bf16_t*)(ws + WS_WOUT);
            pg8::Gemm g{MIX, WOUT, NTOK, 1024, 1024}; SchedOne S{NTOK_P / 256 + (vcu >> 2), vcu & 3};
            EpiOut E{args.in[I_XP], args.in[I_XS], out, (LAS unsigned char*)lds};
            pg8::gemm_phase<EpiOut, SchedOne, true, true>((LAS unsigned char*)lds, g, S, E);
        } else
        for (int uu = (G >= 32 ? vcu - 16 : vcu); uu < 256; uu += (G >= 32 ? G - 16 : G)) {
            const int b = uu >> 5, gI = uu & 31, ch = tid & 255, th = tid >> 8, s0 = 4 * gI + 2 * th;
            const float* sa = SEGA + (size_t)b * 128 * 256 + ch; const float* sh = SEGH + (size_t)b * 128 * 256 + ch;
            float H = 0.f;
            {   int s = 0;
                for (; s + 16 <= s0; s += 16) { float av[16], hv[16];
#pragma unroll
                    for (int k = 0; k < 16; ++k) { av[k] = sa[(s + k) * 256]; hv[k] = sh[(s + k) * 256]; }
#pragma unroll
                    for (int k = 0; k < 16; ++k) H = av[k] * H + hv[k]; }
                for (; s < s0; ++s) H = sa[s * 256] * H + sh[s * 256]; }
            for (int s = s0; s < s0 + 2; ++s) {
                const size_t rbase = (size_t)b * SEQ + 64 * s;
#pragma unroll 8
                for (int t = 0; t < 64; ++t) { const size_t row = rbase + t; const float hv = HL[row * 256 + ch] + AC[row * 256 + ch] * H;
                    bf16_t* p = MIX + row * 1024 + 512 + ch; *p = (bf16_t)f2bf(hv * bf2f(*p));
                    if (s == 127 && t == 63) out[O_HP + (size_t)b * 256 + ch] = hv; }
                H = sa[s * 256] * H + sh[s * 256];
            }
            if (gI == 31 && th == 0) {
#pragma unroll
                for (int k = 0; k < 3; ++k) out[O_CP + ((size_t)b * 3 + k) * 256 + ch] = LX[((size_t)b * SEQ + SEQ - 3 + k) * 256 + ch];
            }
        }
#endif
        asm volatile("s_waitcnt vmcnt(0) lgkmcnt(0)" ::: "memory"); __syncthreads();
    }
    GRID_SYNC(3);

    if (IN(4)) {
        bf16_t* const MIX = (bf16_t*)(ws + WS_MIX); bf16_t* const WOUT = (bf16_t*)(ws + WS_WOUT);
#ifndef SKIP_P4

        pg8::Gemm g{MIX, WOUT, NTOK, 1024, 1024}; SchedOut S{G, bx};
        EpiOut E{args.in[I_XP], args.in[I_XS], out, (LAS unsigned char*)lds};
        pg8::gemm_phase<EpiOut, SchedOut, true, true>((LAS unsigned char*)lds, g, S, E);
        if (G < 32) { asm volatile("s_waitcnt vmcnt(0) lgkmcnt(0)" ::: "memory"); __syncthreads();
            for (int k = bx; k < 16; k += G) { SchedOne S1{NTOK_P / 256 + (k >> 2), k & 3}; pg8::gemm_phase<EpiOut, SchedOne, true, true>((LAS unsigned char*)lds, g, S1, E); asm volatile("s_waitcnt vmcnt(0) lgkmcnt(0)" ::: "memory"); __syncthreads(); } }
#ifdef REP_P4
        asm volatile("s_waitcnt vmcnt(0) lgkmcnt(0)" ::: "memory"); __syncthreads();
        pg8::gemm_phase<EpiOut, SchedOut, true, true>((LAS unsigned char*)lds, g, S, E);
#endif
#endif
    }
#undef IN
#undef GRID_SYNC
}

extern "C" void kernel_launch(void* const* d_in, const int* in_sizes, int n_in, void* d_out, int out_size, void* d_ws, size_t ws_size, hipStream_t stream) {
    static int grid = 0;
    if (grid == 0) {
        if (n_in != 30 || (size_t)out_size != O_END || ws_size < WS_END) { fprintf(stderr, "kernel_launch: unexpected shapes (n_in %d out %d ws %zu)\n", n_in, out_size, ws_size); grid = -1; return; }
        int dev = 0, cus = 0, per_cu = 0;
        hipGetDevice(&dev); hipDeviceGetAttribute(&cus, hipDeviceAttributeMultiprocessorCount, dev);
        if (hipFuncSetAttribute((const void*)fwd_kernel, hipFuncAttributeMaxDynamicSharedMemorySize, LDS_BYTES) != hipSuccess) { fprintf(stderr, "kernel_launch: hipFuncSetAttribute failed\n"); grid = -1; return; }
        if (hipOccupancyMaxActiveBlocksPerMultiprocessor(&per_cu, (const void*)fwd_kernel, 512, LDS_BYTES) != hipSuccess || per_cu < 1) { fprintf(stderr, "kernel_launch: occupancy query says %d\n", per_cu); per_cu = 1; }
        (void)hipGetLastError();
        grid = cus;
    }
    if (grid < 0) return;
    Args a{};
    for (int i = 0; i < 30; ++i) a.in[i] = (const float*)d_in[i];
    a.out = (float*)d_out; a.ws = (unsigned char*)d_ws;
    a.rope_r0 = std::pow(500000.0, -1.0 / 8.0); a.inv2pi = 1.0 / (2.0 * M_PI);
#if MK_N_LAUNCHES == 1
    a.ph_lo = 0; a.ph_hi = 5;
    void* kargs[] = {&a};
    hipError_t e = hipLaunchCooperativeKernel((const void*)fwd_kernel, dim3(grid), dim3(512), kargs, LDS_BYTES, stream);
    if (e != hipSuccess) fprintf(stderr, "cooperative launch failed: %s (grid %d)\n", hipGetErrorString(e), grid);
#else
    for (int p = 0; p < 5; ++p) { a.ph_lo = p; a.ph_hi = p + 1; hipLaunchKernelGGL(fwd_kernel, dim3(grid), dim3(512), LDS_BYTES, stream, a); }
#endif
}
```

```cpp
#include <hip/hip_runtime.h>
#include <hip/hip_cooperative_groups.h>
#include <cstdio>
#include <cstdint>
#include <cmath>
namespace cg = cooperative_groups;
#ifndef MK_N_LAUNCHES
#define MK_N_LAUNCHES 1
#endif
namespace pg8 {
#define PG8_LAS __attribute__((address_space(3)))
typedef unsigned short bf16_t;
typedef short bf16x8 __attribute__((ext_vector_type(8)));
typedef float f32x4 __attribute__((ext_vector_type(4)));
typedef unsigned u32x4 __attribute__((ext_vector_type(4)));
constexpr int BM = 256, BK = 64, HALF = 128, HTB = HALF * BK * 2  , STAGE_BYTES = 8 * HTB, NXCD = 8, WGM = 8;

__host__ __device__ __forceinline__ int lds_byte(int r, int c) { const int st = (r >> 4) * 2 + (c >> 5), rr = r & 15, cc = c & 31, ob = rr * 64 + cc * 2; return st * 1024 + (ob ^ (((ob >> 9) & 1) << 5)); }
__host__ __device__ __forceinline__ void stage_rc(int b, int& R, int& C) { const int st = b / 1024, sb = b % 1024, swz = sb ^ (((sb >> 9) & 1) << 5); R = (st >> 1) * 16 + swz / 64; C = (st & 1) * 32 + (swz % 64) / 2; }
__host__ __device__ __forceinline__ int perm32(int rho) { const int n = rho >> 4, i = rho & 15; return 8 * (i >> 2) + 4 * n + (i & 3); }

struct Unit { int pm, pn; };
struct Gemm { const bf16_t* A; const bf16_t* Bt; int M, N, K; };

struct StaticOrder {
    int nM, nN, nwg, G, c;
    __host__ __device__ void init(int M, int N, int G_, int c_) { nM = M / BM; nN = N / BM; nwg = nM * nN; G = G_; c = c_; }
    __host__ __device__ bool next(int i, Unit& u) const {
        const long L = (long)i * G + c; if (L >= nwg) return false;
        int wgid = (int)L; { const int q = nwg / NXCD, r = nwg % NXCD, xcd = wgid % NXCD, off = wgid / NXCD; wgid = (xcd < r ? xcd * (q + 1) : r * (q + 1) + (xcd - r) * q) + off; }
        const int nig = WGM * nN, gid = wgid / nig, fm = gid * WGM, gsz = (nM - fm) < WGM ? (nM - fm) : WGM;
        u.pm = fm + ((wgid % nig) % gsz); u.pn = (wgid % nig) / gsz; return true;
    }
    __device__ __forceinline__ void a_ready(const Unit&) const {}
    __device__ __forceinline__ void done(const Unit&) const {}
};

__device__ __forceinline__ unsigned cvt_pk_bf16(float lo, float hi) { unsigned r; asm volatile("v_cvt_pk_bf16_f32 %0, %1, %2" : "=v"(r) : "v"(lo), "v"(hi)); return r; }
typedef float f32x2 __attribute__((ext_vector_type(2)));
template <class Epi, class Sched, bool ALIGN_EPI = false, bool SP2 = false>
__device__ __forceinline__ void gemm_phase(PG8_LAS unsigned char* lds, const Gemm g, const Sched& S, const Epi& E) {
    const int tid = threadIdx.x, wid = __builtin_amdgcn_readfirstlane(tid >> 6), lane = tid & 63, wr = wid >> 2, wc = wid & 3, fr = lane & 15, fq = lane >> 4;
    const int K = g.K, nt = K / BK;
    unsigned voffA[2], voffB[2];
#pragma unroll
    for (int i = 0; i < 2; ++i) { int R, C; stage_rc(tid * 16 + i * 8192, R, C); const int Rb = Epi::PERM ? ((R & ~31) + perm32(R & 31)) : R;
        voffA[i] = (unsigned)(R * K + C) * 2u; voffB[i] = (unsigned)(Rb * K + C) * 2u; }
    const size_t kstep = (size_t)(BK * 2);
    const size_t hstep = (size_t)HALF * K * 2;
    const size_t tstep = 2 * hstep;
    const unsigned ldsw = (unsigned)wid * 1024u;
    const int aoff = lds_byte(wr * 64 + fr, fq * 8), boff = lds_byte(wc * 32 + fr, fq * 8);
#define PG8_SA(b, h) (((b) * 2 + (h)) * HTB)
#define PG8_SB(b, h) ((4 + (b) * 2 + (h)) * HTB)
#define PG8_STAGE(bufoff, gbase, voff) do { _Pragma("unroll") for (int _i = 0; _i < 2; ++_i) \
        __builtin_amdgcn_global_load_lds((const unsigned*)((const char*)(gbase) + (voff)[_i]), (PG8_LAS unsigned*)(lds + (bufoff) + ldsw + _i * 8192), 16, 0, 0); } while (0)
#define PG8_LDA(dst, b, h) do { _Pragma("unroll") for (int m = 0; m < 4; ++m) _Pragma("unroll") for (int k = 0; k < 2; ++k) dst[m][k] = *(const PG8_LAS bf16x8*)(lds + PG8_SA(b, h) + aoff + m * 2048 + k * 1024); } while (0)
#define PG8_LDB(dst, b, h) do { _Pragma("unroll") for (int n = 0; n < 2; ++n) _Pragma("unroll") for (int k = 0; k < 2; ++k) dst[n][k] = *(const PG8_LAS bf16x8*)(lds + PG8_SB(b, h) + boff + n * 2048 + k * 1024); } while (0)
#define PG8_MMA(ai, bj, At, Bt) do { __builtin_amdgcn_s_setprio(1); _Pragma("unroll") for (int m = 0; m < 4; ++m) _Pragma("unroll") for (int n = 0; n < 2; ++n) _Pragma("unroll") for (int k = 0; k < 2; ++k) \
        acc[ai][bj][m][n] = __builtin_amdgcn_mfma_f32_16x16x32_bf16(Bt[n][k], At[m][k], acc[ai][bj][m][n], 0, 0, 0); __builtin_amdgcn_s_setprio(0); } while (0)
#define PG8_WAIT_V(n) asm volatile("s_waitcnt vmcnt(" #n ")" ::: "memory")
#define PG8_WAIT_L(n) asm volatile("s_waitcnt lgkmcnt(" #n ")" ::: "memory")
#define PG8_BAR __builtin_amdgcn_s_barrier()
#define PG8_SCHED __builtin_amdgcn_sched_barrier(0)
    Unit cur, nxt; int ui = 0;
    if (!S.next(0, cur)) return;
    f32x4 acc[2][2][4][2];
    E.init(acc, cur, wr, wc, fr, fq);
    bf16x8 At[4][2], B0[2][2], B1[2][2];
    const char* cA = (const char*)g.A + (size_t)cur.pm * tstep; const char* cB = (const char*)g.Bt + (size_t)cur.pn * tstep;
    S.a_ready(cur);
    if constexpr (SP2) {
        PG8_STAGE(PG8_SB(0, 0), cB, voffB); PG8_STAGE(PG8_SB(0, 1), cB + hstep, voffB); PG8_STAGE(PG8_SA(0, 0), cA, voffA); PG8_STAGE(PG8_SA(0, 1), cA + hstep, voffA);
        if (wr == 1) PG8_BAR;
        PG8_WAIT_V(2); PG8_BAR;
        PG8_STAGE(PG8_SB(1, 0), cB + kstep, voffB); PG8_STAGE(PG8_SA(1, 0), cA + kstep, voffA); PG8_STAGE(PG8_SB(1, 1), cB + hstep + kstep, voffB);
        PG8_WAIT_V(6); PG8_BAR;
    } else {
        PG8_STAGE(PG8_SB(0, 0), cB, voffB); PG8_STAGE(PG8_SA(0, 0), cA, voffA); PG8_STAGE(PG8_SB(0, 1), cB + hstep, voffB); PG8_STAGE(PG8_SA(0, 1), cA + hstep, voffA);
        if (wr == 1) PG8_BAR;
        PG8_WAIT_V(4); PG8_BAR;
        PG8_STAGE(PG8_SB(1, 0), cB + kstep, voffB); PG8_STAGE(PG8_SA(1, 0), cA + kstep, voffA); PG8_STAGE(PG8_SB(1, 1), cB + hstep + kstep, voffB);
        PG8_WAIT_V(6); PG8_BAR;
    }
    for (;;) {
        const bool has_next = S.next(ui + 1, nxt);
        const char* nA = has_next ? (const char*)g.A + (size_t)nxt.pm * tstep : cA; const char* nB = has_next ? (const char*)g.Bt + (size_t)nxt.pn * tstep : cB;
        for (int t = 0; t < nt; t += 2) {
            const bool last = (t == nt - 2);
            const char* a1 = cA + (size_t)(t + 1) * kstep;
            const char* a2 = last ? nA : cA + (size_t)(t + 2) * kstep; const char* b2 = last ? nB : cB + (size_t)(t + 2) * kstep;
            const char* a3 = a2 + kstep; const char* b3 = b2 + kstep;
            if (last && has_next) S.a_ready(nxt);
            if constexpr (SP2) {
            PG8_LDB(B0, 0, 0); PG8_LDB(B1, 0, 1); PG8_SCHED; PG8_LDA(At, 0, 0); PG8_STAGE(PG8_SA(1, 1), a1 + hstep, voffA);
            PG8_WAIT_V(8); PG8_WAIT_L(0); PG8_BAR; PG8_MMA(0, 0, At, B0); PG8_MMA(0, 1, At, B1); PG8_BAR; PG8_SCHED;
            PG8_LDA(At, 0, 1); PG8_STAGE(PG8_SB(0, 0), b2, voffB); PG8_STAGE(PG8_SB(0, 1), b2 + hstep, voffB); PG8_STAGE(PG8_SA(0, 0), a2, voffA);
            PG8_WAIT_V(8); PG8_WAIT_L(0); PG8_BAR; PG8_MMA(1, 0, At, B0); PG8_MMA(1, 1, At, B1); PG8_BAR; PG8_SCHED;
            PG8_LDB(B0, 1, 0); PG8_LDB(B1, 1, 1); PG8_SCHED; PG8_LDA(At, 1, 0); PG8_STAGE(PG8_SA(0, 1), a2 + hstep, voffA);
            PG8_WAIT_V(8); PG8_WAIT_L(0); PG8_BAR; PG8_MMA(0, 0, At, B0); PG8_MMA(0, 1, At, B1); PG8_BAR; PG8_SCHED;
            PG8_LDA(At, 1, 1); PG8_STAGE(PG8_SB(1, 0), b3, voffB); PG8_STAGE(PG8_SB(1, 1), b3 + hstep, voffB); PG8_STAGE(PG8_SA(1, 0), a3, voffA);
            PG8_WAIT_V(8); PG8_WAIT_L(0); PG8_BAR; PG8_MMA(1, 0, At, B0); PG8_MMA(1, 1, At, B1); PG8_BAR; PG8_SCHED;
            } else {
            PG8_LDB(B0, 0, 0); PG8_SCHED; PG8_LDA(At, 0, 0); PG8_STAGE(PG8_SA(1, 1), a1 + hstep, voffA);
            PG8_WAIT_L(8); PG8_BAR; PG8_WAIT_L(0); PG8_MMA(0, 0, At, B0); PG8_BAR; PG8_SCHED;
            PG8_LDB(B1, 0, 1); PG8_STAGE(PG8_SB(0, 0), b2, voffB);
            PG8_BAR; PG8_WAIT_L(0); PG8_MMA(0, 1, At, B1); PG8_BAR;
            PG8_LDA(At, 0, 1); PG8_STAGE(PG8_SA(0, 0), a2, voffA);
            PG8_BAR; PG8_WAIT_L(0); PG8_MMA(1, 0, At, B0); PG8_BAR; PG8_SCHED;
            PG8_STAGE(PG8_SB(0, 1), b2 + hstep, voffB);
            PG8_WAIT_V(6); PG8_BAR; PG8_MMA(1, 1, At, B1); PG8_BAR;
            PG8_LDB(B0, 1, 0); PG8_SCHED; PG8_LDA(At, 1, 0); PG8_STAGE(PG8_SA(0, 1), a2 + hstep, voffA);
            PG8_WAIT_L(8); PG8_BAR; PG8_WAIT_L(0); PG8_MMA(0, 0, At, B0); PG8_BAR; PG8_SCHED;
            PG8_LDB(B1, 1, 1); PG8_STAGE(PG8_SB(1, 0), b3, voffB);
            PG8_BAR; PG8_WAIT_L(0); PG8_MMA(0, 1, At, B1); PG8_BAR;
            PG8_LDA(At, 1, 1); PG8_STAGE(PG8_SA(1, 0), a3, voffA);
            PG8_BAR; PG8_WAIT_L(0); PG8_MMA(1, 0, At, B0); PG8_BAR; PG8_SCHED;
            PG8_STAGE(PG8_SB(1, 1), b3 + hstep, voffB);
            PG8_WAIT_V(6); PG8_BAR; PG8_MMA(1, 1, At, B1); PG8_BAR;
            }
        }
        if constexpr (ALIGN_EPI) { if (wr == 0) PG8_BAR; }
        if constexpr (!Epi::AFTER_DRAIN) { E(acc, cur, wr, wc, fr, fq); S.done(cur); }
        if (!has_next) break;
        E.init(acc, nxt, wr, wc, fr, fq);
        cur = nxt; cA = nA; cB = nB; ++ui;
        if constexpr (ALIGN_EPI) { if (wr == 1) PG8_BAR; }
    }
    PG8_WAIT_V(0);
    if constexpr (!ALIGN_EPI) { if (wr == 0) PG8_BAR; }
    PG8_BAR;
    if constexpr (Epi::AFTER_DRAIN) { E.fused(acc, cur, wr, wc, fr, fq, lds, wid, lane); S.done(cur); }
#undef PG8_SA
#undef PG8_SB
#undef PG8_STAGE
#undef PG8_LDA
#undef PG8_LDB
#undef PG8_MMA
#undef PG8_WAIT_V
#undef PG8_WAIT_L
#undef PG8_BAR
#undef PG8_SCHED
}
}

constexpr int NB = 8, SEQ = 8192, SBAT = 32, STOK = 32, PAST = 1024;
constexpr int NTOK_P = NB * SEQ;
constexpr int NTOK_S = SBAT * STOK;
constexpr int NTOK = NTOK_P + NTOK_S;
constexpr int NMEMROW = NB * 256;
constexpr int AROWS = NTOK + NMEMROW;
constexpr int KSROWS = 1088;
constexpr float EPSN = 1e-6f;
constexpr float C2 = 0.125f * 1.4426950408889634f;
constexpr float ONE_M_LINIT = 0.8f, LAMBDA_INIT = 0.2f;
constexpr size_t O_YP = 0;
constexpr size_t O_YS = O_YP + (size_t)NTOK_P * 1024;
constexpr size_t O_KP = O_YS + (size_t)NTOK_S * 1024;
constexpr size_t O_VP = O_KP + (size_t)NTOK_P * 512;
constexpr size_t O_MK = O_VP + (size_t)NTOK_P * 512;
constexpr size_t O_MV = O_MK + (size_t)NMEMROW * 256;
constexpr size_t O_CP = O_MV + (size_t)NMEMROW * 256;
constexpr size_t O_HP = O_CP + 8 * 3 * 256;
constexpr size_t O_KS = O_HP + 8 * 256;
constexpr size_t O_VS = O_KS + (size_t)NTOK_S * 512;
constexpr size_t O_CS = O_VS + (size_t)NTOK_S * 512;
constexpr size_t O_HS = O_CS + 32 * 3 * 256;
constexpr size_t O_END = O_HS + 32 * 256;
constexpr size_t MiB = 1u << 20;
constexpr size_t WS_WIN = 0, WS_WOUT = 8 * MiB, WS_ROPE = 10 * MiB, WS_GAIN = 10 * MiB + 768 * 1024, WS_BAR = 10 * MiB + 800 * 1024, WS_SEGA = 11 * MiB, WS_SEGH = 12 * MiB, WS_AALL = 16 * MiB,
                 WS_QB = 152 * MiB, WS_KB = 218 * MiB, WS_VB = 282 * MiB, WS_KS = 346 * MiB, WS_VS = 382 * MiB, WS_MIX = 418 * MiB,
                 WS_LX = 548 * MiB, WS_MQ = 614 * MiB, WS_MKA = 648 * MiB, WS_MVA = 654 * MiB, WS_HL = 660 * MiB, WS_AC = 724 * MiB, WS_END = 788 * MiB;
#ifndef STAG_P1
#define STAG_P1 2000u
#endif
#ifndef STAG_P4
#define STAG_P4 1400u
#endif
constexpr int LDS_BYTES = 163840;
constexpr int LDS_TR = 131072, LDS_TA = 139264, LDS_GAIN = 143360, LDS_STG = 144384;
constexpr int LDS_WSF = 133120;
constexpr int RED_SLOT_F = 33280 / 4;

typedef unsigned short bf16_t;
typedef float f32x4 __attribute__((ext_vector_type(4)));
typedef float f32x2v __attribute__((ext_vector_type(2)));
typedef unsigned u32x4 __attribute__((ext_vector_type(4)));
typedef unsigned u32x2 __attribute__((ext_vector_type(2)));
#define LAS __attribute__((address_space(3)))

__device__ __forceinline__ unsigned f2bf(float f) { unsigned u = __builtin_bit_cast(unsigned, f); return (u + 0x7fffu + ((u >> 16) & 1u)) >> 16; }
__device__ __forceinline__ unsigned pk2(float lo, float hi) { return f2bf(lo) | (f2bf(hi) << 16); }
__device__ __forceinline__ unsigned hw_pk2(float lo, float hi) { typedef float f2_t __attribute__((ext_vector_type(2))); typedef __bf16 b2_t __attribute__((ext_vector_type(2)));
    f2_t v = {lo, hi}; b2_t b = __builtin_convertvector(v, b2_t); return __builtin_bit_cast(unsigned, b); }
__device__ __forceinline__ float bf2f(unsigned short b) { return __builtin_bit_cast(float, (unsigned)b << 16); }
__device__ __forceinline__ float fast_exp(float x) { return __builtin_amdgcn_exp2f(x * 1.4426950408889634f); }
__device__ __forceinline__ float sigmoidf_(float x) { return __builtin_amdgcn_rcpf(1.0f + fast_exp(-x)); }
__device__ __forceinline__ float siluf_(float x) { return x * sigmoidf_(x); }
template <int M> __device__ __forceinline__ float lane_xor(float v) { return __builtin_bit_cast(float, __builtin_amdgcn_ds_swizzle(__builtin_bit_cast(int, v), (M << 10) | 0x1f)); }
__device__ __forceinline__ float sum_xor32(float v) { const unsigned u = __builtin_bit_cast(unsigned, v); auto rr = __builtin_amdgcn_permlane32_swap(u, u, false, false);
    return __builtin_bit_cast(float, (unsigned)rr[0]) + __builtin_bit_cast(float, (unsigned)rr[1]); }
__device__ __forceinline__ float sum32(float v) { v += lane_xor<1>(v); v += lane_xor<2>(v); v += lane_xor<4>(v); v += lane_xor<8>(v); v += lane_xor<16>(v); return v; }
__device__ __forceinline__ float wave_sum(float v) { return sum_xor32(sum32(v)); }
__device__ __forceinline__ void st_bf16x8(bf16_t* p, const float (&v)[8]) {
    u32x4 w; w.x = hw_pk2(v[0], v[1]); w.y = hw_pk2(v[2], v[3]); w.z = hw_pk2(v[4], v[5]); w.w = hw_pk2(v[6], v[7]); *(u32x4*)p = w;
}
__device__ __forceinline__ void st_f32x8(float* p, const float (&v)[8]) {
    *(f32x4*)p = (f32x4){v[0], v[1], v[2], v[3]}; *(f32x4*)(p + 4) = (f32x4){v[4], v[5], v[6], v[7]};
}

__device__ __forceinline__ void stage_store_f32(LAS float* st, int fr, int fq, const float (&v)[8], float* gbase, size_t pitch) {
    *(LAS f32x4*)(st + fr * 36 + 8 * fq) = (f32x4){v[0], v[1], v[2], v[3]}; *(LAS f32x4*)(st + fr * 36 + 8 * fq + 4) = (f32x4){v[4], v[5], v[6], v[7]};
    asm volatile("s_waitcnt lgkmcnt(0)" ::: "memory");
    int lane = fr + 16 * fq; asm volatile("" : "+v"(lane));
    const int tr = lane >> 3, tc = 4 * (lane & 7);
    const f32x4 t0 = *(LAS const f32x4*)(st + tr * 36 + tc), t1 = *(LAS const f32x4*)(st + (8 + tr) * 36 + tc);
    asm volatile("s_waitcnt lgkmcnt(0)" ::: "memory");
    *(f32x4*)(gbase + (size_t)tr * pitch + tc) = t0; *(f32x4*)(gbase + (size_t)(8 + tr) * pitch + tc) = t1;
}

struct SchedIn {
    int G, c;
    __device__ bool next(int i, pg8::Unit& u) const {
        const long L = (long)i * G + c; constexpr int nM = NTOK / 256, nN = 12, nwg = nM * nN;
        if (L >= nwg + 16) return false;
        if (L >= nwg) { const int r = (int)L - nwg; u.pm = nM + (r >> 1); u.pn = 12 + (r & 1); return true; }
        int wgid = (int)L; { const int q = nwg / 8, xcd = wgid % 8, off = wgid / 8; wgid = xcd * q + off; }
        const int nig = 8 * nN, gid = wgid / nig, fm = gid * 8, gsz = (nM - fm) < 8 ? (nM - fm) : 8;
        u.pm = fm + ((wgid % nig) % gsz); u.pn = (wgid % nig) / gsz; return true;
    }
    __device__ __forceinline__ void a_ready(const pg8::Unit&) const {}
    __device__ __forceinline__ void done(const pg8::Unit&) const {}
};
struct SchedOut {
    int G, c;
    __device__ bool next(int i, pg8::Unit& u) const {
        const long L = (long)i * G + c; constexpr int nM = NTOK_P / 256, nN = 4, nwg = nM * nN;
        if (L >= nwg) return false;
        int wgid = (int)L; { const int q = nwg / 8, xcd = wgid % 8, off = wgid / 8; wgid = xcd * q + off; }
        const int nig = 8 * nN, gid = wgid / nig, fm = gid * 8, gsz = (nM - fm) < 8 ? (nM - fm) : 8;
        u.pm = fm + ((wgid % nig) % gsz); u.pn = (wgid % nig) / gsz; return true;
    }
    __device__ __forceinline__ void a_ready(const pg8::Unit&) const {}
    __device__ __forceinline__ void done(const pg8::Unit&) const {}
};

struct SchedOne {
    int pm, pn;
    __device__ bool next(int i, pg8::Unit& u) const { if (i > 0) return false; u.pm = pm; u.pn = pn; return true; }
    __device__ __forceinline__ void a_ready(const pg8::Unit&) const {}
    __device__ __forceinline__ void done(const pg8::Unit&) const {}
};
struct EpiIn {
    static constexpr bool PERM = true, AFTER_DRAIN = false;
    __device__ __forceinline__ void init(f32x4 (&acc)[2][2][4][2], const pg8::Unit&, int, int, int, int) const {
#pragma unroll
        for (int a = 0; a < 2; ++a)
#pragma unroll
            for (int b = 0; b < 2; ++b)
#pragma unroll
                for (int m = 0; m < 4; ++m)
#pragma unroll
                    for (int n = 0; n < 2; ++n) acc[a][b][m][n] = (f32x4){0.f, 0.f, 0.f, 0.f};
    }
    unsigned char* ws; float* out; LAS unsigned char* ldsb;
    __device__ __forceinline__ void operator()(const f32x4 (&acc)[2][2][4][2], const pg8::Unit& u, int wr, int wc, int fr, int fq) const {
        bf16_t* const Qb = (bf16_t*)(ws + WS_QB); bf16_t* const Kb = (bf16_t*)(ws + WS_KB); bf16_t* const Vb = (bf16_t*)(ws + WS_VB); bf16_t* const KS = (bf16_t*)(ws + WS_KS); bf16_t* const VS = (bf16_t*)(ws + WS_VS);
        bf16_t* const MIX = (bf16_t*)(ws + WS_MIX); bf16_t* const MQ = (bf16_t*)(ws + WS_MQ); bf16_t* const MKA = (bf16_t*)(ws + WS_MKA); bf16_t* const MVA = (bf16_t*)(ws + WS_MVA);
        float* const LX = (float*)(ws + WS_LX);
        const int pn = u.pn;
        LAS float* const stg = (LAS float*)(ldsb + LDS_STG) + (wr * 4 + wc) * 576;
        const int cl0 = 64 * wc + 8 * fq;
        const int rb = u.pm * 256 + wr * 64 + fr;
        LAS const float* g = nullptr;
        { LAS const float* const gains = (LAS const float*)(ldsb + LDS_GAIN); if (pn < 2) g = gains; else if (pn < 4) g = gains + 64; else if (pn == 10) g = gains + 128; else if (pn == 12) g = gains + 192; }
        float gv[2][8];
#pragma unroll
        for (int bj = 0; bj < 2; ++bj)
#pragma unroll
            for (int k = 0; k < 8; ++k) gv[bj][k] = g ? g[32 * bj + 8 * fq + k] : 1.f;
#pragma unroll
        for (int ai = 0; ai < 2; ++ai)
#pragma unroll
            for (int m = 0; m < 4; ++m) {
                const int row = rb + ai * 128 + m * 16;
                float v[2][8];
#pragma unroll
                for (int bj = 0; bj < 2; ++bj)
#pragma unroll
                    for (int n = 0; n < 2; ++n)
#pragma unroll
                        for (int e = 0; e < 4; ++e) v[bj][4 * n + e] = acc[ai][bj][m][n][e];
                if (g) {
                    float ss = 0.f;
#pragma unroll
                    for (int bj = 0; bj < 2; ++bj)
#pragma unroll
                        for (int k = 0; k < 8; ++k) ss += v[bj][k] * v[bj][k];
                    ss += lane_xor<16>(ss); ss = sum_xor32(ss);
                    const float rs = __builtin_amdgcn_rsqf(ss * (1.0f / 64.0f) + EPSN);
#pragma unroll
                    for (int bj = 0; bj < 2; ++bj)
#pragma unroll
                        for (int k = 0; k < 8; ++k) v[bj][k] *= rs * gv[bj][k];
                    if (pn < 4) {
                        const int pos = row < NTOK_P ? (row & (SEQ - 1)) : (PAST + (row & 31));
                        float pv[8];
#pragma unroll
                        for (int k = 0; k < 8; ++k) pv[k] = lane_xor<16>(v[0][k]);
                        if (fq < 2) {
                            LAS const f32x2v* tr = (LAS const f32x2v*)(ldsb + LDS_TR) + (pos & 127) * 8; LAS const f32x2v* ta = (LAS const f32x2v*)(ldsb + LDS_TA) + (pos >> 7) * 8;
#pragma unroll
                            for (int k = 0; k < 8; ++k) { const f32x2v R = tr[k], A = ta[k]; const float cc = A.x * R.x - A.y * R.y, sn = A.y * R.x + A.x * R.y;
                                v[0][k] = fq == 0 ? (v[0][k] * cc - pv[k] * sn) : (v[0][k] * cc + pv[k] * sn); }
                        }
                    }
                }
                if (pn < 2) {
#pragma unroll
                    for (int bj = 0; bj < 2; ++bj) { float o[8];
#pragma unroll
                        for (int k = 0; k < 8; ++k) o[k] = v[bj][k] * C2;
                        st_bf16x8(Qb + (size_t)row * 512 + 256 * pn + cl0 + 32 * bj, o); }
                } else if (pn < 6) {
                    const bool isk = pn < 4; const int col = 256 * (pn - (isk ? 2 : 4)) + cl0;
                    float* of; bf16_t* ob;
                    if (row < NTOK_P) { of = out + (isk ? O_KP : O_VP) + (size_t)row * 512 + col; ob = (isk ? Kb : Vb) + (size_t)row * 512 + col; }
                    else { const int rs_ = row - NTOK_P; of = out + (isk ? O_KS : O_VS) + (size_t)rs_ * 512 + col;
                           ob = (isk ? KS : VS) + ((size_t)(rs_ >> 5) * KSROWS + PAST + (rs_ & 31)) * 512 + col; }
                    float* const gb = of - (size_t)fr * 512 - 8 * fq;
#pragma unroll
                    for (int bj = 0; bj < 2; ++bj) { stage_store_f32(stg, fr, fq, v[bj], gb + 32 * bj, 512); st_bf16x8(ob + 32 * bj, v[bj]); }
                } else if (pn == 8) {
                    float* const gb = LX + (size_t)(row - fr) * 256 + 64 * wc;
#pragma unroll
                    for (int bj = 0; bj < 2; ++bj) stage_store_f32(stg, fr, fq, v[bj], gb + 32 * bj, 256);
                } else if (pn == 10) {
#pragma unroll
                    for (int bj = 0; bj < 2; ++bj) { float o[8];
#pragma unroll
                        for (int k = 0; k < 8; ++k) o[k] = v[bj][k] * C2;
                        st_bf16x8(MQ + (size_t)row * 256 + cl0 + 32 * bj, o); }
                } else if (pn >= 12) {
                    const int rm = row - NTOK;
#pragma unroll
                    for (int bj = 0; bj < 2; ++bj) { st_f32x8(out + (pn == 12 ? O_MK : O_MV) + (size_t)rm * 256 + cl0 + 32 * bj, v[bj]);
                        st_bf16x8((pn == 12 ? MKA : MVA) + (size_t)rm * 256 + cl0 + 32 * bj, v[bj]); }
                } else {
                    const int colb = pn == 6 ? 0 : pn == 7 ? 256 : pn == 9 ? 512 : 768;
#pragma unroll
                    for (int bj = 0; bj < 2; ++bj) { float o[8];
#pragma unroll
                        for (int k = 0; k < 8; ++k) o[k] = siluf_(v[bj][k]);
                        st_bf16x8(MIX + (size_t)row * 1024 + colb + cl0 + 32 * bj, o); }
                }
            }
    }
};
struct EpiOut {
    static constexpr bool PERM = true, AFTER_DRAIN = false;
    const float *xp, *xs; float* out; LAS unsigned char* ldsb;
    __device__ __forceinline__ void init(f32x4 (&acc)[2][2][4][2], const pg8::Unit& u, int wr, int wc, int fr, int fq) const {
        const int lane = fr + 16 * fq; LAS float* st = (LAS float*)(ldsb + LDS_TR) + (wr * 4 + wc) * 576;
        const int tr = lane >> 3, tc = 4 * (lane & 7);
#pragma unroll
        for (int ai = 0; ai < 2; ++ai)
#pragma unroll
            for (int m = 0; m < 4; ++m)
#pragma unroll
                for (int bj = 0; bj < 2; ++bj) {
                    int trr = tr; asm volatile("" : "+v"(trr));
                    const int row0 = u.pm * 256 + ai * 128 + wr * 64 + m * 16, col = 256 * u.pn + 64 * wc + 32 * bj + tc;
#pragma unroll
                    for (int j2 = 0; j2 < 2; ++j2) { const int row = row0 + 8 * j2 + trr;
                        acc[ai][bj][m][j2] = __builtin_nontemporal_load((const f32x4*)((row < NTOK_P ? xp + (size_t)row * 1024 : xs + (size_t)(row - NTOK_P) * 1024) + col)); }
                }
#pragma unroll
        for (int ai = 0; ai < 2; ++ai)
#pragma unroll
            for (int m = 0; m < 4; ++m)
#pragma unroll
                for (int bj = 0; bj < 2; ++bj) {
#pragma unroll
                    for (int j2 = 0; j2 < 2; ++j2) *(LAS f32x4*)(st + (8 * j2 + tr) * 36 + tc) = acc[ai][bj][m][j2];
                    asm volatile("s_waitcnt lgkmcnt(0)" ::: "memory");
#pragma unroll
                    for (int n = 0; n < 2; ++n) acc[ai][bj][m][n] = *(LAS const f32x4*)(st + fr * 36 + 8 * fq + 4 * n);
                    asm volatile("s_waitcnt lgkmcnt(0)" ::: "memory");
                }
    }
    __device__ __forceinline__ void operator()(const f32x4 (&acc)[2][2][4][2], const pg8::Unit& u, int wr, int wc, int fr, int fq) const {
        const int lane = fr + 16 * fq; LAS float* st = (LAS float*)(ldsb + LDS_TR) + (wr * 4 + wc) * 576;
        const int tr = lane >> 3, tc = 4 * (lane & 7);
#pragma unroll
        for (int ai = 0; ai < 2; ++ai)
#pragma unroll
            for (int m = 0; m < 4; ++m)
#pragma unroll
                for (int bj = 0; bj < 2; ++bj) {
#pragma unroll
                    for (int n = 0; n < 2; ++n) *(LAS f32x4*)(st + fr * 36 + 8 * fq + 4 * n) = acc[ai][bj][m][n];
                    asm volatile("s_waitcnt lgkmcnt(0)" ::: "memory");
                    int trr = tr; asm volatile("" : "+v"(trr));
                    const int row0 = u.pm * 256 + ai * 128 + wr * 64 + m * 16, col = 256 * u.pn + 64 * wc + 32 * bj + tc;
                    f32x4 t[2];
#pragma unroll
                    for (int j2 = 0; j2 < 2; ++j2) t[j2] = *(LAS const f32x4*)(st + (8 * j2 + tr) * 36 + tc);
                    asm volatile("s_waitcnt lgkmcnt(0)" ::: "memory");
#pragma unroll
                    for (int j2 = 0; j2 < 2; ++j2) *(f32x4*)(out + (size_t)(row0 + 8 * j2 + trr) * 1024 + col) = t[j2];
                }
    }
};

namespace att {
typedef short bf16x8 __attribute__((ext_vector_type(8)));
typedef short s16x4 __attribute__((ext_vector_type(4)));
typedef float f32x16 __attribute__((ext_vector_type(16)));
typedef float f32x2_t __attribute__((ext_vector_type(2)));
typedef __bf16 bf16x2_t __attribute__((ext_vector_type(2)));
__device__ __forceinline__ unsigned cvtpk(float lo, float hi) { f32x2_t v = {lo, hi}; bf16x2_t b = __builtin_convertvector(v, bf16x2_t); return __builtin_bit_cast(unsigned, b); }
__device__ __forceinline__ void glds16(const void* gsrc, unsigned lds_dst) { unsigned keep;
    asm volatile("s_mov_b32 %0, m0\n\ts_mov_b32 m0, %2\n\ts_nop 0\n\tglobal_load_lds_dwordx4 %1, off\n\ts_mov_b32 m0, %0" : "=&s"(keep) : "v"(gsrc), "s"(lds_dst) : "memory"); }
#define ATT_WAIT_BAR() asm volatile("s_waitcnt vmcnt(0) lgkmcnt(0)\n\ts_barrier" ::: "memory")
#ifndef ATT_PRIO
#define ATT_PRIO(x) do {} while (0)
#endif
#define ATT_LBAR() asm volatile("s_waitcnt lgkmcnt(0)\n\ts_barrier" ::: "memory")
__device__ __forceinline__ s16x4 vtr(LAS const unsigned char* p) { typedef short v4i16_t __attribute__((ext_vector_type(4)));
    return __builtin_bit_cast(s16x4, __builtin_amdgcn_ds_read_tr16_b64_v4i16((LAS v4i16_t*)p)); }
__device__ __forceinline__ int crow(int r, int hh) { return (r & 3) + 8 * (r >> 2) + 4 * hh; }

template <int NC, int DV>
__device__ __forceinline__ void attn_loop(unsigned char* ldsg, const bf16_t* Qrow, const unsigned char* Kg, const unsigned char* Vg, int kvstride, int NT, int last_nh, int mode, int wpar, int c,
                                          f32x16 (&O)[DV / 32], float& l) {
    constexpr int KROW = NC * 128, VROW = DV * 2, KT = 64 * KROW, VT = 64 * VROW, BUF = KT + VT, KPW = KT / 8192, VPW = VT / 8192, PPW = KPW + VPW;
    const int tid = threadIdx.x, lane = tid & 63, r32 = lane & 31, hh = lane >> 5; const int w = __builtin_amdgcn_readfirstlane(tid >> 6);
    LAS const unsigned char* lds3 = (LAS const unsigned char*)ldsg; const unsigned lds0 = (unsigned)(uintptr_t)ldsg;
    unsigned ksrc[KPW], vsrc[VPW];
#pragma unroll
    for (int i = 0; i < KPW; ++i) { const int pos = 64 * (KPW * w + i) + lane; constexpr int CPR = KROW / 16; const int row = pos / CPR, cp = pos % CPR;
        const int cc = cp ^ (KROW == 256 ? (row & 15) : ((row >> 1) & 7)); ksrc[i] = (unsigned)(row * kvstride + cc * 16); }
#pragma unroll
    for (int i = 0; i < VPW; ++i) { const int pos = 64 * (VPW * w + i) + lane; constexpr int CPR = VROW / 16; const int row = pos / CPR, cp = pos % CPR;
        const int cc = cp ^ (VROW == 256 ? 4 * (row & 3) : 4 * ((row >> 1) & 1)); vsrc[i] = (unsigned)(row * kvstride + cc * 16); }
#define ATT_ISSUE(j) do { const size_t tb_ = (size_t)(j) * 64 * (size_t)kvstride; const unsigned sb_ = lds0 + ((j) & 3) * BUF; \
        _Pragma("unroll") for (int i_ = 0; i_ < KPW; ++i_) glds16(Kg + tb_ + ksrc[i_], (unsigned)__builtin_amdgcn_readfirstlane(sb_ + 1024 * (KPW * w + i_))); \
        _Pragma("unroll") for (int i_ = 0; i_ < VPW; ++i_) glds16(Vg + tb_ + vsrc[i_], (unsigned)__builtin_amdgcn_readfirstlane(sb_ + KT + 1024 * (VPW * w + i_))); } while (0)
    bf16x8 q[4];
#pragma unroll
    for (int ks = 0; ks < 4; ++ks) q[ks] = *(const bf16x8*)(Qrow + c * 64 + ks * 16 + hh * 8);
    ATT_ISSUE(0); if (NT > 1) ATT_ISSUE(1); if (NT > 2) ATT_ISSUE(2);
    asm volatile("" : "+v"(q[0]), "+v"(q[1]), "+v"(q[2]), "+v"(q[3]) :: "memory");
    const int kx = KROW == 256 ? (r32 & 15) : ((r32 >> 1) & 7);
    const int kb = r32 * KROW + ((hh ^ (kx & 1)) << 4), kxh = (kx & ~1) << 4, cb = c << 7;
    const int L = lane & 15, gp = (lane >> 4) & 1, sw = VROW == 256 ? ((L >> 2) & 3) : ((L >> 3) & 1);
    int vo[DV / 32];
#pragma unroll
    for (int db = 0; db < DV / 32; ++db) vo[db] = (4 * hh + (L >> 2)) * VROW + ((((db ^ sw) << 2) + 2 * gp + ((L & 3) >> 1)) << 4) + 8 * (L & 1);
#pragma nounroll
    for (int j = 0; j < NT; ++j) {
        {   const int rem = NT - 1 - j;
            if (rem >= 2) { if constexpr (PPW == 4) asm volatile("s_waitcnt vmcnt(8) lgkmcnt(0)\n\ts_barrier" ::: "memory"); else asm volatile("s_waitcnt vmcnt(4) lgkmcnt(0)\n\ts_barrier" ::: "memory"); }
            else if (rem == 1) { if constexpr (PPW == 4) asm volatile("s_waitcnt vmcnt(4) lgkmcnt(0)\n\ts_barrier" ::: "memory"); else asm volatile("s_waitcnt vmcnt(2) lgkmcnt(0)\n\ts_barrier" ::: "memory"); }
            else asm volatile("s_waitcnt vmcnt(0) lgkmcnt(0)\n\ts_barrier" ::: "memory"); }
        if (j + 3 < NT) ATT_ISSUE(j + 3);
        const bool active = mode == 0 ? (j <= wpar) : mode == 1 ? ((j & 3) == wpar) : ((j >> 1) == wpar);
        if (active) {
            const int nh = (j == NT - 1) ? last_nh : 2;
            LAS const unsigned char* Kt = lds3 + (j & 3) * BUF; LAS const unsigned char* Vt = Kt + KT;
#pragma unroll
            for (int kh = 0; kh < 2; ++kh) {
                if (kh < nh) {
                    f32x16 X = {};
                    ATT_PRIO(1);
#pragma unroll
                    for (int ks = 0; ks < 4; ++ks) {
                        const int co = kb + ((cb + (ks << 5)) ^ kxh) + kh * 32 * KROW;
                        const bf16x8 a0 = *(LAS const bf16x8*)(Kt + co);
                        X = __builtin_amdgcn_mfma_f32_32x32x16_bf16(a0, q[ks], X, 0, 0, 0);
                    }
                    ATT_PRIO(0);
                    float s = 0.f; u32x4 pk[2];
#pragma unroll
                    for (int r = 0; r < 16; ++r) { X[r] = __builtin_amdgcn_exp2f(X[r]); s += X[r]; }
#pragma unroll
                    for (int s2 = 0; s2 < 2; ++s2) pk[s2] = (u32x4){cvtpk(X[8 * s2], X[8 * s2 + 1]), cvtpk(X[8 * s2 + 2], X[8 * s2 + 3]), cvtpk(X[8 * s2 + 4], X[8 * s2 + 5]), cvtpk(X[8 * s2 + 6], X[8 * s2 + 7])};
                    l += s;
                    ATT_PRIO(1);
#pragma unroll
                    for (int s2 = 0; s2 < 2; ++s2) {
                        const bf16x8 pa = __builtin_bit_cast(bf16x8, pk[s2]);
#pragma unroll
                        for (int db = 0; db < DV / 32; ++db) {
                            const s16x4 lo = vtr(Vt + vo[db] + (32 * kh + 16 * s2) * VROW), hi = vtr(Vt + vo[db] + (32 * kh + 16 * s2 + 8) * VROW);
                            const bf16x8 vb = (bf16x8){lo[0], lo[1], lo[2], lo[3], hi[0], hi[1], hi[2], hi[3]};
                            O[db] = __builtin_amdgcn_mfma_f32_32x32x16_bf16(pa, vb, O[db], 0, 0, 0);
                        }
                    }
                    ATT_PRIO(0);
                }
            }
        }
    }
    ATT_WAIT_BAR();
#undef ATT_ISSUE
}

template <int NDB>
__device__ __forceinline__ void tree_reduce4(f32x16 (&O)[NDB], float& l, LAS float* red, int w, int lane) {
    constexpr int SLOTF = (NDB * 16 + 1) * 64; const int grp = w >> 2, idx = w & 3;
#pragma unroll
    for (int step = 2; step >= 1; step >>= 1) {
        if (idx >= step && idx < 2 * step) { LAS float* s = red + (grp * 2 + idx - step) * SLOTF + lane;
#pragma unroll
            for (int db = 0; db < NDB; ++db) {
#pragma unroll
                for (int r = 0; r < 16; ++r) s[64 * (db * 16 + r)] = O[db][r];
                asm volatile("" ::: "memory"); }
            s[64 * NDB * 16] = l; }
        ATT_LBAR();
        if (idx < step) { LAS const float* s = red + (grp * 2 + idx) * SLOTF + lane;
#pragma unroll
            for (int db = 0; db < NDB; ++db) {
#pragma unroll
                for (int r = 0; r < 16; ++r) O[db][r] += s[64 * (db * 16 + r)];
                asm volatile("s_waitcnt lgkmcnt(0)" ::: "memory"); }
            l += s[64 * NDB * 16]; }
        ATT_LBAR();
    }
}
__device__ __forceinline__ void diff_finish(f32x16 (&O)[4], float l, int c, bool doit, float lam, LAS float* wsf, LAS float* xs, int tok0, int h, const float* gsub, bf16_t* MIX) {
    int lane = threadIdx.x & 63; asm volatile("" : "+v"(lane), "+v"(tok0));
    const int r32 = lane & 31, hh = lane >> 5;
    const float ls = sum_xor32(l);
    if (hh == 0) wsf[r32] = (c == 0 ? 1.0f : lam) / ls;
    asm volatile("s_waitcnt lgkmcnt(0)" ::: "memory");
    if (doit && c == 1) {
#pragma unroll
        for (int r = 0; r < 16; ++r) { const float a = wsf[crow(r, hh)];
#pragma unroll
            for (int db = 0; db < 4; ++db) xs[64 * (db * 16 + r) + lane] = O[db][r] * a; }
    }
    ATT_LBAR();
    if (doit && c == 0) {
        float gs[4];
#pragma unroll
        for (int db = 0; db < 4; ++db) gs[db] = gsub[32 * db + r32] * ONE_M_LINIT;
#pragma unroll
        for (int r0 = 0; r0 < 16; r0 += 8) {
            unsigned short gt[8][4];
#pragma unroll
            for (int r = 0; r < 8; ++r) { const bf16_t* p = MIX + (size_t)(tok0 + crow(r0 + r, hh)) * 1024 + h * 128 + r32;
#pragma unroll
                for (int db = 0; db < 4; ++db) gt[r][db] = p[32 * db]; }
#pragma unroll
            for (int r = 0; r < 8; ++r) {
                const int qr = crow(r0 + r, hh); const float a = wsf[qr];
                float o[4], ss = 0.f;
#pragma unroll
                for (int db = 0; db < 4; ++db) { o[db] = O[db][r0 + r] * a - xs[64 * (db * 16 + r0 + r) + lane]; ss += o[db] * o[db]; }
                ss = sum32(ss);
                const float rs = __builtin_amdgcn_rsqf(ss * (1.0f / 128.0f) + EPSN);
                bf16_t* p = MIX + (size_t)(tok0 + qr) * 1024 + h * 128 + r32;
#pragma unroll
                for (int db = 0; db < 4; ++db) p[32 * db] = (bf16_t)f2bf(o[db] * rs * gs[db] * bf2f(gt[r][db]));
            }
            asm volatile("" ::: "memory");
        }
    }
    ATT_LBAR();
}
__device__ __forceinline__ void mem_finish(f32x16 (&O)[2], float l, int part, bool doit, bool pair, LAS float* wsf, LAS float* xs, int tok0, int h, bf16_t* MIX) {
    int lane = threadIdx.x & 63; asm volatile("" : "+v"(lane), "+v"(tok0));
    const int r32 = lane & 31, hh = lane >> 5;
    const float ls = sum_xor32(l);
    if (doit && part == 1) {
#pragma unroll
        for (int db = 0; db < 2; ++db)
#pragma unroll
            for (int r = 0; r < 16; ++r) xs[64 * (db * 16 + r) + lane] = O[db][r];
        xs[64 * 32 + lane] = ls;
    }
    ATT_LBAR();
    if (doit && part == 0) {
        const float lt = ls + (pair ? xs[64 * 32 + lane] : 0.f);
        if (hh == 0) wsf[r32] = 1.0f / lt;
        asm volatile("s_waitcnt lgkmcnt(0)" ::: "memory");
        unsigned short gt[16][2];
#pragma unroll
        for (int r = 0; r < 16; ++r) { const bf16_t* p = MIX + (size_t)(tok0 + crow(r, hh)) * 1024 + 768 + h * 64 + r32; gt[r][0] = p[0]; gt[r][1] = p[32]; }
#pragma unroll
        for (int r = 0; r < 16; ++r) {
            const int qr = crow(r, hh); const float a = wsf[qr];
            bf16_t* p = MIX + (size_t)(tok0 + qr) * 1024 + 768 + h * 64 + r32;
#pragma unroll
            for (int db = 0; db < 2; ++db) p[32 * db] = (bf16_t)f2bf((O[db][r] + (pair ? xs[64 * (db * 16 + r) + lane] : 0.f)) * a * bf2f(gt[r][db]));
        }
    }
    ATT_LBAR();
}
}

struct Args { const float* in[30]; float* out; unsigned char* ws; double rope_r0; double inv2pi; int ph_lo, ph_hi; };
enum { I_XP = 0, I_XS, I_MEM, I_CDK, I_CDV, I_CMK, I_CMV, I_SCONV, I_SH, I_NORMG, I_WIN, I_GQ, I_GK, I_LQ1, I_LK1, I_LQ2, I_LK2, I_GSUB, I_CONVW, I_CONVB, I_WA, I_BA, I_WX, I_BX,
       I_LAMBDA, I_MEMNG, I_WMEM, I_GMQ, I_GMK, I_WOUT };

__device__ __forceinline__ void p0_transpose_item(const float* W, int N, bf16_t* WT, int row_off, LAS float* scr, int item, int lane) {
    const int nblk = N / 32, kb = item / nblk, nb = item % nblk, k0 = 64 * kb, n0 = 32 * nb;
#pragma unroll 8
    for (int i = 0; i < 32; ++i) { const int kk = 2 * i + (lane >> 5); scr[kk * 33 + (lane & 31)] = W[(size_t)(k0 + kk) * N + n0 + (lane & 31)]; }
    asm volatile("s_waitcnt lgkmcnt(0)" ::: "memory");
    const int cl = n0 & 255, p0 = (n0 & ~255) + 128 * ((cl >> 5) & 1) + 32 * (cl >> 6);
    const int c = lane & 7;
#pragma unroll
    for (int j = 0; j < 4; ++j) { const int n = (lane >> 3) + 8 * j; const LAS float* s = scr + (8 * c) * 33 + n;
        u32x4 o; o.x = pk2(s[0 * 33], s[1 * 33]); o.y = pk2(s[2 * 33], s[3 * 33]); o.z = pk2(s[4 * 33], s[5 * 33]); o.w = pk2(s[6 * 33], s[7 * 33]);
        *(u32x4*)(WT + (size_t)(row_off + p0 + n) * 1024 + k0 + 8 * c) = o; }
    asm volatile("s_waitcnt lgkmcnt(0)" ::: "memory");
}
__device__ __forceinline__ void rms_row_to_bf16(const float* xrow, const float* g, bf16_t* orow, int lane) {
    const f32x4* xr = (const f32x4*)xrow + lane; const f32x4* gr = (const f32x4*)g + lane;
    f32x4 v[4]; float s = 0.f;
#pragma unroll
    for (int j = 0; j < 4; ++j) { v[j] = __builtin_nontemporal_load(xr + 64 * j); s += (v[j].x * v[j].x + v[j].y * v[j].y) + (v[j].z * v[j].z + v[j].w * v[j].w); }
    const float rs = __builtin_amdgcn_rsqf(wave_sum(s) * (1.f / 1024.f) + EPSN);
    unsigned long long* o8 = (unsigned long long*)orow + lane;
#pragma unroll
    for (int j = 0; j < 4; ++j) { const f32x4 gg = gr[64 * j]; const f32x4 t = v[j] * gg * rs;
        o8[64 * j] = (unsigned long long)pk2(t.x, t.y) | ((unsigned long long)pk2(t.z, t.w) << 32); }
}

#define XB_TMO      128
#define XB_XCNT(j)  (256  + 64 * (j))
#define XB_XSUB(j)  (1280 + 64 * (j))
#define XB_XGEN(j)  (2304 + 64 * (j))
#define XB_TOP      3328
#define XB_TOPGEN   3392
#define XCD_BAR_WORDS 3456
#define XB_SPIN_CAP (1u << 18)

__device__ __forceinline__ unsigned xb_ld(unsigned* p)              { return __hip_atomic_load(p, __ATOMIC_RELAXED, __HIP_MEMORY_SCOPE_AGENT); }
__device__ __forceinline__ unsigned xb_add(unsigned* p, unsigned v) { return __hip_atomic_fetch_add(p, v, __ATOMIC_RELAXED, __HIP_MEMORY_SCOPE_AGENT); }
__device__ __forceinline__ unsigned xb_xcc_id() { return (unsigned)__builtin_amdgcn_s_getreg((3 << 11) | 20) & 0xFu; }
#define XB_SPIN(cond, bar) do { unsigned _sp = 0; while (cond) { __builtin_amdgcn_s_sleep(1); \
    if ((++_sp & 255u) == 0u) { if (xb_ld(&(bar)[XB_TMO])) break; if (_sp > XB_SPIN_CAP) { atomicAdd(&(bar)[XB_TMO], 1u); break; } } } } while (0)

struct XcdBarrier {
    unsigned* bar; unsigned x;
    volatile LAS unsigned* st;
};

__device__ __forceinline__ XcdBarrier xcd_barrier_post(unsigned* bar, volatile LAS unsigned* st) {
    XcdBarrier b; b.bar = bar; b.x = xb_xcc_id(); b.st = st;
    if (threadIdx.x == 0) (void)xb_add(&bar[XB_XCNT(b.x)], 1u);
    return b;
}
__device__ __forceinline__ void xcd_barrier_complete(unsigned* bar, unsigned x, unsigned& nloc, unsigned& nx) {
    const unsigned G = gridDim.x * gridDim.y * gridDim.z;
    unsigned sum, cnt, mine, sp = 0u;
    for (;;) {
        sum = 0u; cnt = 0u; mine = 0u;
#pragma unroll
        for (unsigned j = 0; j < 16; ++j) { const unsigned c = xb_ld(&bar[XB_XCNT(j)]); sum += c; cnt += (c > 0u) ? 1u : 0u; mine = (j == x) ? c : mine; }
        if (sum == G) break;
        __builtin_amdgcn_s_sleep(1);
        if ((++sp & 255u) == 0u) { if (xb_ld(&bar[XB_TMO])) break; if (sp > XB_SPIN_CAP) { atomicAdd(&bar[XB_TMO], 1u); break; } }
    }
    nloc = mine > 0u ? mine : 1u; nx = cnt > 0u ? cnt : 1u;
}

__device__ __forceinline__ void xcd_barrier(const XcdBarrier& b) {
    asm volatile("s_waitcnt vmcnt(0)" ::: "memory");
    __syncthreads();
    if (threadIdx.x == 0) {
        unsigned* bar = b.bar;
        __builtin_amdgcn_s_waitcnt(0);
        unsigned nloc = b.st[0], nx = b.st[1];
        if (nloc == 0u) { xcd_barrier_complete(bar, b.x, nloc, nx); b.st[0] = nloc; b.st[1] = nx; }
        const unsigned old = xb_add(&bar[XB_XSUB(b.x)], 1u);
        const unsigned gen = old / nloc;
        if (old + 1u == (gen + 1u) * nloc) {
            __builtin_amdgcn_fence(__ATOMIC_RELEASE, "agent");
            asm volatile("s_waitcnt vmcnt(0)" ::: "memory");
            const unsigned og = xb_add(&bar[XB_TOP], 1u);
            const unsigned tg = og / nx;
            if (og + 1u == (tg + 1u) * nx) xb_add(&bar[XB_TOPGEN], 1u);
            else XB_SPIN(xb_ld(&bar[XB_TOPGEN]) == tg, bar);
            __builtin_amdgcn_fence(__ATOMIC_ACQUIRE, "agent");
            xb_add(&bar[XB_XGEN(b.x)], 1u);
            asm volatile("s_waitcnt vmcnt(0)" ::: "memory");
        } else {
            XB_SPIN(xb_ld(&bar[XB_XGEN(b.x)]) == gen, bar);
            __builtin_amdgcn_fence(__ATOMIC_ACQUIRE, "agent");
            asm volatile("s_waitcnt vmcnt(0)" ::: "memory");
        }
    }
    __syncthreads();
}

__device__ __forceinline__ void grid_bar(unsigned* ctr, unsigned target) {
    asm volatile("s_waitcnt vmcnt(0) lgkmcnt(0)" ::: "memory");
    __syncthreads();
    if (threadIdx.x == 0) {
        __builtin_amdgcn_fence(__ATOMIC_RELEASE, "agent");
        asm volatile("s_waitcnt vmcnt(0)" ::: "memory");
        __hip_atomic_fetch_add(ctr, 1u, __ATOMIC_RELAXED, __HIP_MEMORY_SCOPE_AGENT);
        while (__hip_atomic_load(ctr, __ATOMIC_RELAXED, __HIP_MEMORY_SCOPE_AGENT) < target) __builtin_amdgcn_s_sleep(2);
        __builtin_amdgcn_fence(__ATOMIC_ACQUIRE, "agent");
        asm volatile("s_waitcnt vmcnt(0)" ::: "memory");
    }
    __syncthreads();
}

__device__ __forceinline__ void stagger(bool late, unsigned ticks) {
    if (late) { const unsigned long long t0 = __builtin_amdgcn_s_memrealtime(); while (__builtin_amdgcn_s_memrealtime() - t0 < ticks) __builtin_amdgcn_s_sleep(20); }
}

__global__ void __launch_bounds__(512, 2) fwd_kernel(Args args) {
    extern __shared__ __attribute__((aligned(16))) unsigned char lds[];
    const int tid = threadIdx.x, lane = tid & 63; const int wave = __builtin_amdgcn_readfirstlane(tid >> 6);
    const int G = gridDim.x, bx = blockIdx.x;
    const int vcu = (G % 8 == 0) ? (bx % 8) * (G / 8) + bx / 8 : bx;
    unsigned char* ws = args.ws; float* out = args.out;
    const int lo = args.ph_lo, hi = args.ph_hi;
#define IN(k) (lo <= (k) && (k) < hi)
#define GRID_SYNC(k) do { if (IN(k) && IN((k) + 1)) xcd_barrier(xbar); } while (0)
    XcdBarrier xbar; xbar.bar = (unsigned*)(ws + WS_BAR); xbar.x = 0; xbar.st = (volatile LAS unsigned*)((LAS unsigned char*)lds + LDS_BYTES - 16);
    if (hi - lo > 1) {
        if (bx == 0) for (int i = tid; i < XCD_BAR_WORDS; i += 512) __hip_atomic_store((unsigned*)(ws + WS_BAR) + i, 0u, __ATOMIC_RELAXED, __HIP_MEMORY_SCOPE_AGENT);
        if (tid < 2) xbar.st[tid] = 0u;
        cg::this_grid().sync();
        xbar = xcd_barrier_post((unsigned*)(ws + WS_BAR), xbar.st);
    }

    if (IN(0)) {
        bf16_t* const WIN = (bf16_t*)(ws + WS_WIN); bf16_t* const WOUT = (bf16_t*)(ws + WS_WOUT); f32x2v* const ROPE = (f32x2v*)(ws + WS_ROPE); bf16_t* const AALL = (bf16_t*)(ws + WS_AALL); bf16_t* const KS = (bf16_t*)(ws + WS_KS); bf16_t* const VS = (bf16_t*)(ws + WS_VS); bf16_t* const MKA = (bf16_t*)(ws + WS_MKA); bf16_t* const MVA = (bf16_t*)(ws + WS_MVA);
#ifndef SKIP_P0
        LAS float* scr = (LAS float*)((LAS unsigned char*)lds + wave * 16384);
        const int gw = vcu * 8 + wave, NGW = G * 8;
        constexpr int I_IN = 16 * 96, I_MEMW = 16 * 16, I_OUTW = 16 * 32;
        for (int it = gw; it < I_IN + I_MEMW + I_OUTW; it += NGW) {
            int r = it;
            if (r < I_IN) { p0_transpose_item(args.in[I_WIN], 3072, WIN, 0, scr, r, lane); continue; } r -= I_IN;
            if (r < I_MEMW) { p0_transpose_item(args.in[I_WMEM], 512, WIN, 3072, scr, r, lane); continue; } r -= I_MEMW;
            p0_transpose_item(args.in[I_WOUT], 1024, WOUT, 0, scr, r, lane);
        }
        for (int m = gw; m < AROWS; m += NGW) {
            const float* src = m < NTOK_P ? args.in[I_XP] + (size_t)m * 1024 : m < NTOK ? args.in[I_XS] + (size_t)(m - NTOK_P) * 1024 : args.in[I_MEM] + (size_t)(m - NTOK) * 1024;
            rms_row_to_bf16(src, m < NTOK ? args.in[I_NORMG] : args.in[I_MEMNG], AALL + (size_t)m * 1024, lane);
        }
        for (int m = gw; m < 2 * SBAT * PAST; m += NGW) {
            const int which = m >= SBAT * PAST, r = which ? m - SBAT * PAST : m, b = r >> 10, t = r & 1023;
            const f32x4* s = (const f32x4*)(args.in[which ? I_CDV : I_CDK] + (size_t)r * 512) + 2 * lane; const f32x4 a = s[0], c = s[1];
            u32x4 o; o.x = pk2(a.x, a.y); o.y = pk2(a.z, a.w); o.z = pk2(c.x, c.y); o.w = pk2(c.z, c.w);
            *((u32x4*)((which ? VS : KS) + ((size_t)b * KSROWS + t) * 512) + lane) = o;
        }
        for (int m = gw; m < 2 * SBAT * 256; m += NGW) {
            const int which = m >= SBAT * 256, r = which ? m - SBAT * 256 : m;
            const f32x4 a = *((const f32x4*)(args.in[which ? I_CMV : I_CMK] + (size_t)r * 256) + lane);
            u32x2 o; o.x = pk2(a.x, a.y); o.y = pk2(a.z, a.w);
            *((u32x2*)((which ? MVA : MKA) + (size_t)(NMEMROW + r) * 256) + lane) = o;
        }
        if (vcu == 0 && tid < 256) { const int k = tid >> 6; const float* src = k == 0 ? args.in[I_GQ] : k == 1 ? args.in[I_GK] : k == 2 ? args.in[I_GMQ] : args.in[I_GMK];
            ((float*)(ws + WS_GAIN))[tid] = src[tid & 63]; }
        for (int idx = (vcu * 512 + tid); idx < SEQ * 8; idx += G * 512) {
            const int pos = idx >> 3, i = idx & 7; double f = args.inv2pi;
            for (int k = 0; k < i; ++k) f *= args.rope_r0;
            double rev = (double)pos * f; rev -= __builtin_rint(rev);
            const float fr = (float)rev; ROPE[idx] = (f32x2v){__builtin_amdgcn_cosf(fr), __builtin_amdgcn_sinf(fr)};
        }
#endif
        asm volatile("s_waitcnt vmcnt(0) lgkmcnt(0)" ::: "memory"); __syncthreads();
    }
    GRID_SYNC(0);

    if (IN(1)) {
        bf16_t* const WIN = (bf16_t*)(ws + WS_WIN); bf16_t* const AALL = (bf16_t*)(ws + WS_AALL);
#ifndef SKIP_P1

        {   const f32x2v* const ROPE = (const f32x2v*)(ws + WS_ROPE); LAS f32x2v* tr = (LAS f32x2v*)((LAS unsigned char*)lds + LDS_TR); LAS f32x2v* ta = (LAS f32x2v*)((LAS unsigned char*)lds + LDS_TA);
            for (int i = tid; i < 1024; i += 512) tr[i] = ROPE[i];
            ta[tid] = ROPE[(size_t)(tid >> 3) * 128 * 8 + (tid & 7)];
            if (tid < 256) ((LAS float*)((LAS unsigned char*)lds + LDS_GAIN))[tid] = ((const float*)(ws + WS_GAIN))[tid];
            asm volatile("s_waitcnt vmcnt(0) lgkmcnt(0)" ::: "memory"); __syncthreads(); }
        pg8::Gemm g{AALL, WIN, AROWS, 3584, 1024}; SchedIn S{G, bx};
        EpiIn E{ws, out, (LAS unsigned char*)lds};
        pg8::gemm_phase<EpiIn, SchedIn, true, true>((LAS unsigned char*)lds, g, S, E);
#ifdef REP_P1
        asm volatile("s_waitcnt vmcnt(0) lgkmcnt(0)" ::: "memory"); __syncthreads();
        pg8::gemm_phase<EpiIn, SchedIn, true, true>((LAS unsigned char*)lds, g, S, E);
#endif
#endif
        asm volatile("s_waitcnt vmcnt(0) lgkmcnt(0)" ::: "memory"); __syncthreads();
    }
    GRID_SYNC(1);

    if (IN(2)) {
        bf16_t* const QB = (bf16_t*)(ws + WS_QB); bf16_t* const KB = (bf16_t*)(ws + WS_KB); bf16_t* const VB = (bf16_t*)(ws + WS_VB); bf16_t* const KS = (bf16_t*)(ws + WS_KS); bf16_t* const VS = (bf16_t*)(ws + WS_VS); bf16_t* const MIX = (bf16_t*)(ws + WS_MIX); float* const LX = (float*)(ws + WS_LX); bf16_t* const MQ = (bf16_t*)(ws + WS_MQ); bf16_t* const MKA = (bf16_t*)(ws + WS_MKA); bf16_t* const MVA = (bf16_t*)(ws + WS_MVA); float* const HL = (float*)(ws + WS_HL); float* const AC = (float*)(ws + WS_AC); float* const SEGA = (float*)(ws + WS_SEGA); float* const SEGH = (float*)(ws + WS_SEGH);
        LAS float* wsf = (LAS float*)((LAS unsigned char*)lds + LDS_WSF) + wave * 64;
        float lam;
        { const float d1 = wave_sum(args.in[I_LQ1][lane] * args.in[I_LK1][lane]), d2 = wave_sum(args.in[I_LQ2][lane] * args.in[I_LK2][lane]); lam = expf(d1) - expf(d2) + LAMBDA_INIT; }
        const int r32 = lane & 31;
#ifndef SKIP_P2A
        const int qg = wave & 3, cw = wave >> 2;
        LAS float* xs = (LAS float*)lds + qg * 4160;
        for (int vv = vcu; vv < 256; vv += G) {
            const int xcd = vv >> 5, kk = vv & 31;
#pragma nounroll
            for (int i = 0; i < 8; ++i) {
                const int bh = xcd * 4 + (i >> 1), b = bh >> 2, h = bh & 3;
                const int qb = (i & 1) ? 63 - kk : kk;
                const int tok0 = b * SEQ + qb * 128 + qg * 32;
                {   att::f32x16 O[4]; float l = 0.f;
#pragma unroll
                    for (int db = 0; db < 4; ++db) O[db] = att::f32x16{};
                    att::attn_loop<2, 128>(lds, QB + (size_t)(tok0 + r32) * 512 + h * 128, (const unsigned char*)(KB + (size_t)b * SEQ * 512 + h * 128), (const unsigned char*)(VB + (size_t)b * SEQ * 512 + h * 128),
                                           1024, 2 * qb + 2, 2, 0, 2 * qb + (qg >> 1), cw, O, l);
#ifdef REP_ATT
                    att::attn_loop<2, 128>(lds, QB + (size_t)(tok0 + r32) * 512 + h * 128, (const unsigned char*)(KB + (size_t)b * SEQ * 512 + h * 128), (const unsigned char*)(VB + (size_t)b * SEQ * 512 + h * 128),
                                           1024, 2 * qb + 2, 2, 0, 2 * qb + (qg >> 1), cw, O, l);
#endif
                    att::diff_finish(O, l, cw, true, lam, wsf, xs, tok0, h, args.in[I_GSUB], MIX); }
                {   att::f32x16 O[2]; float l = 0.f; O[0] = att::f32x16{}; O[1] = att::f32x16{};
                    att::attn_loop<1, 64>(lds, MQ + (size_t)(tok0 + r32) * 256 + h * 64, (const unsigned char*)(MKA + (size_t)b * 256 * 256 + h * 64), (const unsigned char*)(MVA + (size_t)b * 256 * 256 + h * 64),
                                          512, 4, 2, 2, cw, 0, O, l);
                    att::mem_finish(O, l, cw, true, true, wsf, xs, tok0, h, MIX); }
            }
        }
        for (int uu = vcu; uu < 128; uu += G) {
            const int b = uu >> 2, h = uu & 3, tok0 = NTOK_P + b * 32;
            {   att::f32x16 O[4]; float l = 0.f;
#pragma unroll
                for (int db = 0; db < 4; ++db) O[db] = att::f32x16{};
                att::attn_loop<2, 128>(lds, QB + (size_t)(tok0 + r32) * 512 + h * 128, (const unsigned char*)(KS + (size_t)b * KSROWS * 512 + h * 128), (const unsigned char*)(VS + (size_t)b * KSROWS * 512 + h * 128),
                                       1024, 17, 1, 1, qg, cw, O, l);
                att::tree_reduce4<4>(O, l, (LAS float*)lds, wave, lane);
                att::diff_finish(O, l, cw, qg == 0, lam, wsf, (LAS float*)lds, tok0, h, args.in[I_GSUB], MIX); }
            {   att::f32x16 O[2]; float l = 0.f; O[0] = att::f32x16{}; O[1] = att::f32x16{};
                att::attn_loop<1, 64>(lds, MQ + (size_t)(tok0 + r32) * 256 + h * 64, (const unsigned char*)(MKA + (size_t)(NB + b) * 256 * 256 + h * 64), (const unsigned char*)(MVA + (size_t)(NB + b) * 256 * 256 + h * 64),
                                      512, 4, 2, 1, cw == 0 ? qg : 7, 0, O, l);
                att::tree_reduce4<2>(O, l, (LAS float*)lds, wave, lane);
                att::mem_finish(O, l, 0, wave == 0, false, wsf, (LAS float*)lds, tok0, h, MIX); }
        }
#endif
#ifndef SKIP_P2L
        for (int uu = (G - 1 - vcu); uu < 640; uu += G) {
            const bool smp = uu >= 512; int b, n, row0, ntok, seg0;
            if (!smp) { b = uu >> 6; n = (uu >> 4) & 3; const int c = uu & 15; row0 = b * SEQ + c * 512; ntok = 512; seg0 = 8 * c; }
            else { const int r = uu - 512; b = r >> 2; n = r & 3; row0 = NTOK_P + b * 32; ntok = 32; seg0 = 0; }
            const int t0 = wave * 64, ch = n * 64 + lane;
            if (t0 < ntok) {
                const int ntw = (ntok - t0) < 64 ? (ntok - t0) : 64;
                const float* cw = args.in[I_CONVW]; const float cw0 = cw[ch], cw1 = cw[256 + ch], cw2 = cw[512 + ch], cw3 = cw[768 + ch], cb = args.in[I_CONVB][ch];
                float xm3, xm2, xm1;
                if (seg0 + wave > 0) { const float* p = LX + (size_t)(row0 + t0) * 256 + ch; xm3 = p[-3 * 256]; xm2 = p[-2 * 256]; xm1 = p[-256]; }
                else if (smp) { const float* p = args.in[I_SCONV] + (size_t)b * 3 * 256 + ch; xm3 = p[0]; xm2 = p[256]; xm1 = p[512]; }
                else { xm3 = 0.f; xm2 = 0.f; xm1 = 0.f; }
                LAS float* xc = (LAS float*)lds + wave * 4096;
                for (int tb = 0; tb < ntw; tb += 16) {
                    float xb[16];
#pragma unroll
                    for (int k = 0; k < 16; ++k) xb[k] = LX[(size_t)(row0 + t0 + tb + k) * 256 + ch];
#pragma unroll
                    for (int k = 0; k < 16; ++k) { const float x = xb[k]; xc[(tb + k) * 64 + lane] = cb + cw0 * xm3 + cw1 * xm2 + cw2 * xm1 + cw3 * x; xm3 = xm2; xm2 = xm1; xm1 = x; }
                }
                asm volatile("s_waitcnt lgkmcnt(0)" ::: "memory");
                f32x2v w2[64];
                { const float* pa = args.in[I_WA] + (size_t)n * 4096 + lane; const float* px = args.in[I_WX] + (size_t)n * 4096 + lane;
#pragma unroll
                  for (int i = 0; i < 64; ++i) w2[i] = (f32x2v){pa[i * 64], px[i * 64]}; }
                const float ba = args.in[I_BA][ch], bxx = args.in[I_BX][ch];
                const float sp = log1pf(expf(-args.in[I_LAMBDA][ch]));
                float hcur = smp ? args.in[I_SH][(size_t)b * 256 + ch] : 0.f, acur = 1.f;
                for (int t = 0; t < ntw; ++t) {
                    f32x2v g2 = {ba, bxx};
#pragma unroll
                    for (int i4 = 0; i4 < 16; ++i4) { const f32x4 xv = *(LAS const f32x4*)(xc + t * 64 + 4 * i4);
                        g2 = __builtin_elementwise_fma((f32x2v){xv.x, xv.x}, w2[4 * i4], g2); g2 = __builtin_elementwise_fma((f32x2v){xv.y, xv.y}, w2[4 * i4 + 1], g2);
                        g2 = __builtin_elementwise_fma((f32x2v){xv.z, xv.z}, w2[4 * i4 + 2], g2); g2 = __builtin_elementwise_fma((f32x2v){xv.w, xv.w}, w2[4 * i4 + 3], g2); }
                    const float xcj = xc[t * 64 + lane];
                    const float rg = sigmoidf_(g2.x), ig = sigmoidf_(g2.y);
                    const float la = -8.0f * rg * sp, a = fast_exp(la), y2 = 2.0f * la;
                    const float em = -y2 * (1.0f + y2 * (0.5f + y2 * (0.16666667f + y2 * (0.041666668f + y2 * 0.008333334f))));
                    const float bb = __builtin_amdgcn_sqrtf(em) * (ig * xcj);
                    hcur = a * hcur + bb; acur *= a;
                    const size_t row = (size_t)(row0 + t0 + t);
                    if (!smp) { HL[row * 256 + ch] = hcur; AC[row * 256 + ch] = acur; }
                    else { bf16_t* p = MIX + row * 1024 + 512 + ch; *p = (bf16_t)f2bf(hcur * bf2f(*p)); }
                }
                if (!smp) { const size_t si = ((size_t)b * 128 + seg0 + wave) * 256 + ch; SEGA[si] = acur; SEGH[si] = hcur; }
                else { out[O_HS + (size_t)b * 256 + ch] = hcur;
#pragma unroll
                    for (int k = 0; k < 3; ++k) out[O_CS + ((size_t)b * 3 + k) * 256 + ch] = LX[(size_t)(row0 + 29 + k) * 256 + ch]; }
            }
            asm volatile("s_waitcnt lgkmcnt(0)" ::: "memory"); __syncthreads();
        }
#endif
        asm volatile("s_waitcnt vmcnt(0) lgkmcnt(0)" ::: "memory"); __syncthreads();
    }
    GRID_SYNC(2);

    if (IN(3)) {
        bf16_t* const MIX = (bf16_t*)(ws + WS_MIX); float* const LX = (float*)(ws + WS_LX); float* const HL = (float*)(ws + WS_HL); float* const AC = (float*)(ws + WS_AC); float* const SEGA = (float*)(ws + WS_SEGA); float* const SEGH = (float*)(ws + WS_SEGH);
#ifndef SKIP_P3
        if (G >= 32 && vcu < 16) {
            bf16_t* const WOUT = (bf16_t*)(ws + WS_WOUT);
            pg8::Gemm g{MIX, WOUT, NTOK, 1024, 1024}; SchedOne S{NTOK_P / 256 + (vcu >> 2), vcu & 3};
            EpiOut E{args.in[I_XP], args.in[I_XS], out, (LAS unsigned char*)lds};
            pg8::gemm_phase<EpiOut, SchedOne, true, true>((LAS unsigned char*)lds, g, S, E);
        } else
        for (int uu = (G >= 32 ? vcu - 16 : vcu); uu < 256; uu += (G >= 32 ? G - 16 : G)) {
            const int b = uu >> 5, gI = uu & 31, ch = tid & 255, th = tid >> 8, s0 = 4 * gI + 2 * th;
            const float* sa = SEGA + (size_t)b * 128 * 256 + ch; const float* sh = SEGH + (size_t)b * 128 * 256 + ch;
            float H = 0.f;
            {   int s = 0;
                for (; s + 16 <= s0; s += 16) { float av[16], hv[16];
#pragma unroll
                    for (int k = 0; k < 16; ++k) { av[k] = sa[(s + k) * 256]; hv[k] = sh[(s + k) * 256]; }
#pragma unroll
                    for (int k = 0; k < 16; ++k) H = av[k] * H + hv[k]; }
                for (; s < s0; ++s) H = sa[s * 256] * H + sh[s * 256]; }
            for (int s = s0; s < s0 + 2; ++s) {
                const size_t rbase = (size_t)b * SEQ + 64 * s;
#pragma unroll 8
                for (int t = 0; t < 64; ++t) { const size_t row = rbase + t; const float hv = HL[row * 256 + ch] + AC[row * 256 + ch] * H;
                    bf16_t* p = MIX + row * 1024 + 512 + ch; *p = (bf16_t)f2bf(hv * bf2f(*p));
                    if (s == 127 && t == 63) out[O_HP + (size_t)b * 256 + ch] = hv; }
                H = sa[s * 256] * H + sh[s * 256];
            }
            if (gI == 31 && th == 0) {
#pragma unroll
                for (int k = 0; k < 3; ++k) out[O_CP + ((size_t)b * 3 + k) * 256 + ch] = LX[((size_t)b * SEQ + SEQ - 3 + k) * 256 + ch];
            }
        }
#endif
        asm volatile("s_waitcnt vmcnt(0) lgkmcnt(0)" ::: "memory"); __syncthreads();
    }
    GRID_SYNC(3);

    if (IN(4)) {
        bf16_t* const MIX = (bf16_t*)(ws + WS_MIX); bf16_t* const WOUT = (bf16_t*)(ws + WS_WOUT);
#ifndef SKIP_P4

        pg8::Gemm g{MIX, WOUT, NTOK, 1024, 1024}; SchedOut S{G, bx};
        EpiOut E{args.in[I_XP], args.in[I_XS], out, (LAS unsigned char*)lds};
        pg8::gemm_phase<EpiOut, SchedOut, true, true>((LAS unsigned char*)lds, g, S, E);
        if (G < 32) { asm volatile("s_waitcnt vmcnt(0) lgkmcnt(0)" ::: "memory"); __syncthreads();
            for (int k = bx; k < 16; k += G) { SchedOne S1{NTOK_P / 256 + (k >> 2), k & 3}; pg8::gemm_phase<EpiOut, SchedOne, true, true>((LAS unsigned char*)lds, g, S1, E); asm volatile("s_waitcnt vmcnt(0) lgkmcnt(0)" ::: "memory"); __syncthreads(); } }
#ifdef REP_P4
        asm volatile("s_waitcnt vmcnt(0) lgkmcnt(0)" ::: "memory"); __syncthreads();
        pg8::gemm_phase<EpiOut, SchedOut, true, true>((LAS unsigned char*)lds, g, S, E);
#endif
#endif
    }
#undef IN
#undef GRID_SYNC
}

extern "C" void kernel_launch(void* const* d_in, const int* in_sizes, int n_in, void* d_out, int out_size, void* d_ws, size_t ws_size, hipStream_t stream) {
    static int grid = 0;
    if (grid == 0) {
        if (n_in != 30 || (size_t)out_size != O_END || ws_size < WS_END) { fprintf(stderr, "kernel_launch: unexpected shapes (n_in %d out %d ws %zu)\n", n_in, out_size, ws_size); grid = -1; return; }
        int dev = 0, cus = 0, per_cu = 0;
        hipGetDevice(&dev); hipDeviceGetAttribute(&cus, hipDeviceAttributeMultiprocessorCount, dev);
        if (hipFuncSetAttribute((const void*)fwd_kernel, hipFuncAttributeMaxDynamicSharedMemorySize, LDS_BYTES) != hipSuccess) { fprintf(stderr, "kernel_launch: hipFuncSetAttribute failed\n"); grid = -1; return; }
        if (hipOccupancyMaxActiveBlocksPerMultiprocessor(&per_cu, (const void*)fwd_kernel, 512, LDS_BYTES) != hipSuccess || per_cu < 1) { fprintf(stderr, "kernel_launch: occupancy query says %d\n", per_cu); per_cu = 1; }
        (void)hipGetLastError();
        grid = cus;
    }
    if (grid < 0) return;
    Args a{};
    for (int i = 0; i < 30; ++i) a.in[i] = (const float*)d_in[i];
    a.out = (float*)d_out; a.ws = (unsigned char*)d_ws;
    a.rope_r0 = std::pow(500000.0, -1.0 / 8.0); a.inv2pi = 1.0 / (2.0 * M_PI);
#if MK_N_LAUNCHES == 1
    a.ph_lo = 0; a.ph_hi = 5;
    void* kargs[] = {&a};
    hipError_t e = hipLaunchCooperativeKernel((const void*)fwd_kernel, dim3(grid), dim3(512), kargs, LDS_BYTES, stream);
    if (e != hipSuccess) fprintf(stderr, "cooperative launch failed: %s (grid %d)\n", hipGetErrorString(e), grid);
#else
    for (int p = 0; p < 5; ++p) { a.ph_lo = p; a.ph_hi = p + 1; hipLaunchKernelGGL(fwd_kernel, dim3(grid), dim3(512), LDS_BYTES, stream, a); }
#endif
}
```

```cpp
#include <hip/hip_runtime.h>
#include <hip/hip_cooperative_groups.h>
#include <cstdio>
#include <cstdint>
#include <cmath>
namespace cg = cooperative_groups;
#ifndef MK_N_LAUNCHES
#define MK_N_LAUNCHES 1
#endif
namespace pg8 {
#define PG8_LAS __attribute__((address_space(3)))
typedef unsigned short bf16_t;
typedef short bf16x8 __attribute__((ext_vector_type(8)));
typedef float f32x4 __attribute__((ext_vector_type(4)));
typedef unsigned u32x4 __attribute__((ext_vector_type(4)));
constexpr int BM = 256, BK = 64, HALF = 128, HTB = HALF * BK * 2  , STAGE_BYTES = 8 * HTB, NXCD = 8, WGM = 8;

__host__ __device__ __forceinline__ int lds_byte(int r, int c) { const int st = (r >> 4) * 2 + (c >> 5), rr = r & 15, cc = c & 31, ob = rr * 64 + cc * 2; return st * 1024 + (ob ^ (((ob >> 9) & 1) << 5)); }
__host__ __device__ __forceinline__ void stage_rc(int b, int& R, int& C) { const int st = b / 1024, sb = b % 1024, swz = sb ^ (((sb >> 9) & 1) << 5); R = (st >> 1) * 16 + swz / 64; C = (st & 1) * 32 + (swz % 64) / 2; }
__host__ __device__ __forceinline__ int perm32(int rho) { const int n = rho >> 4, i = rho & 15; return 8 * (i >> 2) + 4 * n + (i & 3); }

struct Unit { int pm, pn; };
struct Gemm { const bf16_t* A; const bf16_t* Bt; int M, N, K; };

struct StaticOrder {
    int nM, nN, nwg, G, c;
    __host__ __device__ void init(int M, int N, int G_, int c_) { nM = M / BM; nN = N / BM; nwg = nM * nN; G = G_; c = c_; }
    __host__ __device__ bool next(int i, Unit& u) const {
        const long L = (long)i * G + c; if (L >= nwg) return false;
        int wgid = (int)L; { const int q = nwg / NXCD, r = nwg % NXCD, xcd = wgid % NXCD, off = wgid / NXCD; wgid = (xcd < r ? xcd * (q + 1) : r * (q + 1) + (xcd - r) * q) + off; }
        const int nig = WGM * nN, gid = wgid / nig, fm = gid * WGM, gsz = (nM - fm) < WGM ? (nM - fm) : WGM;
        u.pm = fm + ((wgid % nig) % gsz); u.pn = (wgid % nig) / gsz; return true;
    }
    __device__ __forceinline__ void a_ready(const Unit&) const {}
    __device__ __forceinline__ void done(const Unit&) const {}
};

__device__ __forceinline__ unsigned cvt_pk_bf16(float lo, float hi) { unsigned r; asm volatile("v_cvt_pk_bf16_f32 %0, %1, %2" : "=v"(r) : "v"(lo), "v"(hi)); return r; }
typedef float f32x2 __attribute__((ext_vector_type(2)));
template <class Epi, class Sched, bool ALIGN_EPI = false, bool SP2 = false>
__device__ __forceinline__ void gemm_phase(PG8_LAS unsigned char* lds, const Gemm g, const Sched& S, const Epi& E) {
    const int tid = threadIdx.x, wid = __builtin_amdgcn_readfirstlane(tid >> 6), lane = tid & 63, wr = wid >> 2, wc = wid & 3, fr = lane & 15, fq = lane >> 4;
    const int K = g.K, nt = K / BK;
    unsigned voffA[2], voffB[2];
#pragma unroll
    for (int i = 0; i < 2; ++i) { int R, C; stage_rc(tid * 16 + i * 8192, R, C); const int Rb = Epi::PERM ? ((R & ~31) + perm32(R & 31)) : R;
        voffA[i] = (unsigned)(R * K + C) * 2u; voffB[i] = (unsigned)(Rb * K + C) * 2u; }
    const size_t kstep = (size_t)(BK * 2);
    const size_t hstep = (size_t)HALF * K * 2;
    const size_t tstep = 2 * hstep;
    const unsigned ldsw = (unsigned)wid * 1024u;
    const int aoff = lds_byte(wr * 64 + fr, fq * 8), boff = lds_byte(wc * 32 + fr, fq * 8);
#define PG8_SA(b, h) (((b) * 2 + (h)) * HTB)
#define PG8_SB(b, h) ((4 + (b) * 2 + (h)) * HTB)
#define PG8_STAGE(bufoff, gbase, voff) do { _Pragma("unroll") for (int _i = 0; _i < 2; ++_i) \
        __builtin_amdgcn_global_load_lds((const unsigned*)((const char*)(gbase) + (voff)[_i]), (PG8_LAS unsigned*)(lds + (bufoff) + ldsw + _i * 8192), 16, 0, 0); } while (0)
#define PG8_LDA(dst, b, h) do { _Pragma("unroll") for (int m = 0; m < 4; ++m) _Pragma("unroll") for (int k = 0; k < 2; ++k) dst[m][k] = *(const PG8_LAS bf16x8*)(lds + PG8_SA(b, h) + aoff + m * 2048 + k * 1024); } while (0)
#define PG8_LDB(dst, b, h) do { _Pragma("unroll") for (int n = 0; n < 2; ++n) _Pragma("unroll") for (int k = 0; k < 2; ++k) dst[n][k] = *(const PG8_LAS bf16x8*)(lds + PG8_SB(b, h) + boff + n * 2048 + k * 1024); } while (0)
#define PG8_MMA(ai, bj, At, Bt) do { __builtin_amdgcn_s_setprio(1); _Pragma("unroll") for (int m = 0; m < 4; ++m) _Pragma("unroll") for (int n = 0; n < 2; ++n) _Pragma("unroll") for (int k = 0; k < 2; ++k) \
        acc[ai][bj][m][n] = __builtin_amdgcn_mfma_f32_16x16x32_bf16(Bt[n][k], At[m][k], acc[ai][bj][m][n], 0, 0, 0); __builtin_amdgcn_s_setprio(0); } while (0)
#define PG8_WAIT_V(n) asm volatile("s_waitcnt vmcnt(" #n ")" ::: "memory")
#define PG8_WAIT_L(n) asm volatile("s_waitcnt lgkmcnt(" #n ")" ::: "memory")
#define PG8_BAR __builtin_amdgcn_s_barrier()
#define PG8_SCHED __builtin_amdgcn_sched_barrier(0)
    Unit cur, nxt; int ui = 0;
    if (!S.next(0, cur)) return;
    f32x4 acc[2][2][4][2];
    E.init(acc, cur, wr, wc, fr, fq);
    bf16x8 At[4][2], B0[2][2], B1[2][2];
    const char* cA = (const char*)g.A + (size_t)cur.pm * tstep; const char* cB = (const char*)g.Bt + (size_t)cur.pn * tstep;
    S.a_ready(cur);
    if constexpr (SP2) {
        PG8_STAGE(PG8_SB(0, 0), cB, voffB); PG8_STAGE(PG8_SB(0, 1), cB + hstep, voffB); PG8_STAGE(PG8_SA(0, 0), cA, voffA); PG8_STAGE(PG8_SA(0, 1), cA + hstep, voffA);
        if (wr == 1) PG8_BAR;
        PG8_WAIT_V(2); PG8_BAR;
        PG8_STAGE(PG8_SB(1, 0), cB + kstep, voffB); PG8_STAGE(PG8_SA(1, 0), cA + kstep, voffA); PG8_STAGE(PG8_SB(1, 1), cB + hstep + kstep, voffB);
        PG8_WAIT_V(6); PG8_BAR;
    } else {
        PG8_STAGE(PG8_SB(0, 0), cB, voffB); PG8_STAGE(PG8_SA(0, 0), cA, voffA); PG8_STAGE(PG8_SB(0, 1), cB + hstep, voffB); PG8_STAGE(PG8_SA(0, 1), cA + hstep, voffA);
        if (wr == 1) PG8_BAR;
        PG8_WAIT_V(4); PG8_BAR;
        PG8_STAGE(PG8_SB(1, 0), cB + kstep, voffB); PG8_STAGE(PG8_SA(1, 0), cA + kstep, voffA); PG8_STAGE(PG8_SB(1, 1), cB + hstep + kstep, voffB);
        PG8_WAIT_V(6); PG8_BAR;
    }
    for (;;) {
        const bool has_next = S.next(ui + 1, nxt);
        const char* nA = has_next ? (const char*)g.A + (size_t)nxt.pm * tstep : cA; const char* nB = has_next ? (const char*)g.Bt + (size_t)nxt.pn * tstep : cB;
        for (int t = 0; t < nt; t += 2) {
            const bool last = (t == nt - 2);
            const char* a1 = cA + (size_t)(t + 1) * kstep;
            const char* a2 = last ? nA : cA + (size_t)(t + 2) * kstep; const char* b2 = last ? nB : cB + (size_t)(t + 2) * kstep;
            const char* a3 = a2 + kstep; const char* b3 = b2 + kstep;
            if (last && has_next) S.a_ready(nxt);
            if constexpr (SP2) {
            PG8_LDB(B0, 0, 0); PG8_LDB(B1, 0, 1); PG8_SCHED; PG8_LDA(At, 0, 0); PG8_STAGE(PG8_SA(1, 1), a1 + hstep, voffA);
            PG8_WAIT_V(8); PG8_WAIT_L(0); PG8_BAR; PG8_MMA(0, 0, At, B0); PG8_MMA(0, 1, At, B1); PG8_BAR; PG8_SCHED;
            PG8_LDA(At, 0, 1); PG8_STAGE(PG8_SB(0, 0), b2, voffB); PG8_STAGE(PG8_SB(0, 1), b2 + hstep, voffB); PG8_STAGE(PG8_SA(0, 0), a2, voffA);
            PG8_WAIT_V(8); PG8_WAIT_L(0); PG8_BAR; PG8_MMA(1, 0, At, B0); PG8_MMA(1, 1, At, B1); PG8_BAR; PG8_SCHED;
            PG8_LDB(B0, 1, 0); PG8_LDB(B1, 1, 1); PG8_SCHED; PG8_LDA(At, 1, 0); PG8_STAGE(PG8_SA(0, 1), a2 + hstep, voffA);
            PG8_WAIT_V(8); PG8_WAIT_L(0); PG8_BAR; PG8_MMA(0, 0, At, B0); PG8_MMA(0, 1, At, B1); PG8_BAR; PG8_SCHED;
            PG8_LDA(At, 1, 1); PG8_STAGE(PG8_SB(1, 0), b3, voffB); PG8_STAGE(PG8_SB(1, 1), b3 + hstep, voffB); PG8_STAGE(PG8_SA(1, 0), a3, voffA);
            PG8_WAIT_V(8); PG8_WAIT_L(0); PG8_BAR; PG8_MMA(1, 0, At, B0); PG8_MMA(1, 1, At, B1); PG8_BAR; PG8_SCHED;
            } else {
            PG8_LDB(B0, 0, 0); PG8_SCHED; PG8_LDA(At, 0, 0); PG8_STAGE(PG8_SA(1, 1), a1 + hstep, voffA);
            PG8_WAIT_L(8); PG8_BAR; PG8_WAIT_L(0); PG8_MMA(0, 0, At, B0); PG8_BAR; PG8_SCHED;
            PG8_LDB(B1, 0, 1); PG8_STAGE(PG8_SB(0, 0), b2, voffB);
            PG8_BAR; PG8_WAIT_L(0); PG8_MMA(0, 1, At, B1); PG8_BAR;
            PG8_LDA(At, 0, 1); PG8_STAGE(PG8_SA(0, 0), a2, voffA);
            PG8_BAR; PG8_WAIT_L(0); PG8_MMA(1, 0, At, B0); PG8_BAR; PG8_SCHED;
            PG8_STAGE(PG8_SB(0, 1), b2 + hstep, voffB);
            PG8_WAIT_V(6); PG8_BAR; PG8_MMA(1, 1, At, B1); PG8_BAR;
            PG8_LDB(B0, 1, 0); PG8_SCHED; PG8_LDA(At, 1, 0); PG8_STAGE(PG8_SA(0, 1), a2 + hstep, voffA);
            PG8_WAIT_L(8); PG8_BAR; PG8_WAIT_L(0); PG8_MMA(0, 0, At, B0); PG8_BAR; PG8_SCHED;
            PG8_LDB(B1, 1, 1); PG8_STAGE(PG8_SB(1, 0), b3, voffB);
            PG8_BAR; PG8_WAIT_L(0); PG8_MMA(0, 1, At, B1); PG8_BAR;
            PG8_LDA(At, 1, 1); PG8_STAGE(PG8_SA(1, 0), a3, voffA);
            PG8_BAR; PG8_WAIT_L(0); PG8_MMA(1, 0, At, B0); PG8_BAR; PG8_SCHED;
            PG8_STAGE(PG8_SB(1, 1), b3 + hstep, voffB);
            PG8_WAIT_V(6); PG8_BAR; PG8_MMA(1, 1, At, B1); PG8_BAR;
            }
        }
        if constexpr (ALIGN_EPI) { if (wr == 0) PG8_BAR; }
        if constexpr (!Epi::AFTER_DRAIN) { E(acc, cur, wr, wc, fr, fq); S.done(cur); }
        if (!has_next) break;
        E.init(acc, nxt, wr, wc, fr, fq);
        cur = nxt; cA = nA; cB = nB; ++ui;
        if constexpr (ALIGN_EPI) { if (wr == 1) PG8_BAR; }
    }
    PG8_WAIT_V(0);
    if constexpr (!ALIGN_EPI) { if (wr == 0) PG8_BAR; }
    PG8_BAR;
    if constexpr (Epi::AFTER_DRAIN) { E.fused(acc, cur, wr, wc, fr, fq, lds, wid, lane); S.done(cur); }
#undef PG8_SA
#undef PG8_SB
#undef PG8_STAGE
#undef PG8_LDA
#undef PG8_LDB
#undef PG8_MMA
#undef PG8_WAIT_V
#undef PG8_WAIT_L
#undef PG8_BAR
#undef PG8_SCHED
}
}

constexpr int NB = 8, SEQ = 8192, SBAT = 32, STOK = 32, PAST = 1024;
constexpr int NTOK_P = NB * SEQ;
constexpr int NTOK_S = SBAT * STOK;
constexpr int NTOK = NTOK_P + NTOK_S;
constexpr int NMEMROW = NB * 256;
constexpr int AROWS = NTOK + NMEMROW;
constexpr int KSROWS = 1088;
constexpr float EPSN = 1e-6f;
constexpr float C2 = 0.125f * 1.4426950408889634f;
constexpr float ONE_M_LINIT = 0.8f, LAMBDA_INIT = 0.2f;
constexpr size_t O_YP = 0;
constexpr size_t O_YS = O_YP + (size_t)NTOK_P * 1024;
constexpr size_t O_KP = O_YS + (size_t)NTOK_S * 1024;
constexpr size_t O_VP = O_KP + (size_t)NTOK_P * 512;
constexpr size_t O_MK = O_VP + (size_t)NTOK_P * 512;
constexpr size_t O_MV = O_MK + (size_t)NMEMROW * 256;
constexpr size_t O_CP = O_MV + (size_t)NMEMROW * 256;
constexpr size_t O_HP = O_CP + 8 * 3 * 256;
constexpr size_t O_KS = O_HP + 8 * 256;
constexpr size_t O_VS = O_KS + (size_t)NTOK_S * 512;
constexpr size_t O_CS = O_VS + (size_t)NTOK_S * 512;
constexpr size_t O_HS = O_CS + 32 * 3 * 256;
constexpr size_t O_END = O_HS + 32 * 256;
constexpr size_t MiB = 1u << 20;
constexpr size_t WS_WIN = 0, WS_WOUT = 8 * MiB, WS_ROPE = 10 * MiB, WS_GAIN = 10 * MiB + 768 * 1024, WS_BAR = 10 * MiB + 800 * 1024, WS_SEGA = 11 * MiB, WS_SEGH = 12 * MiB, WS_AALL = 16 * MiB,
                 WS_QB = 152 * MiB, WS_KB = 218 * MiB, WS_VB = 282 * MiB, WS_KS = 346 * MiB, WS_VS = 382 * MiB, WS_MIX = 418 * MiB,
                 WS_LX = 548 * MiB, WS_MQ = 614 * MiB, WS_MKA = 648 * MiB, WS_MVA = 654 * MiB, WS_HL = 660 * MiB, WS_AC = 724 * MiB, WS_END = 788 * MiB;
#ifndef STAG_P1
#define STAG_P1 2000u
#endif
#ifndef STAG_P4
#define STAG_P4 1400u
#endif
constexpr int LDS_BYTES = 163840;
constexpr int LDS_TR = 131072, LDS_TA = 139264, LDS_GAIN = 143360, LDS_STG = 144384;
constexpr int LDS_WSF = 133120;
constexpr int RED_SLOT_F = 33280 / 4;

typedef unsigned short bf16_t;
typedef float f32x4 __attribute__((ext_vector_type(4)));
typedef float f32x2v __attribute__((ext_vector_type(2)));
typedef unsigned u32x4 __attribute__((ext_vector_type(4)));
typedef unsigned u32x2 __attribute__((ext_vector_type(2)));
#define LAS __attribute__((address_space(3)))

__device__ __forceinline__ unsigned f2bf(float f) { unsigned u = __builtin_bit_cast(unsigned, f); return (u + 0x7fffu + ((u >> 16) & 1u)) >> 16; }
__device__ __forceinline__ unsigned pk2(float lo, float hi) { return f2bf(lo) | (f2bf(hi) << 16); }
__device__ __forceinline__ unsigned hw_pk2(float lo, float hi) { typedef float f2_t __attribute__((ext_vector_type(2))); typedef __bf16 b2_t __attribute__((ext_vector_type(2)));
    f2_t v = {lo, hi}; b2_t b = __builtin_convertvector(v, b2_t); return __builtin_bit_cast(unsigned, b); }
__device__ __forceinline__ float bf2f(unsigned short b) { return __builtin_bit_cast(float, (unsigned)b << 16); }
__device__ __forceinline__ float fast_exp(float x) { return __builtin_amdgcn_exp2f(x * 1.4426950408889634f); }
__device__ __forceinline__ float sigmoidf_(float x) { return __builtin_amdgcn_rcpf(1.0f + fast_exp(-x)); }
__device__ __forceinline__ float siluf_(float x) { return x * sigmoidf_(x); }
template <int M> __device__ __forceinline__ float lane_xor(float v) { return __builtin_bit_cast(float, __builtin_amdgcn_ds_swizzle(__builtin_bit_cast(int, v), (M << 10) | 0x1f)); }
__device__ __forceinline__ float sum_xor32(float v) { const unsigned u = __builtin_bit_cast(unsigned, v); auto rr = __builtin_amdgcn_permlane32_swap(u, u, false, false);
    return __builtin_bit_cast(float, (unsigned)rr[0]) + __builtin_bit_cast(float, (unsigned)rr[1]); }
__device__ __forceinline__ float sum32(float v) { v += lane_xor<1>(v); v += lane_xor<2>(v); v += lane_xor<4>(v); v += lane_xor<8>(v); v += lane_xor<16>(v); return v; }
__device__ __forceinline__ float wave_sum(float v) { return sum_xor32(sum32(v)); }
__device__ __forceinline__ void st_bf16x8(bf16_t* p, const float (&v)[8]) {
    u32x4 w; w.x = hw_pk2(v[0], v[1]); w.y = hw_pk2(v[2], v[3]); w.z = hw_pk2(v[4], v[5]); w.w = hw_pk2(v[6], v[7]); *(u32x4*)p = w;
}
__device__ __forceinline__ void st_f32x8(float* p, const float (&v)[8]) {
    *(f32x4*)p = (f32x4){v[0], v[1], v[2], v[3]}; *(f32x4*)(p + 4) = (f32x4){v[4], v[5], v[6], v[7]};
}

__device__ __forceinline__ void stage_store_f32(LAS float* st, int fr, int fq, const float (&v)[8], float* gbase, size_t pitch) {
    *(LAS f32x4*)(st + fr * 36 + 8 * fq) = (f32x4){v[0], v[1], v[2], v[3]}; *(LAS f32x4*)(st + fr * 36 + 8 * fq + 4) = (f32x4){v[4], v[5], v[6], v[7]};
    asm volatile("s_waitcnt lgkmcnt(0)" ::: "memory");
    int lane = fr + 16 * fq; asm volatile("" : "+v"(lane));
    const int tr = lane >> 3, tc = 4 * (lane & 7);
    const f32x4 t0 = *(LAS const f32x4*)(st + tr * 36 + tc), t1 = *(LAS const f32x4*)(st + (8 + tr) * 36 + tc);
    asm volatile("s_waitcnt lgkmcnt(0)" ::: "memory");
    *(f32x4*)(gbase + (size_t)tr * pitch + tc) = t0; *(f32x4*)(gbase + (size_t)(8 + tr) * pitch + tc) = t1;
}

struct SchedIn {
    int G, c;
    __device__ bool next(int i, pg8::Unit& u) const {
        const long L = (long)i * G + c; constexpr int nM = NTOK / 256, nN = 12, nwg = nM * nN;
        if (L >= nwg + 16) return false;
        if (L >= nwg) { const int r = (int)L - nwg; u.pm = nM + (r >> 1); u.pn = 12 + (r & 1); return true; }
        int wgid = (int)L; { const int q = nwg / 8, xcd = wgid % 8, off = wgid / 8; wgid = xcd * q + off; }
        const int nig = 8 * nN, gid = wgid / nig, fm = gid * 8, gsz = (nM - fm) < 8 ? (nM - fm) : 8;
        u.pm = fm + ((wgid % nig) % gsz); u.pn = (wgid % nig) / gsz; return true;
    }
    __device__ __forceinline__ void a_ready(const pg8::Unit&) const {}
    __device__ __forceinline__ void done(const pg8::Unit&) const {}
};
struct SchedOut {
    int G, c;
    __device__ bool next(int i, pg8::Unit& u) const {
        const long L = (long)i * G + c; constexpr int nM = NTOK_P / 256, nN = 4, nwg = nM * nN;
        if (L >= nwg) return false;
        int wgid = (int)L; { const int q = nwg / 8, xcd = wgid % 8, off = wgid / 8; wgid = xcd * q + off; }
        const int nig = 8 * nN, gid = wgid / nig, fm = gid * 8, gsz = (nM - fm) < 8 ? (nM - fm) : 8;
        u.pm = fm + ((wgid % nig) % gsz); u.pn = (wgid % nig) / gsz; return true;
    }
    __device__ __forceinline__ void a_ready(const pg8::Unit&) const {}
    __device__ __forceinline__ void done(const pg8::Unit&) const {}
};

struct SchedOne {
    int pm, pn;
    __device__ bool next(int i, pg8::Unit& u) const { if (i > 0) return false; u.pm = pm; u.pn = pn; return true; }
    __device__ __forceinline__ void a_ready(const pg8::Unit&) const {}
    __device__ __forceinline__ void done(const pg8::Unit&) const {}
};
struct EpiIn {
    static constexpr bool PERM = true, AFTER_DRAIN = false;
    __device__ __forceinline__ void init(f32x4 (&acc)[2][2][4][2], const pg8::Unit&, int, int, int, int) const {
#pragma unroll
        for (int a = 0; a < 2; ++a)
#pragma unroll
            for (int b = 0; b < 2; ++b)
#pragma unroll
                for (int m = 0; m < 4; ++m)
#pragma unroll
                    for (int n = 0; n < 2; ++n) acc[a][b][m][n] = (f32x4){0.f, 0.f, 0.f, 0.f};
    }
    unsigned char* ws; float* out; LAS unsigned char* ldsb;
    __device__ __forceinline__ void operator()(const f32x4 (&acc)[2][2][4][2], const pg8::Unit& u, int wr, int wc, int fr, int fq) const {
        bf16_t* const Qb = (bf16_t*)(ws + WS_QB); bf16_t* const Kb = (bf16_t*)(ws + WS_KB); bf16_t* const Vb = (bf16_t*)(ws + WS_VB); bf16_t* const KS = (bf16_t*)(ws + WS_KS); bf16_t* const VS = (bf16_t*)(ws + WS_VS);
        bf16_t* const MIX = (bf16_t*)(ws + WS_MIX); bf16_t* const MQ = (bf16_t*)(ws + WS_MQ); bf16_t* const MKA = (bf16_t*)(ws + WS_MKA); bf16_t* const MVA = (bf16_t*)(ws + WS_MVA);
        float* const LX = (float*)(ws + WS_LX);
        const int pn = u.pn;
        LAS float* const stg = (LAS float*)(ldsb + LDS_STG) + (wr * 4 + wc) * 576;
        const int cl0 = 64 * wc + 8 * fq;
        const int rb = u.pm * 256 + wr * 64 + fr;
        LAS const float* g = nullptr;
        { LAS const float* const gains = (LAS const float*)(ldsb + LDS_GAIN); if (pn < 2) g = gains; else if (pn < 4) g = gains + 64; else if (pn == 10) g = gains + 128; else if (pn == 12) g = gains + 192; }
        float gv[2][8];
#pragma unroll
        for (int bj = 0; bj < 2; ++bj)
#pragma unroll
            for (int k = 0; k < 8; ++k) gv[bj][k] = g ? g[32 * bj + 8 * fq + k] : 1.f;
#pragma unroll
        for (int ai = 0; ai < 2; ++ai)
#pragma unroll
            for (int m = 0; m < 4; ++m) {
                const int row = rb + ai * 128 + m * 16;
                float v[2][8];
#pragma unroll
                for (int bj = 0; bj < 2; ++bj)
#pragma unroll
                    for (int n = 0; n < 2; ++n)
#pragma unroll
                        for (int e = 0; e < 4; ++e) v[bj][4 * n + e] = acc[ai][bj][m][n][e];
                if (g) {
                    float ss = 0.f;
#pragma unroll
                    for (int bj = 0; bj < 2; ++bj)
#pragma unroll
                        for (int k = 0; k < 8; ++k) ss += v[bj][k] * v[bj][k];
                    ss += lane_xor<16>(ss); ss = sum_xor32(ss);
                    const float rs = __builtin_amdgcn_rsqf(ss * (1.0f / 64.0f) + EPSN);
#pragma unroll
                    for (int bj = 0; bj < 2; ++bj)
#pragma unroll
                        for (int k = 0; k < 8; ++k) v[bj][k] *= rs * gv[bj][k];
                    if (pn < 4) {
                        const int pos = row < NTOK_P ? (row & (SEQ - 1)) : (PAST + (row & 31));
                        float pv[8];
#pragma unroll
                        for (int k = 0; k < 8; ++k) pv[k] = lane_xor<16>(v[0][k]);
                        if (fq < 2) {
                            LAS const f32x2v* tr = (LAS const f32x2v*)(ldsb + LDS_TR) + (pos & 127) * 8; LAS const f32x2v* ta = (LAS const f32x2v*)(ldsb + LDS_TA) + (pos >> 7) * 8;
#pragma unroll
                            for (int k = 0; k < 8; ++k) { const f32x2v R = tr[k], A = ta[k]; const float cc = A.x * R.x - A.y * R.y, sn = A.y * R.x + A.x * R.y;
                                v[0][k] = fq == 0 ? (v[0][k] * cc - pv[k] * sn) : (v[0][k] * cc + pv[k] * sn); }
                        }
                    }
                }
                if (pn < 2) {
#pragma unroll
                    for (int bj = 0; bj < 2; ++bj) { float o[8];
#pragma unroll
                        for (int k = 0; k < 8; ++k) o[k] = v[bj][k] * C2;
                        st_bf16x8(Qb + (size_t)row * 512 + 256 * pn + cl0 + 32 * bj, o); }
                } else if (pn < 6) {
                    const bool isk = pn < 4; const int col = 256 * (pn - (isk ? 2 : 4)) + cl0;
                    float* of; bf16_t* ob;
                    if (row < NTOK_P) { of = out + (isk ? O_KP : O_VP) + (size_t)row * 512 + col; ob = (isk ? Kb : Vb) + (size_t)row * 512 + col; }
                    else { const int rs_ = row - NTOK_P; of = out + (isk ? O_KS : O_VS) + (size_t)rs_ * 512 + col;
                           ob = (isk ? KS : VS) + ((size_t)(rs_ >> 5) * KSROWS + PAST + (rs_ & 31)) * 512 + col; }
                    float* const gb = of - (size_t)fr * 512 - 8 * fq;
#pragma unroll
                    for (int bj = 0; bj < 2; ++bj) { stage_store_f32(stg, fr, fq, v[bj], gb + 32 * bj, 512); st_bf16x8(ob + 32 * bj, v[bj]); }
                } else if (pn == 8) {
                    float* const gb = LX + (size_t)(row - fr) * 256 + 64 * wc;
#pragma unroll
                    for (int bj = 0; bj < 2; ++bj) stage_store_f32(stg, fr, fq, v[bj], gb + 32 * bj, 256);
                } else if (pn == 10) {
#pragma unroll
                    for (int bj = 0; bj < 2; ++bj) { float o[8];
#pragma unroll
                        for (int k = 0; k < 8; ++k) o[k] = v[bj][k] * C2;
                        st_bf16x8(MQ + (size_t)row * 256 + cl0 + 32 * bj, o); }
                } else if (pn >= 12) {
                    const int rm = row - NTOK;
#pragma unroll
                    for (int bj = 0; bj < 2; ++bj) { st_f32x8(out + (pn == 12 ? O_MK : O_MV) + (size_t)rm * 256 + cl0 + 32 * bj, v[bj]);
                        st_bf16x8((pn == 12 ? MKA : MVA) + (size_t)rm * 256 + cl0 + 32 * bj, v[bj]); }
                } else {
                    const int colb = pn == 6 ? 0 : pn == 7 ? 256 : pn == 9 ? 512 : 768;
#pragma unroll
                    for (int bj = 0; bj < 2; ++bj) { float o[8];
#pragma unroll
                        for (int k = 0; k < 8; ++k) o[k] = siluf_(v[bj][k]);
                        st_bf16x8(MIX + (size_t)row * 1024 + colb + cl0 + 32 * bj, o); }
                }
            }
    }
};
struct EpiOut {
    static constexpr bool PERM = true, AFTER_DRAIN = false;
    const float *xp, *xs; float* out; LAS unsigned char* ldsb;
    __device__ __forceinline__ void init(f32x4 (&acc)[2][2][4][2], const pg8::Unit& u, int wr, int wc, int fr, int fq) const {
        const int lane = fr + 16 * fq; LAS float* st = (LAS float*)(ldsb + LDS_TR) + (wr * 4 + wc) * 576;
        const int tr = lane >> 3, tc = 4 * (lane & 7);
#pragma unroll
        for (int ai = 0; ai < 2; ++ai)
#pragma unroll
            for (int m = 0; m < 4; ++m)
#pragma unroll
                for (int bj = 0; bj < 2; ++bj) {
                    int trr = tr; asm volatile("" : "+v"(trr));
                    const int row0 = u.pm * 256 + ai * 128 + wr * 64 + m * 16, col = 256 * u.pn + 64 * wc + 32 * bj + tc;
#pragma unroll
                    for (int j2 = 0; j2 < 2; ++j2) { const int row = row0 + 8 * j2 + trr;
                        acc[ai][bj][m][j2] = *(const f32x4*)((row < NTOK_P ? xp + (size_t)row * 1024 : xs + (size_t)(row - NTOK_P) * 1024) + col); }
                }
#pragma unroll
        for (int ai = 0; ai < 2; ++ai)
#pragma unroll
            for (int m = 0; m < 4; ++m)
#pragma unroll
                for (int bj = 0; bj < 2; ++bj) {
#pragma unroll
                    for (int j2 = 0; j2 < 2; ++j2) *(LAS f32x4*)(st + (8 * j2 + tr) * 36 + tc) = acc[ai][bj][m][j2];
                    asm volatile("s_waitcnt lgkmcnt(0)" ::: "memory");
#pragma unroll
                    for (int n = 0; n < 2; ++n) acc[ai][bj][m][n] = *(LAS const f32x4*)(st + fr * 36 + 8 * fq + 4 * n);
                    asm volatile("s_waitcnt lgkmcnt(0)" ::: "memory");
                }
    }
    __device__ __forceinline__ void operator()(const f32x4 (&acc)[2][2][4][2], const pg8::Unit& u, int wr, int wc, int fr, int fq) const {
        const int lane = fr + 16 * fq; LAS float* st = (LAS float*)(ldsb + LDS_TR) + (wr * 4 + wc) * 576;
        const int tr = lane >> 3, tc = 4 * (lane & 7);
#pragma unroll
        for (int ai = 0; ai < 2; ++ai)
#pragma unroll
            for (int m = 0; m < 4; ++m)
#pragma unroll
                for (int bj = 0; bj < 2; ++bj) {
#pragma unroll
                    for (int n = 0; n < 2; ++n) *(LAS f32x4*)(st + fr * 36 + 8 * fq + 4 * n) = acc[ai][bj][m][n];
                    asm volatile("s_waitcnt lgkmcnt(0)" ::: "memory");
                    int trr = tr; asm volatile("" : "+v"(trr));
                    const int row0 = u.pm * 256 + ai * 128 + wr * 64 + m * 16, col = 256 * u.pn + 64 * wc + 32 * bj + tc;
                    f32x4 t[2];
#pragma unroll
                    for (int j2 = 0; j2 < 2; ++j2) t[j2] = *(LAS const f32x4*)(st + (8 * j2 + tr) * 36 + tc);
                    asm volatile("s_waitcnt lgkmcnt(0)" ::: "memory");
#pragma unroll
                    for (int j2 = 0; j2 < 2; ++j2) *(f32x4*)(out + (size_t)(row0 + 8 * j2 + trr) * 1024 + col) = t[j2];
                }
    }
};

namespace att {
typedef short bf16x8 __attribute__((ext_vector_type(8)));
typedef short s16x4 __attribute__((ext_vector_type(4)));
typedef float f32x16 __attribute__((ext_vector_type(16)));
typedef float f32x2_t __attribute__((ext_vector_type(2)));
typedef __bf16 bf16x2_t __attribute__((ext_vector_type(2)));
__device__ __forceinline__ unsigned cvtpk(float lo, float hi) { f32x2_t v = {lo, hi}; bf16x2_t b = __builtin_convertvector(v, bf16x2_t); return __builtin_bit_cast(unsigned, b); }
__device__ __forceinline__ void glds16(const void* gsrc, unsigned lds_dst) { unsigned keep;
    asm volatile("s_mov_b32 %0, m0\n\ts_mov_b32 m0, %2\n\ts_nop 0\n\tglobal_load_lds_dwordx4 %1, off\n\ts_mov_b32 m0, %0" : "=&s"(keep) : "v"(gsrc), "s"(lds_dst) : "memory"); }
#define ATT_WAIT_BAR() asm volatile("s_waitcnt vmcnt(0) lgkmcnt(0)\n\ts_barrier" ::: "memory")
#ifndef ATT_PRIO
#define ATT_PRIO(x) do {} while (0)
#endif
#define ATT_LBAR() asm volatile("s_waitcnt lgkmcnt(0)\n\ts_barrier" ::: "memory")
__device__ __forceinline__ s16x4 vtr(LAS const unsigned char* p) { typedef short v4i16_t __attribute__((ext_vector_type(4)));
    return __builtin_bit_cast(s16x4, __builtin_amdgcn_ds_read_tr16_b64_v4i16((LAS v4i16_t*)p)); }
__device__ __forceinline__ int crow(int r, int hh) { return (r & 3) + 8 * (r >> 2) + 4 * hh; }

template <int NC, int DV>
__device__ __forceinline__ void attn_loop(unsigned char* ldsg, const bf16_t* Qrow, const unsigned char* Kg, const unsigned char* Vg, int kvstride, int NT, int last_nh, int mode, int wpar, int c,
                                          f32x16 (&O)[DV / 32], float& l) {
    constexpr int KROW = NC * 128, VROW = DV * 2, KT = 64 * KROW, VT = 64 * VROW, BUF = KT + VT, KPW = KT / 8192, VPW = VT / 8192, PPW = KPW + VPW;
    const int tid = threadIdx.x, lane = tid & 63, r32 = lane & 31, hh = lane >> 5; const int w = __builtin_amdgcn_readfirstlane(tid >> 6);
    LAS const unsigned char* lds3 = (LAS const unsigned char*)ldsg; const unsigned lds0 = (unsigned)(uintptr_t)ldsg;
    unsigned ksrc[KPW], vsrc[VPW];
#pragma unroll
    for (int i = 0; i < KPW; ++i) { const int pos = 64 * (KPW * w + i) + lane; constexpr int CPR = KROW / 16; const int row = pos / CPR, cp = pos % CPR;
        const int cc = cp ^ (KROW == 256 ? (row & 15) : ((row >> 1) & 7)); ksrc[i] = (unsigned)(row * kvstride + cc * 16); }
#pragma unroll
    for (int i = 0; i < VPW; ++i) { const int pos = 64 * (VPW * w + i) + lane; constexpr int CPR = VROW / 16; const int row = pos / CPR, cp = pos % CPR;
        const int cc = cp ^ (VROW == 256 ? 4 * (row & 3) : 4 * ((row >> 1) & 1)); vsrc[i] = (unsigned)(row * kvstride + cc * 16); }
#define ATT_ISSUE(j) do { const size_t tb_ = (size_t)(j) * 64 * (size_t)kvstride; const unsigned sb_ = lds0 + ((j) & 3) * BUF; \
        _Pragma("unroll") for (int i_ = 0; i_ < KPW; ++i_) glds16(Kg + tb_ + ksrc[i_], (unsigned)__builtin_amdgcn_readfirstlane(sb_ + 1024 * (KPW * w + i_))); \
        _Pragma("unroll") for (int i_ = 0; i_ < VPW; ++i_) glds16(Vg + tb_ + vsrc[i_], (unsigned)__builtin_amdgcn_readfirstlane(sb_ + KT + 1024 * (VPW * w + i_))); } while (0)
    bf16x8 q[4];
#pragma unroll
    for (int ks = 0; ks < 4; ++ks) q[ks] = *(const bf16x8*)(Qrow + c * 64 + ks * 16 + hh * 8);
    ATT_ISSUE(0); if (NT > 1) ATT_ISSUE(1); if (NT > 2) ATT_ISSUE(2);
    asm volatile("" : "+v"(q[0]), "+v"(q[1]), "+v"(q[2]), "+v"(q[3]) :: "memory");
    const int kx = KROW == 256 ? (r32 & 15) : ((r32 >> 1) & 7);
    const int kb = r32 * KROW + ((hh ^ (kx & 1)) << 4), kxh = (kx & ~1) << 4, cb = c << 7;
    const int L = lane & 15, gp = (lane >> 4) & 1, sw = VROW == 256 ? ((L >> 2) & 3) : ((L >> 3) & 1);
    int vo[DV / 32];
#pragma unroll
    for (int db = 0; db < DV / 32; ++db) vo[db] = (4 * hh + (L >> 2)) * VROW + ((((db ^ sw) << 2) + 2 * gp + ((L & 3) >> 1)) << 4) + 8 * (L & 1);
#pragma nounroll
    for (int j = 0; j < NT; ++j) {
        {   const int rem = NT - 1 - j;
            if (rem >= 2) { if constexpr (PPW == 4) asm volatile("s_waitcnt vmcnt(8) lgkmcnt(0)\n\ts_barrier" ::: "memory"); else asm volatile("s_waitcnt vmcnt(4) lgkmcnt(0)\n\ts_barrier" ::: "memory"); }
            else if (rem == 1) { if constexpr (PPW == 4) asm volatile("s_waitcnt vmcnt(4) lgkmcnt(0)\n\ts_barrier" ::: "memory"); else asm volatile("s_waitcnt vmcnt(2) lgkmcnt(0)\n\ts_barrier" ::: "memory"); }
            else asm volatile("s_waitcnt vmcnt(0) lgkmcnt(0)\n\ts_barrier" ::: "memory"); }
        if (j + 3 < NT) ATT_ISSUE(j + 3);
        const bool active = mode == 0 ? (j <= wpar) : mode == 1 ? ((j & 3) == wpar) : ((j >> 1) == wpar);
        if (active) {
            const int nh = (j == NT - 1) ? last_nh : 2;
            LAS const unsigned char* Kt = lds3 + (j & 3) * BUF; LAS const unsigned char* Vt = Kt + KT;
#pragma unroll
            for (int kh = 0; kh < 2; ++kh) {
                if (kh < nh) {
                    f32x16 X = {};
                    ATT_PRIO(1);
#pragma unroll
                    for (int ks = 0; ks < 4; ++ks) {
                        const int co = kb + ((cb + (ks << 5)) ^ kxh) + kh * 32 * KROW;
                        const bf16x8 a0 = *(LAS const bf16x8*)(Kt + co);
                        X = __builtin_amdgcn_mfma_f32_32x32x16_bf16(a0, q[ks], X, 0, 0, 0);
                    }
                    ATT_PRIO(0);
                    float s = 0.f; u32x4 pk[2];
#pragma unroll
                    for (int r = 0; r < 16; ++r) { X[r] = __builtin_amdgcn_exp2f(X[r]); s += X[r]; }
#pragma unroll
                    for (int s2 = 0; s2 < 2; ++s2) pk[s2] = (u32x4){cvtpk(X[8 * s2], X[8 * s2 + 1]), cvtpk(X[8 * s2 + 2], X[8 * s2 + 3]), cvtpk(X[8 * s2 + 4], X[8 * s2 + 5]), cvtpk(X[8 * s2 + 6], X[8 * s2 + 7])};
                    l += s;
                    ATT_PRIO(1);
#pragma unroll
                    for (int s2 = 0; s2 < 2; ++s2) {
                        const bf16x8 pa = __builtin_bit_cast(bf16x8, pk[s2]);
#pragma unroll
                        for (int db = 0; db < DV / 32; ++db) {
                            const s16x4 lo = vtr(Vt + vo[db] + (32 * kh + 16 * s2) * VROW), hi = vtr(Vt + vo[db] + (32 * kh + 16 * s2 + 8) * VROW);
                            const bf16x8 vb = (bf16x8){lo[0], lo[1], lo[2], lo[3], hi[0], hi[1], hi[2], hi[3]};
                            O[db] = __builtin_amdgcn_mfma_f32_32x32x16_bf16(pa, vb, O[db], 0, 0, 0);
                        }
                    }
                    ATT_PRIO(0);
                }
            }
        }
    }
    ATT_WAIT_BAR();
#undef ATT_ISSUE
}

template <int NDB>
__device__ __forceinline__ void tree_reduce4(f32x16 (&O)[NDB], float& l, LAS float* red, int w, int lane) {
    constexpr int SLOTF = (NDB * 16 + 1) * 64; const int grp = w >> 2, idx = w & 3;
#pragma unroll
    for (int step = 2; step >= 1; step >>= 1) {
        if (idx >= step && idx < 2 * step) { LAS float* s = red + (grp * 2 + idx - step) * SLOTF + lane;
#pragma unroll
            for (int db = 0; db < NDB; ++db) {
#pragma unroll
                for (int r = 0; r < 16; ++r) s[64 * (db * 16 + r)] = O[db][r];
                asm volatile("" ::: "memory"); }
            s[64 * NDB * 16] = l; }
        ATT_LBAR();
        if (idx < step) { LAS const float* s = red + (grp * 2 + idx) * SLOTF + lane;
#pragma unroll
            for (int db = 0; db < NDB; ++db) {
#pragma unroll
                for (int r = 0; r < 16; ++r) O[db][r] += s[64 * (db * 16 + r)];
                asm volatile("s_waitcnt lgkmcnt(0)" ::: "memory"); }
            l += s[64 * NDB * 16]; }
        ATT_LBAR();
    }
}
template <int RLO>
__device__ __forceinline__ void df_export(f32x16 (&O)[4], LAS float* wsf, LAS float* xs, int lane, int hh) {
    constexpr int XLO = 8 - RLO;
#pragma unroll
    for (int r = 0; r < 8; ++r) { const float a = wsf[crow(XLO + r, hh)];
#pragma unroll
        for (int db = 0; db < 4; ++db) xs[64 * (db * 16 + XLO + r) + lane] = O[db][XLO + r] * a; }
}
template <int RLO, bool FIRST>
__device__ __forceinline__ void df_finish(f32x16 (&O)[4], LAS float* wsf, LAS float* xs, int tok0, int h, const float* gsub, bf16_t* MIX, int lane, int r32, int hh) {
    float gs[4];
#pragma unroll
    for (int db = 0; db < 4; ++db) gs[db] = gsub[32 * db + r32] * ONE_M_LINIT;
    unsigned short gt[8][4];
#pragma unroll
    for (int r = 0; r < 8; ++r) { const bf16_t* p = MIX + (size_t)(tok0 + crow(RLO + r, hh)) * 1024 + h * 128 + r32;
#pragma unroll
        for (int db = 0; db < 4; ++db) gt[r][db] = p[32 * db]; }
#pragma unroll
    for (int r = 0; r < 8; ++r) {
        const int qr = crow(RLO + r, hh); const float a = wsf[qr];
        float o[4], ss = 0.f;
#pragma unroll
        for (int db = 0; db < 4; ++db) { const float own = O[db][RLO + r] * a, oth = xs[64 * (db * 16 + RLO + r) + lane]; o[db] = FIRST ? own - oth : oth - own; ss += o[db] * o[db]; }
        ss = sum32(ss);
        const float rs = __builtin_amdgcn_rsqf(ss * (1.0f / 128.0f) + EPSN);
        bf16_t* p = MIX + (size_t)(tok0 + qr) * 1024 + h * 128 + r32;
#pragma unroll
        for (int db = 0; db < 4; ++db) p[32 * db] = (bf16_t)f2bf(o[db] * rs * gs[db] * bf2f(gt[r][db]));
    }
}
__device__ __forceinline__ void diff_finish(f32x16 (&O)[4], float l, int c, bool doit, float lam, LAS float* wsf, LAS float* xs, int tok0, int h, const float* gsub, bf16_t* MIX) {
    int lane = threadIdx.x & 63; asm volatile("" : "+v"(lane), "+v"(tok0));
    const int r32 = lane & 31, hh = lane >> 5;
    const float ls = sum_xor32(l);
    if (hh == 0) wsf[r32] = (c == 0 ? 1.0f : lam) / ls;
    asm volatile("s_waitcnt lgkmcnt(0)" ::: "memory");
    if (doit) { if (c == 0) df_export<0>(O, wsf, xs, lane, hh); else df_export<8>(O, wsf, xs, lane, hh); }
    ATT_LBAR();
    if (doit) { if (c == 0) df_finish<0, true>(O, wsf, xs, tok0, h, gsub, MIX, lane, r32, hh); else df_finish<8, false>(O, wsf, xs, tok0, h, gsub, MIX, lane, r32, hh); }
    ATT_LBAR();
}
__device__ __forceinline__ void mem_finish(f32x16 (&O)[2], float l, int part, bool doit, bool pair, LAS float* wsf, LAS float* xs, int tok0, int h, bf16_t* MIX) {
    int lane = threadIdx.x & 63; asm volatile("" : "+v"(lane), "+v"(tok0));
    const int r32 = lane & 31, hh = lane >> 5;
    const float ls = sum_xor32(l);
    if (doit && part == 1) {
#pragma unroll
        for (int db = 0; db < 2; ++db)
#pragma unroll
            for (int r = 0; r < 16; ++r) xs[64 * (db * 16 + r) + lane] = O[db][r];
        xs[64 * 32 + lane] = ls;
    }
    ATT_LBAR();
    if (doit && part == 0) {
        const float lt = ls + (pair ? xs[64 * 32 + lane] : 0.f);
        if (hh == 0) wsf[r32] = 1.0f / lt;
        asm volatile("s_waitcnt lgkmcnt(0)" ::: "memory");
        unsigned short gt[16][2];
#pragma unroll
        for (int r = 0; r < 16; ++r) { const bf16_t* p = MIX + (size_t)(tok0 + crow(r, hh)) * 1024 + 768 + h * 64 + r32; gt[r][0] = p[0]; gt[r][1] = p[32]; }
#pragma unroll
        for (int r = 0; r < 16; ++r) {
            const int qr = crow(r, hh); const float a = wsf[qr];
            bf16_t* p = MIX + (size_t)(tok0 + qr) * 1024 + 768 + h * 64 + r32;
#pragma unroll
            for (int db = 0; db < 2; ++db) p[32 * db] = (bf16_t)f2bf((O[db][r] + (pair ? xs[64 * (db * 16 + r) + lane] : 0.f)) * a * bf2f(gt[r][db]));
        }
    }
    ATT_LBAR();
}
}

struct Args { const float* in[30]; float* out; unsigned char* ws; double rope_r0; double inv2pi; int ph_lo, ph_hi; };
enum { I_XP = 0, I_XS, I_MEM, I_CDK, I_CDV, I_CMK, I_CMV, I_SCONV, I_SH, I_NORMG, I_WIN, I_GQ, I_GK, I_LQ1, I_LK1, I_LQ2, I_LK2, I_GSUB, I_CONVW, I_CONVB, I_WA, I_BA, I_WX, I_BX,
       I_LAMBDA, I_MEMNG, I_WMEM, I_GMQ, I_GMK, I_WOUT };

__device__ __forceinline__ void p0_transpose_item(const float* W, int N, bf16_t* WT, int row_off, LAS float* scr, int item, int lane) {
    const int nblk = N / 32, kb = item / nblk, nb = item % nblk, k0 = 64 * kb, n0 = 32 * nb;
#pragma unroll 8
    for (int i = 0; i < 32; ++i) { const int kk = 2 * i + (lane >> 5); scr[kk * 33 + (lane & 31)] = W[(size_t)(k0 + kk) * N + n0 + (lane & 31)]; }
    asm volatile("s_waitcnt lgkmcnt(0)" ::: "memory");
    const int cl = n0 & 255, p0 = (n0 & ~255) + 128 * ((cl >> 5) & 1) + 32 * (cl >> 6);
    const int c = lane & 7;
#pragma unroll
    for (int j = 0; j < 4; ++j) { const int n = (lane >> 3) + 8 * j; const LAS float* s = scr + (8 * c) * 33 + n;
        u32x4 o; o.x = pk2(s[0 * 33], s[1 * 33]); o.y = pk2(s[2 * 33], s[3 * 33]); o.z = pk2(s[4 * 33], s[5 * 33]); o.w = pk2(s[6 * 33], s[7 * 33]);
        *(u32x4*)(WT + (size_t)(row_off + p0 + n) * 1024 + k0 + 8 * c) = o; }
    asm volatile("s_waitcnt lgkmcnt(0)" ::: "memory");
}
__device__ __forceinline__ void rms_row_to_bf16(const float* xrow, const float* g, bf16_t* orow, int lane) {
    const f32x4* xr = (const f32x4*)xrow + lane; const f32x4* gr = (const f32x4*)g + lane;
    f32x4 v[4]; float s = 0.f;
#pragma unroll
    for (int j = 0; j < 4; ++j) { v[j] = xr[64 * j]; s += (v[j].x * v[j].x + v[j].y * v[j].y) + (v[j].z * v[j].z + v[j].w * v[j].w); }
    const float rs = __builtin_amdgcn_rsqf(wave_sum(s) * (1.f / 1024.f) + EPSN);
    unsigned long long* o8 = (unsigned long long*)orow + lane;
#pragma unroll
    for (int j = 0; j < 4; ++j) { const f32x4 gg = gr[64 * j]; const f32x4 t = v[j] * gg * rs;
        o8[64 * j] = (unsigned long long)pk2(t.x, t.y) | ((unsigned long long)pk2(t.z, t.w) << 32); }
}

#define XB_TMO      128
#define XB_XCNT(j)  (256  + 64 * (j))
#define XB_XSUB(j)  (1280 + 64 * (j))
#define XB_XGEN(j)  (2304 + 64 * (j))
#define XB_TOP      3328
#define XB_TOPGEN   3392
#define XCD_BAR_WORDS 3456
#define XB_SPIN_CAP (1u << 18)

__device__ __forceinline__ unsigned xb_ld(unsigned* p)              { return __hip_atomic_load(p, __ATOMIC_RELAXED, __HIP_MEMORY_SCOPE_AGENT); }
__device__ __forceinline__ unsigned xb_add(unsigned* p, unsigned v) { return __hip_atomic_fetch_add(p, v, __ATOMIC_RELAXED, __HIP_MEMORY_SCOPE_AGENT); }
__device__ __forceinline__ unsigned xb_xcc_id() { return (unsigned)__builtin_amdgcn_s_getreg((3 << 11) | 20) & 0xFu; }
#define XB_SPIN(cond, bar) do { unsigned _sp = 0; while (cond) { __builtin_amdgcn_s_sleep(1); \
    if ((++_sp & 255u) == 0u) { if (xb_ld(&(bar)[XB_TMO])) break; if (_sp > XB_SPIN_CAP) { atomicAdd(&(bar)[XB_TMO], 1u); break; } } } } while (0)

struct XcdBarrier {
    unsigned* bar; unsigned x;
    volatile LAS unsigned* st;
};

__device__ __forceinline__ XcdBarrier xcd_barrier_post(unsigned* bar, volatile LAS unsigned* st) {
    XcdBarrier b; b.bar = bar; b.x = xb_xcc_id(); b.st = st;
    if (threadIdx.x == 0) (void)xb_add(&bar[XB_XCNT(b.x)], 1u);
    return b;
}
__device__ __forceinline__ void xcd_barrier_complete(unsigned* bar, unsigned x, unsigned& nloc, unsigned& nx) {
    const unsigned G = gridDim.x * gridDim.y * gridDim.z;
    unsigned sum, cnt, mine, sp = 0u;
    for (;;) {
        sum = 0u; cnt = 0u; mine = 0u;
#pragma unroll
        for (unsigned j = 0; j < 16; ++j) { const unsigned c = xb_ld(&bar[XB_XCNT(j)]); sum += c; cnt += (c > 0u) ? 1u : 0u; mine = (j == x) ? c : mine; }
        if (sum == G) break;
        __builtin_amdgcn_s_sleep(1);
        if ((++sp & 255u) == 0u) { if (xb_ld(&bar[XB_TMO])) break; if (sp > XB_SPIN_CAP) { atomicAdd(&bar[XB_TMO], 1u); break; } }
    }
    nloc = mine > 0u ? mine : 1u; nx = cnt > 0u ? cnt : 1u;
}

__device__ __forceinline__ void xcd_barrier(const XcdBarrier& b) {
    asm volatile("s_waitcnt vmcnt(0)" ::: "memory");
    __syncthreads();
    if (threadIdx.x == 0) {
        unsigned* bar = b.bar;
        __builtin_amdgcn_s_waitcnt(0);
        unsigned nloc = b.st[0], nx = b.st[1];
        if (nloc == 0u) { xcd_barrier_complete(bar, b.x, nloc, nx); b.st[0] = nloc; b.st[1] = nx; }
        const unsigned old = xb_add(&bar[XB_XSUB(b.x)], 1u);
        const unsigned gen = old / nloc;
        if (old + 1u == (gen + 1u) * nloc) {
            __builtin_amdgcn_fence(__ATOMIC_RELEASE, "agent");
            asm volatile("s_waitcnt vmcnt(0)" ::: "memory");
            const unsigned og = xb_add(&bar[XB_TOP], 1u);
            const unsigned tg = og / nx;
            if (og + 1u == (tg + 1u) * nx) xb_add(&bar[XB_TOPGEN], 1u);
            else XB_SPIN(xb_ld(&bar[XB_TOPGEN]) == tg, bar);
            __builtin_amdgcn_fence(__ATOMIC_ACQUIRE, "agent");
            xb_add(&bar[XB_XGEN(b.x)], 1u);
            asm volatile("s_waitcnt vmcnt(0)" ::: "memory");
        } else {
            XB_SPIN(xb_ld(&bar[XB_XGEN(b.x)]) == gen, bar);
            __builtin_amdgcn_fence(__ATOMIC_ACQUIRE, "agent");
            asm volatile("s_waitcnt vmcnt(0)" ::: "memory");
        }
    }
    __syncthreads();
}

__device__ __forceinline__ void grid_bar(unsigned* ctr, unsigned target) {
    asm volatile("s_waitcnt vmcnt(0) lgkmcnt(0)" ::: "memory");
    __syncthreads();
    if (threadIdx.x == 0) {
        __builtin_amdgcn_fence(__ATOMIC_RELEASE, "agent");
        asm volatile("s_waitcnt vmcnt(0)" ::: "memory");
        __hip_atomic_fetch_add(ctr, 1u, __ATOMIC_RELAXED, __HIP_MEMORY_SCOPE_AGENT);
        while (__hip_atomic_load(ctr, __ATOMIC_RELAXED, __HIP_MEMORY_SCOPE_AGENT) < target) __builtin_amdgcn_s_sleep(2);
        __builtin_amdgcn_fence(__ATOMIC_ACQUIRE, "agent");
        asm volatile("s_waitcnt vmcnt(0)" ::: "memory");
    }
    __syncthreads();
}

__device__ __forceinline__ void stagger(bool late, unsigned ticks) {
    if (late) { const unsigned long long t0 = __builtin_amdgcn_s_memrealtime(); while (__builtin_amdgcn_s_memrealtime() - t0 < ticks) __builtin_amdgcn_s_sleep(20); }
}

__global__ void __launch_bounds__(512, 2) fwd_kernel(Args args) {
    extern __shared__ __attribute__((aligned(16))) unsigned char lds[];
    const int tid = threadIdx.x, lane = tid & 63; const int wave = __builtin_amdgcn_readfirstlane(tid >> 6);
    const int G = gridDim.x, bx = blockIdx.x;
    const int vcu = (G % 8 == 0) ? (bx % 8) * (G / 8) + bx / 8 : bx;
    unsigned char* ws = args.ws; float* out = args.out;
    const int lo = args.ph_lo, hi = args.ph_hi;
#define IN(k) (lo <= (k) && (k) < hi)
#define GRID_SYNC(k) do { if (IN(k) && IN((k) + 1)) xcd_barrier(xbar); } while (0)
    XcdBarrier xbar; xbar.bar = (unsigned*)(ws + WS_BAR); xbar.x = 0; xbar.st = (volatile LAS unsigned*)((LAS unsigned char*)lds + LDS_BYTES - 16);
    if (hi - lo > 1) {
        if (bx == 0) for (int i = tid; i < XCD_BAR_WORDS; i += 512) __hip_atomic_store((unsigned*)(ws + WS_BAR) + i, 0u, __ATOMIC_RELAXED, __HIP_MEMORY_SCOPE_AGENT);
        if (tid < 2) xbar.st[tid] = 0u;
        cg::this_grid().sync();
        xbar = xcd_barrier_post((unsigned*)(ws + WS_BAR), xbar.st);
    }

    if (IN(0)) {
        bf16_t* const WIN = (bf16_t*)(ws + WS_WIN); bf16_t* const WOUT = (bf16_t*)(ws + WS_WOUT); f32x2v* const ROPE = (f32x2v*)(ws + WS_ROPE); bf16_t* const AALL = (bf16_t*)(ws + WS_AALL); bf16_t* const KS = (bf16_t*)(ws + WS_KS); bf16_t* const VS = (bf16_t*)(ws + WS_VS); bf16_t* const MKA = (bf16_t*)(ws + WS_MKA); bf16_t* const MVA = (bf16_t*)(ws + WS_MVA);
#ifndef SKIP_P0
        LAS float* scr = (LAS float*)((LAS unsigned char*)lds + wave * 16384);
        const int gw = vcu * 8 + wave, NGW = G * 8;
        constexpr int I_IN = 16 * 96, I_MEMW = 16 * 16, I_OUTW = 16 * 32;
        for (int it = gw; it < I_IN + I_MEMW + I_OUTW; it += NGW) {
            int r = it;
            if (r < I_IN) { p0_transpose_item(args.in[I_WIN], 3072, WIN, 0, scr, r, lane); continue; } r -= I_IN;
            if (r < I_MEMW) { p0_transpose_item(args.in[I_WMEM], 512, WIN, 3072, scr, r, lane); continue; } r -= I_MEMW;
            p0_transpose_item(args.in[I_WOUT], 1024, WOUT, 0, scr, r, lane);
        }
        for (int m = gw; m < AROWS; m += NGW) {
            const float* src = m < NTOK_P ? args.in[I_XP] + (size_t)m * 1024 : m < NTOK ? args.in[I_XS] + (size_t)(m - NTOK_P) * 1024 : args.in[I_MEM] + (size_t)(m - NTOK) * 1024;
            rms_row_to_bf16(src, m < NTOK ? args.in[I_NORMG] : args.in[I_MEMNG], AALL + (size_t)m * 1024, lane);
        }
        for (int m = gw; m < 2 * SBAT * PAST; m += NGW) {
            const int which = m >= SBAT * PAST, r = which ? m - SBAT * PAST : m, b = r >> 10, t = r & 1023;
            const f32x4* s = (const f32x4*)(args.in[which ? I_CDV : I_CDK] + (size_t)r * 512) + 2 * lane; const f32x4 a = s[0], c = s[1];
            u32x4 o; o.x = pk2(a.x, a.y); o.y = pk2(a.z, a.w); o.z = pk2(c.x, c.y); o.w = pk2(c.z, c.w);
            *((u32x4*)((which ? VS : KS) + ((size_t)b * KSROWS + t) * 512) + lane) = o;
        }
        for (int m = gw; m < 2 * SBAT * 256; m += NGW) {
            const int which = m >= SBAT * 256, r = which ? m - SBAT * 256 : m;
            const f32x4 a = *((const f32x4*)(args.in[which ? I_CMV : I_CMK] + (size_t)r * 256) + lane);
            u32x2 o; o.x = pk2(a.x, a.y); o.y = pk2(a.z, a.w);
            *((u32x2*)((which ? MVA : MKA) + (size_t)(NMEMROW + r) * 256) + lane) = o;
        }
        if (vcu == 0 && tid < 256) { const int k = tid >> 6; const float* src = k == 0 ? args.in[I_GQ] : k == 1 ? args.in[I_GK] : k == 2 ? args.in[I_GMQ] : args.in[I_GMK];
            ((float*)(ws + WS_GAIN))[tid] = src[tid & 63]; }
        for (int idx = (vcu * 512 + tid); idx < SEQ * 8; idx += G * 512) {
            const int pos = idx >> 3, i = idx & 7; double f = args.inv2pi;
            for (int k = 0; k < i; ++k) f *= args.rope_r0;
            double rev = (double)pos * f; rev -= __builtin_rint(rev);
            const float fr = (float)rev; ROPE[idx] = (f32x2v){__builtin_amdgcn_cosf(fr), __builtin_amdgcn_sinf(fr)};
        }
#endif
        asm volatile("s_waitcnt vmcnt(0) lgkmcnt(0)" ::: "memory"); __syncthreads();
    }
    GRID_SYNC(0);

    if (IN(1)) {
        bf16_t* const WIN = (bf16_t*)(ws + WS_WIN); bf16_t* const AALL = (bf16_t*)(ws + WS_AALL);
#ifndef SKIP_P1

        {   const f32x2v* const ROPE = (const f32x2v*)(ws + WS_ROPE); LAS f32x2v* tr = (LAS f32x2v*)((LAS unsigned char*)lds + LDS_TR); LAS f32x2v* ta = (LAS f32x2v*)((LAS unsigned char*)lds + LDS_TA);
            for (int i = tid; i < 1024; i += 512) tr[i] = ROPE[i];
            ta[tid] = ROPE[(size_t)(tid >> 3) * 128 * 8 + (tid & 7)];
            if (tid < 256) ((LAS float*)((LAS unsigned char*)lds + LDS_GAIN))[tid] = ((const float*)(ws + WS_GAIN))[tid];
            asm volatile("s_waitcnt vmcnt(0) lgkmcnt(0)" ::: "memory"); __syncthreads(); }
        pg8::Gemm g{AALL, WIN, AROWS, 3584, 1024}; SchedIn S{G, bx};
        EpiIn E{ws, out, (LAS unsigned char*)lds};
        pg8::gemm_phase<EpiIn, SchedIn, true, true>((LAS unsigned char*)lds, g, S, E);
#ifdef REP_P1
        asm volatile("s_waitcnt vmcnt(0) lgkmcnt(0)" ::: "memory"); __syncthreads();
        pg8::gemm_phase<EpiIn, SchedIn, true, true>((LAS unsigned char*)lds, g, S, E);
#endif
#endif
        asm volatile("s_waitcnt vmcnt(0) lgkmcnt(0)" ::: "memory"); __syncthreads();
    }
    GRID_SYNC(1);

    if (IN(2)) {
        bf16_t* const QB = (bf16_t*)(ws + WS_QB); bf16_t* const KB = (bf16_t*)(ws + WS_KB); bf16_t* const VB = (bf16_t*)(ws + WS_VB); bf16_t* const KS = (bf16_t*)(ws + WS_KS); bf16_t* const VS = (bf16_t*)(ws + WS_VS); bf16_t* const MIX = (bf16_t*)(ws + WS_MIX); float* const LX = (float*)(ws + WS_LX); bf16_t* const MQ = (bf16_t*)(ws + WS_MQ); bf16_t* const MKA = (bf16_t*)(ws + WS_MKA); bf16_t* const MVA = (bf16_t*)(ws + WS_MVA); float* const HL = (float*)(ws + WS_HL); float* const AC = (float*)(ws + WS_AC); float* const SEGA = (float*)(ws + WS_SEGA); float* const SEGH = (float*)(ws + WS_SEGH);
        LAS float* wsf = (LAS float*)((LAS unsigned char*)lds + LDS_WSF) + wave * 64;
        float lam;
        { const float d1 = wave_sum(args.in[I_LQ1][lane] * args.in[I_LK1][lane]), d2 = wave_sum(args.in[I_LQ2][lane] * args.in[I_LK2][lane]); lam = expf(d1) - expf(d2) + LAMBDA_INIT; }
        const int r32 = lane & 31;
#ifndef SKIP_P2A
        const int qg = wave & 3, cw = wave >> 2;
        LAS float* xs = (LAS float*)lds + qg * 4160;
        for (int vv = vcu; vv < 256; vv += G) {
            const int xcd = vv >> 5, kk = vv & 31;
#pragma nounroll
            for (int i = 0; i < 8; ++i) {
                const int bh = xcd * 4 + (i >> 1), b = bh >> 2, h = bh & 3;
                const int qb = (i & 1) ? 63 - kk : kk;
                const int tok0 = b * SEQ + qb * 128 + qg * 32;
                {   att::f32x16 O[4]; float l = 0.f;
#pragma unroll
                    for (int db = 0; db < 4; ++db) O[db] = att::f32x16{};
                    att::attn_loop<2, 128>(lds, QB + (size_t)(tok0 + r32) * 512 + h * 128, (const unsigned char*)(KB + (size_t)b * SEQ * 512 + h * 128), (const unsigned char*)(VB + (size_t)b * SEQ * 512 + h * 128),
                                           1024, 2 * qb + 2, 2, 0, 2 * qb + (qg >> 1), cw, O, l);
#ifdef REP_ATT
                    att::attn_loop<2, 128>(lds, QB + (size_t)(tok0 + r32) * 512 + h * 128, (const unsigned char*)(KB + (size_t)b * SEQ * 512 + h * 128), (const unsigned char*)(VB + (size_t)b * SEQ * 512 + h * 128),
                                           1024, 2 * qb + 2, 2, 0, 2 * qb + (qg >> 1), cw, O, l);
#endif
                    att::diff_finish(O, l, cw, true, lam, wsf, xs, tok0, h, args.in[I_GSUB], MIX); }
                {   att::f32x16 O[2]; float l = 0.f; O[0] = att::f32x16{}; O[1] = att::f32x16{};
                    att::attn_loop<1, 64>(lds, MQ + (size_t)(tok0 + r32) * 256 + h * 64, (const unsigned char*)(MKA + (size_t)b * 256 * 256 + h * 64), (const unsigned char*)(MVA + (size_t)b * 256 * 256 + h * 64),
                                          512, 4, 2, 2, cw, 0, O, l);
                    att::mem_finish(O, l, cw, true, true, wsf, xs, tok0, h, MIX); }
            }
        }
        for (int uu = vcu; uu < 128; uu += G) {
            const int b = uu >> 2, h = uu & 3, tok0 = NTOK_P + b * 32;
            {   att::f32x16 O[4]; float l = 0.f;
#pragma unroll
                for (int db = 0; db < 4; ++db) O[db] = att::f32x16{};
                att::attn_loop<2, 128>(lds, QB + (size_t)(tok0 + r32) * 512 + h * 128, (const unsigned char*)(KS + (size_t)b * KSROWS * 512 + h * 128), (const unsigned char*)(VS + (size_t)b * KSROWS * 512 + h * 128),
                                       1024, 17, 1, 1, qg, cw, O, l);
                att::tree_reduce4<4>(O, l, (LAS float*)lds, wave, lane);
                att::diff_finish(O, l, cw, qg == 0, lam, wsf, (LAS float*)lds, tok0, h, args.in[I_GSUB], MIX); }
            {   att::f32x16 O[2]; float l = 0.f; O[0] = att::f32x16{}; O[1] = att::f32x16{};
                att::attn_loop<1, 64>(lds, MQ + (size_t)(tok0 + r32) * 256 + h * 64, (const unsigned char*)(MKA + (size_t)(NB + b) * 256 * 256 + h * 64), (const unsigned char*)(MVA + (size_t)(NB + b) * 256 * 256 + h * 64),
                                      512, 4, 2, 1, cw == 0 ? qg : 7, 0, O, l);
                att::tree_reduce4<2>(O, l, (LAS float*)lds, wave, lane);
                att::mem_finish(O, l, 0, wave == 0, false, wsf, (LAS float*)lds, tok0, h, MIX); }
        }
#endif
#ifndef SKIP_P2L
        for (int uu = (G - 1 - vcu); uu < 640; uu += G) {
            const bool smp = uu >= 512; int b, n, row0, ntok, seg0;
            if (!smp) { b = uu >> 6; n = (uu >> 4) & 3; const int c = uu & 15; row0 = b * SEQ + c * 512; ntok = 512; seg0 = 8 * c; }
            else { const int r = uu - 512; b = r >> 2; n = r & 3; row0 = NTOK_P + b * 32; ntok = 32; seg0 = 0; }
            const int t0 = wave * 64, ch = n * 64 + lane;
            if (t0 < ntok) {
                const int ntw = (ntok - t0) < 64 ? (ntok - t0) : 64;
                const float* cw = args.in[I_CONVW]; const float cw0 = cw[ch], cw1 = cw[256 + ch], cw2 = cw[512 + ch], cw3 = cw[768 + ch], cb = args.in[I_CONVB][ch];
                float xm3, xm2, xm1;
                if (seg0 + wave > 0) { const float* p = LX + (size_t)(row0 + t0) * 256 + ch; xm3 = p[-3 * 256]; xm2 = p[-2 * 256]; xm1 = p[-256]; }
                else if (smp) { const float* p = args.in[I_SCONV] + (size_t)b * 3 * 256 + ch; xm3 = p[0]; xm2 = p[256]; xm1 = p[512]; }
                else { xm3 = 0.f; xm2 = 0.f; xm1 = 0.f; }
                LAS float* xc = (LAS float*)lds + wave * 4096;
                for (int tb = 0; tb < ntw; tb += 16) {
                    float xb[16];
#pragma unroll
                    for (int k = 0; k < 16; ++k) xb[k] = LX[(size_t)(row0 + t0 + tb + k) * 256 + ch];
#pragma unroll
                    for (int k = 0; k < 16; ++k) { const float x = xb[k]; xc[(tb + k) * 64 + lane] = cb + cw0 * xm3 + cw1 * xm2 + cw2 * xm1 + cw3 * x; xm3 = xm2; xm2 = xm1; xm1 = x; }
                }
                asm volatile("s_waitcnt lgkmcnt(0)" ::: "memory");
                f32x2v w2[64];
                { const float* pa = args.in[I_WA] + (size_t)n * 4096 + lane; const float* px = args.in[I_WX] + (size_t)n * 4096 + lane;
#pragma unroll
                  for (int i = 0; i < 64; ++i) w2[i] = (f32x2v){pa[i * 64], px[i * 64]}; }
                const float ba = args.in[I_BA][ch], bxx = args.in[I_BX][ch];
                const float sp = log1pf(expf(-args.in[I_LAMBDA][ch]));
                float hcur = smp ? args.in[I_SH][(size_t)b * 256 + ch] : 0.f, acur = 1.f;
                for (int t = 0; t < ntw; ++t) {
                    f32x2v g2 = {ba, bxx};
#pragma unroll
                    for (int i4 = 0; i4 < 16; ++i4) { const f32x4 xv = *(LAS const f32x4*)(xc + t * 64 + 4 * i4);
                        g2 = __builtin_elementwise_fma((f32x2v){xv.x, xv.x}, w2[4 * i4], g2); g2 = __builtin_elementwise_fma((f32x2v){xv.y, xv.y}, w2[4 * i4 + 1], g2);
                        g2 = __builtin_elementwise_fma((f32x2v){xv.z, xv.z}, w2[4 * i4 + 2], g2); g2 = __builtin_elementwise_fma((f32x2v){xv.w, xv.w}, w2[4 * i4 + 3], g2); }
                    const float xcj = xc[t * 64 + lane];
                    const float rg = sigmoidf_(g2.x), ig = sigmoidf_(g2.y);
                    const float la = -8.0f * rg * sp, a = fast_exp(la), y2 = 2.0f * la;
                    const float em = -y2 * (1.0f + y2 * (0.5f + y2 * (0.16666667f + y2 * (0.041666668f + y2 * 0.008333334f))));
                    const float bb = __builtin_amdgcn_sqrtf(em) * (ig * xcj);
                    hcur = a * hcur + bb; acur *= a;
                    const size_t row = (size_t)(row0 + t0 + t);
                    if (!smp) { HL[row * 256 + ch] = hcur; AC[row * 256 + ch] = acur; }
                    else { bf16_t* p = MIX + row * 1024 + 512 + ch; *p = (bf16_t)f2bf(hcur * bf2f(*p)); }
                }
                if (!smp) { const size_t si = ((size_t)b * 128 + seg0 + wave) * 256 + ch; SEGA[si] = acur; SEGH[si] = hcur; }
                else { out[O_HS + (size_t)b * 256 + ch] = hcur;
#pragma unroll
                    for (int k = 0; k < 3; ++k) out[O_CS + ((size_t)b * 3 + k) * 256 + ch] = LX[(size_t)(row0 + 29 + k) * 256 + ch]; }
            }
            asm volatile("s_waitcnt lgkmcnt(0)" ::: "memory"); __syncthreads();
        }
#endif
        asm volatile("s_waitcnt vmcnt(0) lgkmcnt(0)" ::: "memory"); __syncthreads();
    }
    GRID_SYNC(2);

    if (IN(3)) {
        bf16_t* const MIX = (bf16_t*)(ws + WS_MIX); float* const LX = (float*)(ws + WS_LX); float* const HL = (float*)(ws + WS_HL); float* const AC = (float*)(ws + WS_AC); float* const SEGA = (float*)(ws + WS_SEGA); float* const SEGH = (float*)(ws + WS_SEGH);
#ifndef SKIP_P3
        if (G >= 32 && vcu < 16) {
            bf16_t* const WOUT = (bf16_t*)(ws + WS_WOUT);
            pg8::Gemm g{MIX, WOUT, NTOK, 1024, 1024}; SchedOne S{NTOK_P / 256 + (vcu >> 2), vcu & 3};
            EpiOut E{args.in[I_XP], args.in[I_XS], out, (LAS unsigned char*)lds};
            pg8::gemm_phase<EpiOut, SchedOne, true, true>((LAS unsigned char*)lds, g, S, E);
        } else
        for (int uu = (G >= 32 ? vcu - 16 : vcu); uu < 256; uu += (G >= 32 ? G - 16 : G)) {
            const int b = uu >> 5, gI = uu & 31, ch = tid & 255, th = tid >> 8, s0 = 4 * gI + 2 * th;
            const float* sa = SEGA + (size_t)b * 128 * 256 + ch; const float* sh = SEGH + (size_t)b * 128 * 256 + ch;
            float H = 0.f;
            {   int s = 0;
                for (; s + 16 <= s0; s += 16) { float av[16], hv[16];
#pragma unroll
                    for (int k = 0; k < 16; ++k) { av[k] = sa[(s + k) * 256]; hv[k] = sh[(s + k) * 256]; }
#pragma unroll
                    for (int k = 0; k < 16; ++k) H = av[k] * H + hv[k]; }
                for (; s < s0; ++s) H = sa[s * 256] * H + sh[s * 256]; }
            for (int s = s0; s < s0 + 2; ++s) {
                const size_t rbase = (size_t)b * SEQ + 64 * s;
#pragma unroll 8
                for (int t = 0; t < 64; ++t) { const size_t row = rbase + t; const float hv = HL[row * 256 + ch] + AC[row * 256 + ch] * H;
                    bf16_t* p = MIX + row * 1024 + 512 + ch; *p = (bf16_t)f2bf(hv * bf2f(*p));
                    if (s == 127 && t == 63) out[O_HP + (size_t)b * 256 + ch] = hv; }
                H = sa[s * 256] * H + sh[s * 256];
            }
            if (gI == 31 && th == 0) {
#pragma unroll
                for (int k = 0; k < 3; ++k) out[O_CP + ((size_t)b * 3 + k) * 256 + ch] = LX[((size_t)b * SEQ + SEQ - 3 + k) * 256 + ch];
            }
        }
#endif
        asm volatile("s_waitcnt vmcnt(0) lgkmcnt(0)" ::: "memory"); __syncthreads();
    }
    GRID_SYNC(3);

    if (IN(4)) {
        bf16_t* const MIX = (bf16_t*)(ws + WS_MIX); bf16_t* const WOUT = (bf16_t*)(ws + WS_WOUT);
#ifndef SKIP_P4

        pg8::Gemm g{MIX, WOUT, NTOK, 1024, 1024}; SchedOut S{G, bx};
        EpiOut E{args.in[I_XP], args.in[I_XS], out, (LAS unsigned char*)lds};
        pg8::gemm_phase<EpiOut, SchedOut, true, true>((LAS unsigned char*)lds, g, S, E);
        if (G < 32) { asm volatile("s_waitcnt vmcnt(0) lgkmcnt(0)" ::: "memory"); __syncthreads();
            for (int k = bx; k < 16; k += G) { SchedOne S1{NTOK_P / 256 + (k >> 2), k & 3}; pg8::gemm_phase<EpiOut, SchedOne, true, true>((LAS unsigned char*)lds, g, S1, E); asm volatile("s_waitcnt vmcnt(0) lgkmcnt(0)" ::: "memory"); __syncthreads(); } }
#ifdef REP_P4
        asm volatile("s_waitcnt vmcnt(0) lgkmcnt(0)" ::: "memory"); __syncthreads();
        pg8::gemm_phase<EpiOut, SchedOut, true, true>((LAS unsigned char*)lds, g, S, E);
#endif
#endif
    }
#undef IN
#undef GRID_SYNC
}

extern "C" void kernel_launch(void* const* d_in, const int* in_sizes, int n_in, void* d_out, int out_size, void* d_ws, size_t ws_size, hipStream_t stream) {
    static int grid = 0;
    if (grid == 0) {
        if (n_in != 30 || (size_t)out_size != O_END || ws_size < WS_END) { fprintf(stderr, "kernel_launch: unexpected shapes (n_in %d out %d ws %zu)\n", n_in, out_size, ws_size); grid = -1; return; }
        int dev = 0, cus = 0, per_cu = 0;
        hipGetDevice(&dev); hipDeviceGetAttribute(&cus, hipDeviceAttributeMultiprocessorCount, dev);
        if (hipFuncSetAttribute((const void*)fwd_kernel, hipFuncAttributeMaxDynamicSharedMemorySize, LDS_BYTES) != hipSuccess) { fprintf(stderr, "kernel_launch: hipFuncSetAttribute failed\n"); grid = -1; return; }
        if (hipOccupancyMaxActiveBlocksPerMultiprocessor(&per_cu, (const void*)fwd_kernel, 512, LDS_BYTES) != hipSuccess || per_cu < 1) { fprintf(stderr, "kernel_launch: occupancy query says %d\n", per_cu); per_cu = 1; }
        (void)hipGetLastError();
        grid = cus;
    }
    if (grid < 0) return;
    Args a{};
    for (int i = 0; i < 30; ++i) a.in[i] = (const float*)d_in[i];
    a.out = (float*)d_out; a.ws = (unsigned char*)d_ws;
    a.rope_r0 = std::pow(500000.0, -1.0 / 8.0); a.inv2pi = 1.0 / (2.0 * M_PI);
#if MK_N_LAUNCHES == 1
    a.ph_lo = 0; a.ph_hi = 5;
    void* kargs[] = {&a};
    hipError_t e = hipLaunchCooperativeKernel((const void*)fwd_kernel, dim3(grid), dim3(512), kargs, LDS_BYTES, stream);
    if (e != hipSuccess) fprintf(stderr, "cooperative launch failed: %s (grid %d)\n", hipGetErrorString(e), grid);
#else
    for (int p = 0; p < 5; ++p) { a.ph_lo = p; a.ph_hi = p + 1; hipLaunchKernelGGL(fwd_kernel, dim3(grid), dim3(512), LDS_BYTES, stream, a); }
#endif
}
```

```cpp
#include <hip/hip_runtime.h>
#include <hip/hip_cooperative_groups.h>
#include <cstdio>
#include <cstdint>
#include <cmath>
namespace cg = cooperative_groups;
#ifndef MK_N_LAUNCHES
#define MK_N_LAUNCHES 1
#endif
namespace pg8 {
#define PG8_LAS __attribute__((address_space(3)))
typedef unsigned short bf16_t;
typedef short bf16x8 __attribute__((ext_vector_type(8)));
typedef float f32x4 __attribute__((ext_vector_type(4)));
typedef unsigned u32x4 __attribute__((ext_vector_type(4)));
constexpr int BM = 256, BK = 64, HALF = 128, HTB = HALF * BK * 2  , STAGE_BYTES = 8 * HTB, NXCD = 8, WGM = 8;

__host__ __device__ __forceinline__ int lds_byte(int r, int c) { const int st = (r >> 4) * 2 + (c >> 5), rr = r & 15, cc = c & 31, ob = rr * 64 + cc * 2; return st * 1024 + (ob ^ (((ob >> 9) & 1) << 5)); }
__host__ __device__ __forceinline__ void stage_rc(int b, int& R, int& C) { const int st = b / 1024, sb = b % 1024, swz = sb ^ (((sb >> 9) & 1) << 5); R = (st >> 1) * 16 + swz / 64; C = (st & 1) * 32 + (swz % 64) / 2; }
__host__ __device__ __forceinline__ int perm32(int rho) { const int n = rho >> 4, i = rho & 15; return 8 * (i >> 2) + 4 * n + (i & 3); }

struct Unit { int pm, pn; };
struct Gemm { const bf16_t* A; const bf16_t* Bt; int M, N, K; };

struct StaticOrder {
    int nM, nN, nwg, G, c;
    __host__ __device__ void init(int M, int N, int G_, int c_) { nM = M / BM; nN = N / BM; nwg = nM * nN; G = G_; c = c_; }
    __host__ __device__ bool next(int i, Unit& u) const {
        const long L = (long)i * G + c; if (L >= nwg) return false;
        int wgid = (int)L; { const int q = nwg / NXCD, r = nwg % NXCD, xcd = wgid % NXCD, off = wgid / NXCD; wgid = (xcd < r ? xcd * (q + 1) : r * (q + 1) + (xcd - r) * q) + off; }
        const int nig = WGM * nN, gid = wgid / nig, fm = gid * WGM, gsz = (nM - fm) < WGM ? (nM - fm) : WGM;
        u.pm = fm + ((wgid % nig) % gsz); u.pn = (wgid % nig) / gsz; return true;
    }
    __device__ __forceinline__ void a_ready(const Unit&) const {}
    __device__ __forceinline__ void done(const Unit&) const {}
};

__device__ __forceinline__ unsigned cvt_pk_bf16(float lo, float hi) { unsigned r; asm volatile("v_cvt_pk_bf16_f32 %0, %1, %2" : "=v"(r) : "v"(lo), "v"(hi)); return r; }
typedef float f32x2 __attribute__((ext_vector_type(2)));
template <class Epi, class Sched, bool ALIGN_EPI = false, bool SP2 = false>
__device__ __forceinline__ void gemm_phase(PG8_LAS unsigned char* lds, const Gemm g, const Sched& S, const Epi& E) {
    const int tid = threadIdx.x, wid = __builtin_amdgcn_readfirstlane(tid >> 6), lane = tid & 63, wr = wid >> 2, wc = wid & 3, fr = lane & 15, fq = lane >> 4;
    const int K = g.K, nt = K / BK;
    unsigned voffA[2], voffB[2];
#pragma unroll
    for (int i = 0; i < 2; ++i) { int R, C; stage_rc(tid * 16 + i * 8192, R, C); const int Rb = Epi::PERM ? ((R & ~31) + perm32(R & 31)) : R;
        voffA[i] = (unsigned)(R * K + C) * 2u; voffB[i] = (unsigned)(Rb * K + C) * 2u; }
    const size_t kstep = (size_t)(BK * 2);
    const size_t hstep = (size_t)HALF * K * 2;
    const size_t tstep = 2 * hstep;
    const unsigned ldsw = (unsigned)wid * 1024u;
    const int aoff = lds_byte(wr * 64 + fr, fq * 8), boff = lds_byte(wc * 32 + fr, fq * 8);
#define PG8_SA(b, h) (((b) * 2 + (h)) * HTB)
#define PG8_SB(b, h) ((4 + (b) * 2 + (h)) * HTB)
#define PG8_STAGE(bufoff, gbase, voff) do { _Pragma("unroll") for (int _i = 0; _i < 2; ++_i) \
        __builtin_amdgcn_global_load_lds((const unsigned*)((const char*)(gbase) + (voff)[_i]), (PG8_LAS unsigned*)(lds + (bufoff) + ldsw + _i * 8192), 16, 0, 0); } while (0)
#define PG8_LDA(dst, b, h) do { _Pragma("unroll") for (int m = 0; m < 4; ++m) _Pragma("unroll") for (int k = 0; k < 2; ++k) dst[m][k] = *(const PG8_LAS bf16x8*)(lds + PG8_SA(b, h) + aoff + m * 2048 + k * 1024); } while (0)
#define PG8_LDB(dst, b, h) do { _Pragma("unroll") for (int n = 0; n < 2; ++n) _Pragma("unroll") for (int k = 0; k < 2; ++k) dst[n][k] = *(const PG8_LAS bf16x8*)(lds + PG8_SB(b, h) + boff + n * 2048 + k * 1024); } while (0)
#define PG8_MMA(ai, bj, At, Bt) do { __builtin_amdgcn_s_setprio(1); _Pragma("unroll") for (int m = 0; m < 4; ++m) _Pragma("unroll") for (int n = 0; n < 2; ++n) _Pragma("unroll") for (int k = 0; k < 2; ++k) \
        acc[ai][bj][m][n] = __builtin_amdgcn_mfma_f32_16x16x32_bf16(Bt[n][k], At[m][k], acc[ai][bj][m][n], 0, 0, 0); __builtin_amdgcn_s_setprio(0); } while (0)
#define PG8_WAIT_V(n) asm volatile("s_waitcnt vmcnt(" #n ")" ::: "memory")
#define PG8_WAIT_L(n) asm volatile("s_waitcnt lgkmcnt(" #n ")" ::: "memory")
#define PG8_BAR __builtin_amdgcn_s_barrier()
#define PG8_SCHED __builtin_amdgcn_sched_barrier(0)
    Unit cur, nxt; int ui = 0;
    if (!S.next(0, cur)) return;
    f32x4 acc[2][2][4][2];
    E.init(acc, cur, wr, wc, fr, fq);
    bf16x8 At[4][2], B0[2][2], B1[2][2];
    const char* cA = (const char*)g.A + (size_t)cur.pm * tstep; const char* cB = (const char*)g.Bt + (size_t)cur.pn * tstep;
    S.a_ready(cur);
    if constexpr (SP2) {
        PG8_STAGE(PG8_SB(0, 0), cB, voffB); PG8_STAGE(PG8_SB(0, 1), cB + hstep, voffB); PG8_STAGE(PG8_SA(0, 0), cA, voffA); PG8_STAGE(PG8_SA(0, 1), cA + hstep, voffA);
        if (wr == 1) PG8_BAR;
        PG8_WAIT_V(2); PG8_BAR;
        PG8_STAGE(PG8_SB(1, 0), cB + kstep, voffB); PG8_STAGE(PG8_SA(1, 0), cA + kstep, voffA); PG8_STAGE(PG8_SB(1, 1), cB + hstep + kstep, voffB);
        PG8_WAIT_V(6); PG8_BAR;
    } else {
        PG8_STAGE(PG8_SB(0, 0), cB, voffB); PG8_STAGE(PG8_SA(0, 0), cA, voffA); PG8_STAGE(PG8_SB(0, 1), cB + hstep, voffB); PG8_STAGE(PG8_SA(0, 1), cA + hstep, voffA);
        if (wr == 1) PG8_BAR;
        PG8_WAIT_V(4); PG8_BAR;
        PG8_STAGE(PG8_SB(1, 0), cB + kstep, voffB); PG8_STAGE(PG8_SA(1, 0), cA + kstep, voffA); PG8_STAGE(PG8_SB(1, 1), cB + hstep + kstep, voffB);
        PG8_WAIT_V(6); PG8_BAR;
    }
    for (;;) {
        const bool has_next = S.next(ui + 1, nxt);
        const char* nA = has_next ? (const char*)g.A + (size_t)nxt.pm * tstep : cA; const char* nB = has_next ? (const char*)g.Bt + (size_t)nxt.pn * tstep : cB;
        for (int t = 0; t < nt; t += 2) {
            const bool last = (t == nt - 2);
            const char* a1 = cA + (size_t)(t + 1) * kstep;
            const char* a2 = last ? nA : cA + (size_t)(t + 2) * kstep; const char* b2 = last ? nB : cB + (size_t)(t + 2) * kstep;
            const char* a3 = a2 + kstep; const char* b3 = b2 + kstep;
            if (last && has_next) S.a_ready(nxt);
            if constexpr (SP2) {
            PG8_LDB(B0, 0, 0); PG8_LDB(B1, 0, 1); PG8_SCHED; PG8_LDA(At, 0, 0); PG8_STAGE(PG8_SA(1, 1), a1 + hstep, voffA);
            PG8_WAIT_V(8); PG8_WAIT_L(0); PG8_BAR; PG8_MMA(0, 0, At, B0); PG8_MMA(0, 1, At, B1); PG8_BAR; PG8_SCHED;
            PG8_LDA(At, 0, 1); PG8_STAGE(PG8_SB(0, 0), b2, voffB); PG8_STAGE(PG8_SB(0, 1), b2 + hstep, voffB); PG8_STAGE(PG8_SA(0, 0), a2, voffA);
            PG8_WAIT_V(8); PG8_WAIT_L(0); PG8_BAR; PG8_MMA(1, 0, At, B0); PG8_MMA(1, 1, At, B1); PG8_BAR; PG8_SCHED;
            PG8_LDB(B0, 1, 0); PG8_LDB(B1, 1, 1); PG8_SCHED; PG8_LDA(At, 1, 0); PG8_STAGE(PG8_SA(0, 1), a2 + hstep, voffA);
            PG8_WAIT_V(8); PG8_WAIT_L(0); PG8_BAR; PG8_MMA(0, 0, At, B0); PG8_MMA(0, 1, At, B1); PG8_BAR; PG8_SCHED;
            PG8_LDA(At, 1, 1); PG8_STAGE(PG8_SB(1, 0), b3, voffB); PG8_STAGE(PG8_SB(1, 1), b3 + hstep, voffB); PG8_STAGE(PG8_SA(1, 0), a3, voffA);
            PG8_WAIT_V(8); PG8_WAIT_L(0); PG8_BAR; PG8_MMA(1, 0, At, B0); PG8_MMA(1, 1, At, B1); PG8_BAR; PG8_SCHED;
            } else {
            PG8_LDB(B0, 0, 0); PG8_SCHED; PG8_LDA(At, 0, 0); PG8_STAGE(PG8_SA(1, 1), a1 + hstep, voffA);
            PG8_WAIT_L(8); PG8_BAR; PG8_WAIT_L(0); PG8_MMA(0, 0, At, B0); PG8_BAR; PG8_SCHED;
            PG8_LDB(B1, 0, 1); PG8_STAGE(PG8_SB(0, 0), b2, voffB);
            PG8_BAR; PG8_WAIT_L(0); PG8_MMA(0, 1, At, B1); PG8_BAR;
            PG8_LDA(At, 0, 1); PG8_STAGE(PG8_SA(0, 0), a2, voffA);
            PG8_BAR; PG8_WAIT_L(0); PG8_MMA(1, 0, At, B0); PG8_BAR; PG8_SCHED;
            PG8_STAGE(PG8_SB(0, 1), b2 + hstep, voffB);
            PG8_WAIT_V(6); PG8_BAR; PG8_MMA(1, 1, At, B1); PG8_BAR;
            PG8_LDB(B0, 1, 0); PG8_SCHED; PG8_LDA(At, 1, 0); PG8_STAGE(PG8_SA(0, 1), a2 + hstep, voffA);
            PG8_WAIT_L(8); PG8_BAR; PG8_WAIT_L(0); PG8_MMA(0, 0, At, B0); PG8_BAR; PG8_SCHED;
            PG8_LDB(B1, 1, 1); PG8_STAGE(PG8_SB(1, 0), b3, voffB);
            PG8_BAR; PG8_WAIT_L(0); PG8_MMA(0, 1, At, B1); PG8_BAR;
            PG8_LDA(At, 1, 1); PG8_STAGE(PG8_SA(1, 0), a3, voffA);
            PG8_BAR; PG8_WAIT_L(0); PG8_MMA(1, 0, At, B0); PG8_BAR; PG8_SCHED;
            PG8_STAGE(PG8_SB(1, 1), b3 + hstep, voffB);
            PG8_WAIT_V(6); PG8_BAR; PG8_MMA(1, 1, At, B1); PG8_BAR;
            }
        }
        if constexpr (ALIGN_EPI) { if (wr == 0) PG8_BAR; }
        if constexpr (!Epi::AFTER_DRAIN) { E(acc, cur, wr, wc, fr, fq); S.done(cur); }
        if (!has_next) break;
        E.init(acc, nxt, wr, wc, fr, fq);
        cur = nxt; cA = nA; cB = nB; ++ui;
        if constexpr (ALIGN_EPI) { if (wr == 1) PG8_BAR; }
    }
    PG8_WAIT_V(0);
    if constexpr (!ALIGN_EPI) { if (wr == 0) PG8_BAR; }
    PG8_BAR;
    if constexpr (Epi::AFTER_DRAIN) { E.fused(acc, cur, wr, wc, fr, fq, lds, wid, lane); S.done(cur); }
#undef PG8_SA
#undef PG8_SB
#undef PG8_STAGE
#undef PG8_LDA
#undef PG8_LDB
#undef PG8_MMA
#undef PG8_WAIT_V
#undef PG8_WAIT_L
#undef PG8_BAR
#undef PG8_SCHED
}
}

constexpr int NB = 8, SEQ = 8192, SBAT = 32, STOK = 32, PAST = 1024;
constexpr int NTOK_P = NB * SEQ;
constexpr int NTOK_S = SBAT * STOK;
constexpr int NTOK = NTOK_P + NTOK_S;
constexpr int NMEMROW = NB * 256;
constexpr int AROWS = NTOK + NMEMROW;
constexpr int KSROWS = 1088;
constexpr float EPSN = 1e-6f;
constexpr float C2 = 0.125f * 1.4426950408889634f;
constexpr float ONE_M_LINIT = 0.8f, LAMBDA_INIT = 0.2f;
constexpr size_t O_YP = 0;
constexpr size_t O_YS = O_YP + (size_t)NTOK_P * 1024;
constexpr size_t O_KP = O_YS + (size_t)NTOK_S * 1024;
constexpr size_t O_VP = O_KP + (size_t)NTOK_P * 512;
constexpr size_t O_MK = O_VP + (size_t)NTOK_P * 512;
constexpr size_t O_MV = O_MK + (size_t)NMEMROW * 256;
constexpr size_t O_CP = O_MV + (size_t)NMEMROW * 256;
constexpr size_t O_HP = O_CP + 8 * 3 * 256;
constexpr size_t O_KS = O_HP + 8 * 256;
constexpr size_t O_VS = O_KS + (size_t)NTOK_S * 512;
constexpr size_t O_CS = O_VS + (size_t)NTOK_S * 512;
constexpr size_t O_HS = O_CS + 32 * 3 * 256;
constexpr size_t O_END = O_HS + 32 * 256;
constexpr size_t MiB = 1u << 20;
constexpr size_t WS_WIN = 0, WS_WOUT = 8 * MiB, WS_ROPE = 10 * MiB, WS_GAIN = 10 * MiB + 768 * 1024, WS_BAR = 10 * MiB + 800 * 1024, WS_SEGA = 11 * MiB, WS_SEGH = 12 * MiB, WS_AALL = 16 * MiB,
                 WS_QB = 152 * MiB, WS_KB = 218 * MiB, WS_VB = 282 * MiB, WS_KS = 346 * MiB, WS_VS = 382 * MiB, WS_MIX = 418 * MiB,
                 WS_LX = 548 * MiB, WS_MQ = 614 * MiB, WS_MKA = 648 * MiB, WS_MVA = 654 * MiB, WS_HL = 660 * MiB, WS_AC = 724 * MiB, WS_END = 788 * MiB;
#ifndef STAG_P1
#define STAG_P1 2000u
#endif
#ifndef STAG_P4
#define STAG_P4 1400u
#endif
constexpr int LDS_BYTES = 163840;
constexpr int LDS_TR = 131072, LDS_TA = 139264, LDS_GAIN = 143360, LDS_STG = 144384;
constexpr int LDS_WSF = 133120;
constexpr int RED_SLOT_F = 33280 / 4;

typedef unsigned short bf16_t;
typedef float f32x4 __attribute__((ext_vector_type(4)));
typedef float f32x2v __attribute__((ext_vector_type(2)));
typedef unsigned u32x4 __attribute__((ext_vector_type(4)));
typedef unsigned u32x2 __attribute__((ext_vector_type(2)));
#define LAS __attribute__((address_space(3)))

__device__ __forceinline__ unsigned f2bf(float f) { unsigned u = __builtin_bit_cast(unsigned, f); return (u + 0x7fffu + ((u >> 16) & 1u)) >> 16; }
__device__ __forceinline__ unsigned pk2(float lo, float hi) { return f2bf(lo) | (f2bf(hi) << 16); }
__device__ __forceinline__ unsigned hw_pk2(float lo, float hi) { typedef float f2_t __attribute__((ext_vector_type(2))); typedef __bf16 b2_t __attribute__((ext_vector_type(2)));
    f2_t v = {lo, hi}; b2_t b = __builtin_convertvector(v, b2_t); return __builtin_bit_cast(unsigned, b); }
__device__ __forceinline__ float bf2f(unsigned short b) { return __builtin_bit_cast(float, (unsigned)b << 16); }
__device__ __forceinline__ float fast_exp(float x) { return __builtin_amdgcn_exp2f(x * 1.4426950408889634f); }
__device__ __forceinline__ float sigmoidf_(float x) { return __builtin_amdgcn_rcpf(1.0f + fast_exp(-x)); }
__device__ __forceinline__ float siluf_(float x) { return x * sigmoidf_(x); }
template <int M> __device__ __forceinline__ float lane_xor(float v) { return __builtin_bit_cast(float, __builtin_amdgcn_ds_swizzle(__builtin_bit_cast(int, v), (M << 10) | 0x1f)); }
__device__ __forceinline__ float sum_xor32(float v) { const unsigned u = __builtin_bit_cast(unsigned, v); auto rr = __builtin_amdgcn_permlane32_swap(u, u, false, false);
    return __builtin_bit_cast(float, (unsigned)rr[0]) + __builtin_bit_cast(float, (unsigned)rr[1]); }
__device__ __forceinline__ float sum32(float v) { v += lane_xor<1>(v); v += lane_xor<2>(v); v += lane_xor<4>(v); v += lane_xor<8>(v); v += lane_xor<16>(v); return v; }
__device__ __forceinline__ float wave_sum(float v) { return sum_xor32(sum32(v)); }
__device__ __forceinline__ void st_bf16x8(bf16_t* p, const float (&v)[8]) {
    u32x4 w; w.x = hw_pk2(v[0], v[1]); w.y = hw_pk2(v[2], v[3]); w.z = hw_pk2(v[4], v[5]); w.w = hw_pk2(v[6], v[7]); *(u32x4*)p = w;
}
__device__ __forceinline__ void st_f32x8(float* p, const float (&v)[8]) {
    *(f32x4*)p = (f32x4){v[0], v[1], v[2], v[3]}; *(f32x4*)(p + 4) = (f32x4){v[4], v[5], v[6], v[7]};
}

__device__ __forceinline__ void stage_store_f32(LAS float* st, int fr, int fq, const float (&v)[8], float* gbase, size_t pitch) {
    *(LAS f32x4*)(st + fr * 36 + 8 * fq) = (f32x4){v[0], v[1], v[2], v[3]}; *(LAS f32x4*)(st + fr * 36 + 8 * fq + 4) = (f32x4){v[4], v[5], v[6], v[7]};
    asm volatile("s_waitcnt lgkmcnt(0)" ::: "memory");
    int lane = fr + 16 * fq; asm volatile("" : "+v"(lane));
    const int tr = lane >> 3, tc = 4 * (lane & 7);
    const f32x4 t0 = *(LAS const f32x4*)(st + tr * 36 + tc), t1 = *(LAS const f32x4*)(st + (8 + tr) * 36 + tc);
    asm volatile("s_waitcnt lgkmcnt(0)" ::: "memory");
    *(f32x4*)(gbase + (size_t)tr * pitch + tc) = t0; *(f32x4*)(gbase + (size_t)(8 + tr) * pitch + tc) = t1;
}

struct SchedIn {
    int G, c;
    __device__ bool next(int i, pg8::Unit& u) const {
        const long L = (long)i * G + c; constexpr int nM = NTOK / 256, nN = 12, nwg = nM * nN;
        if (L >= nwg + 16) return false;
        if (L >= nwg) { const int r = (int)L - nwg; u.pm = nM + (r >> 1); u.pn = 12 + (r & 1); return true; }
        int wgid = (int)L; { const int q = nwg / 8, xcd = wgid % 8, off = wgid / 8; wgid = xcd * q + off; }
        const int nig = 8 * nN, gid = wgid / nig, fm = gid * 8, gsz = (nM - fm) < 8 ? (nM - fm) : 8;
        u.pm = fm + ((wgid % nig) % gsz); u.pn = (wgid % nig) / gsz; return true;
    }
    __device__ __forceinline__ void a_ready(const pg8::Unit&) const {}
    __device__ __forceinline__ void done(const pg8::Unit&) const {}
};
struct SchedOut {
    int G, c;
    __device__ bool next(int i, pg8::Unit& u) const {
        const long L = (long)i * G + c; constexpr int nM = NTOK_P / 256, nN = 4, nwg = nM * nN;
        if (L >= nwg) return false;
        int wgid = (int)L; { const int q = nwg / 8, xcd = wgid % 8, off = wgid / 8; wgid = xcd * q + off; }
        const int nig = 8 * nN, gid = wgid / nig, fm = gid * 8, gsz = (nM - fm) < 8 ? (nM - fm) : 8;
        u.pm = fm + ((wgid % nig) % gsz); u.pn = (wgid % nig) / gsz; return true;
    }
    __device__ __forceinline__ void a_ready(const pg8::Unit&) const {}
    __device__ __forceinline__ void done(const pg8::Unit&) const {}
};

struct SchedOne {
    int pm, pn;
    __device__ bool next(int i, pg8::Unit& u) const { if (i > 0) return false; u.pm = pm; u.pn = pn; return true; }
    __device__ __forceinline__ void a_ready(const pg8::Unit&) const {}
    __device__ __forceinline__ void done(const pg8::Unit&) const {}
};
struct EpiIn {
    static constexpr bool PERM = true, AFTER_DRAIN = false;
    __device__ __forceinline__ void init(f32x4 (&acc)[2][2][4][2], const pg8::Unit&, int, int, int, int) const {
#pragma unroll
        for (int a = 0; a < 2; ++a)
#pragma unroll
            for (int b = 0; b < 2; ++b)
#pragma unroll
                for (int m = 0; m < 4; ++m)
#pragma unroll
                    for (int n = 0; n < 2; ++n) acc[a][b][m][n] = (f32x4){0.f, 0.f, 0.f, 0.f};
    }
    unsigned char* ws; float* out; LAS unsigned char* ldsb;
    __device__ __forceinline__ void operator()(const f32x4 (&acc)[2][2][4][2], const pg8::Unit& u, int wr, int wc, int fr, int fq) const {
        bf16_t* const Qb = (bf16_t*)(ws + WS_QB); bf16_t* const Kb = (bf16_t*)(ws + WS_KB); bf16_t* const Vb = (bf16_t*)(ws + WS_VB); bf16_t* const KS = (bf16_t*)(ws + WS_KS); bf16_t* const VS = (bf16_t*)(ws + WS_VS);
        bf16_t* const MIX = (bf16_t*)(ws + WS_MIX); bf16_t* const MQ = (bf16_t*)(ws + WS_MQ); bf16_t* const MKA = (bf16_t*)(ws + WS_MKA); bf16_t* const MVA = (bf16_t*)(ws + WS_MVA);
        float* const LX = (float*)(ws + WS_LX);
        const int pn = u.pn;
        LAS float* const stg = (LAS float*)(ldsb + LDS_STG) + (wr * 4 + wc) * 576;
        const int cl0 = 64 * wc + 8 * fq;
        const int rb = u.pm * 256 + wr * 64 + fr;
        LAS const float* g = nullptr;
        { LAS const float* const gains = (LAS const float*)(ldsb + LDS_GAIN); if (pn < 2) g = gains; else if (pn < 4) g = gains + 64; else if (pn == 10) g = gains + 128; else if (pn == 12) g = gains + 192; }
        float gv[2][8];
#pragma unroll
        for (int bj = 0; bj < 2; ++bj)
#pragma unroll
            for (int k = 0; k < 8; ++k) gv[bj][k] = g ? g[32 * bj + 8 * fq + k] : 1.f;
#pragma unroll
        for (int ai = 0; ai < 2; ++ai)
#pragma unroll
            for (int m = 0; m < 4; ++m) {
                const int row = rb + ai * 128 + m * 16;
                float v[2][8];
#pragma unroll
                for (int bj = 0; bj < 2; ++bj)
#pragma unroll
                    for (int n = 0; n < 2; ++n)
#pragma unroll
                        for (int e = 0; e < 4; ++e) v[bj][4 * n + e] = acc[ai][bj][m][n][e];
                if (g) {
                    float ss = 0.f;
#pragma unroll
                    for (int bj = 0; bj < 2; ++bj)
#pragma unroll
                        for (int k = 0; k < 8; ++k) ss += v[bj][k] * v[bj][k];
                    ss += lane_xor<16>(ss); ss = sum_xor32(ss);
                    const float rs = __builtin_amdgcn_rsqf(ss * (1.0f / 64.0f) + EPSN);
#pragma unroll
                    for (int bj = 0; bj < 2; ++bj)
#pragma unroll
                        for (int k = 0; k < 8; ++k) v[bj][k] *= rs * gv[bj][k];
                    if (pn < 4) {
                        const int pos = row < NTOK_P ? (row & (SEQ - 1)) : (PAST + (row & 31));
                        float pv[8];
#pragma unroll
                        for (int k = 0; k < 8; ++k) pv[k] = lane_xor<16>(v[0][k]);
                        if (fq < 2) {
                            LAS const f32x2v* tr = (LAS const f32x2v*)(ldsb + LDS_TR) + (pos & 127) * 8; LAS const f32x2v* ta = (LAS const f32x2v*)(ldsb + LDS_TA) + (pos >> 7) * 8;
#pragma unroll
                            for (int k = 0; k < 8; ++k) { const f32x2v R = tr[k], A = ta[k]; const float cc = A.x * R.x - A.y * R.y, sn = A.y * R.x + A.x * R.y;
                                v[0][k] = fq == 0 ? (v[0][k] * cc - pv[k] * sn) : (v[0][k] * cc + pv[k] * sn); }
                        }
                    }
                }
                if (pn < 2) {
#pragma unroll
                    for (int bj = 0; bj < 2; ++bj) { float o[8];
#pragma unroll
                        for (int k = 0; k < 8; ++k) o[k] = v[bj][k] * C2;
                        st_bf16x8(Qb + (size_t)row * 512 + 256 * pn + cl0 + 32 * bj, o); }
                } else if (pn < 6) {
                    const bool isk = pn < 4; const int col = 256 * (pn - (isk ? 2 : 4)) + cl0;
                    float* of; bf16_t* ob;
                    if (row < NTOK_P) { of = out + (isk ? O_KP : O_VP) + (size_t)row * 512 + col; ob = (isk ? Kb : Vb) + (size_t)row * 512 + col; }
                    else { const int rs_ = row - NTOK_P; of = out + (isk ? O_KS : O_VS) + (size_t)rs_ * 512 + col;
                           ob = (isk ? KS : VS) + ((size_t)(rs_ >> 5) * KSROWS + PAST + (rs_ & 31)) * 512 + col; }
                    float* const gb = of - (size_t)fr * 512 - 8 * fq;
#pragma unroll
                    for (int bj = 0; bj < 2; ++bj) { stage_store_f32(stg, fr, fq, v[bj], gb + 32 * bj, 512); st_bf16x8(ob + 32 * bj, v[bj]); }
                } else if (pn == 8) {
                    float* const gb = LX + (size_t)(row - fr) * 256 + 64 * wc;
#pragma unroll
                    for (int bj = 0; bj < 2; ++bj) stage_store_f32(stg, fr, fq, v[bj], gb + 32 * bj, 256);
                } else if (pn == 10) {
#pragma unroll
                    for (int bj = 0; bj < 2; ++bj) { float o[8];
#pragma unroll
                        for (int k = 0; k < 8; ++k) o[k] = v[bj][k] * C2;
                        st_bf16x8(MQ + (size_t)row * 256 + cl0 + 32 * bj, o); }
                } else if (pn >= 12) {
                    const int rm = row - NTOK;
#pragma unroll
                    for (int bj = 0; bj < 2; ++bj) { st_f32x8(out + (pn == 12 ? O_MK : O_MV) + (size_t)rm * 256 + cl0 + 32 * bj, v[bj]);
                        st_bf16x8((pn == 12 ? MKA : MVA) + (size_t)rm * 256 + cl0 + 32 * bj, v[bj]); }
                } else {
                    const int colb = pn == 6 ? 0 : pn == 7 ? 256 : pn == 9 ? 512 : 768;
#pragma unroll
                    for (int bj = 0; bj < 2; ++bj) { float o[8];
#pragma unroll
                        for (int k = 0; k < 8; ++k) o[k] = siluf_(v[bj][k]);
                        st_bf16x8(MIX + (size_t)row * 1024 + colb + cl0 + 32 * bj, o); }
                }
            }
    }
};
struct EpiOut {
    static constexpr bool PERM = true, AFTER_DRAIN = false;
    const float *xp, *xs; float* out; LAS unsigned char* ldsb;
    __device__ __forceinline__ void init(f32x4 (&acc)[2][2][4][2], const pg8::Unit& u, int wr, int wc, int fr, int fq) const {
        const int lane = fr + 16 * fq; LAS float* st = (LAS float*)(ldsb + LDS_TR) + (wr * 4 + wc) * 576;
        const int tr = lane >> 3, tc = 4 * (lane & 7);
#pragma unroll
        for (int ai = 0; ai < 2; ++ai)
#pragma unroll
            for (int m = 0; m < 4; ++m)
#pragma unroll
                for (int bj = 0; bj < 2; ++bj) {
                    int trr = tr; asm volatile("" : "+v"(trr));
                    const int row0 = u.pm * 256 + ai * 128 + wr * 64 + m * 16, col = 256 * u.pn + 64 * wc + 32 * bj + tc;
#pragma unroll
                    for (int j2 = 0; j2 < 2; ++j2) { const int row = row0 + 8 * j2 + trr;
                        acc[ai][bj][m][j2] = *(const f32x4*)((row < NTOK_P ? xp + (size_t)row * 1024 : xs + (size_t)(row - NTOK_P) * 1024) + col); }
                }
#pragma unroll
        for (int ai = 0; ai < 2; ++ai)
#pragma unroll
            for (int m = 0; m < 4; ++m)
#pragma unroll
                for (int bj = 0; bj < 2; ++bj) {
#pragma unroll
                    for (int j2 = 0; j2 < 2; ++j2) *(LAS f32x4*)(st + (8 * j2 + tr) * 36 + tc) = acc[ai][bj][m][j2];
                    asm volatile("s_waitcnt lgkmcnt(0)" ::: "memory");
#pragma unroll
                    for (int n = 0; n < 2; ++n) acc[ai][bj][m][n] = *(LAS const f32x4*)(st + fr * 36 + 8 * fq + 4 * n);
                    asm volatile("s_waitcnt lgkmcnt(0)" ::: "memory");
                }
    }
    __device__ __forceinline__ void operator()(const f32x4 (&acc)[2][2][4][2], const pg8::Unit& u, int wr, int wc, int fr, int fq) const {
        const int lane = fr + 16 * fq; LAS float* st = (LAS float*)(ldsb + LDS_TR) + (wr * 4 + wc) * 576;
        const int tr = lane >> 3, tc = 4 * (lane & 7);
#pragma unroll
        for (int ai = 0; ai < 2; ++ai)
#pragma unroll
            for (int m = 0; m < 4; ++m)
#pragma unroll
                for (int bj = 0; bj < 2; ++bj) {
#pragma unroll
                    for (int n = 0; n < 2; ++n) *(LAS f32x4*)(st + fr * 36 + 8 * fq + 4 * n) = acc[ai][bj][m][n];
                    asm volatile("s_waitcnt lgkmcnt(0)" ::: "memory");
                    int trr = tr; asm volatile("" : "+v"(trr));
                    const int row0 = u.pm * 256 + ai * 128 + wr * 64 + m * 16, col = 256 * u.pn + 64 * wc + 32 * bj + tc;
                    f32x4 t[2];
#pragma unroll
                    for (int j2 = 0; j2 < 2; ++j2) t[j2] = *(LAS const f32x4*)(st + (8 * j2 + tr) * 36 + tc);
                    asm volatile("s_waitcnt lgkmcnt(0)" ::: "memory");
#pragma unroll
                    for (int j2 = 0; j2 < 2; ++j2) *(f32x4*)(out + (size_t)(row0 + 8 * j2 + trr) * 1024 + col) = t[j2];
                }
    }
};

namespace att {
typedef short bf16x8 __attribute__((ext_vector_type(8)));
typedef short s16x4 __attribute__((ext_vector_type(4)));
typedef float f32x16 __attribute__((ext_vector_type(16)));
typedef float f32x2_t __attribute__((ext_vector_type(2)));
typedef __bf16 bf16x2_t __attribute__((ext_vector_type(2)));
__device__ __forceinline__ unsigned cvtpk(float lo, float hi) { f32x2_t v = {lo, hi}; bf16x2_t b = __builtin_convertvector(v, bf16x2_t); return __builtin_bit_cast(unsigned, b); }
__device__ __forceinline__ void glds16(const void* gsrc, unsigned lds_dst) { unsigned keep;
    asm volatile("s_mov_b32 %0, m0\n\ts_mov_b32 m0, %2\n\ts_nop 0\n\tglobal_load_lds_dwordx4 %1, off\n\ts_mov_b32 m0, %0" : "=&s"(keep) : "v"(gsrc), "s"(lds_dst) : "memory"); }
#define ATT_WAIT_BAR() asm volatile("s_waitcnt vmcnt(0) lgkmcnt(0)\n\ts_barrier" ::: "memory")
#ifndef ATT_IGLP
#define ATT_IGLP 0
#endif
#ifndef ATT_PRIO
#define ATT_PRIO(x) do {} while (0)
#endif
#define ATT_LBAR() asm volatile("s_waitcnt lgkmcnt(0)\n\ts_barrier" ::: "memory")
__device__ __forceinline__ s16x4 vtr(LAS const unsigned char* p) { typedef short v4i16_t __attribute__((ext_vector_type(4)));
    return __builtin_bit_cast(s16x4, __builtin_amdgcn_ds_read_tr16_b64_v4i16((LAS v4i16_t*)p)); }
__device__ __forceinline__ int crow(int r, int hh) { return (r & 3) + 8 * (r >> 2) + 4 * hh; }

template <int NC, int DV>
__device__ __forceinline__ void attn_loop(unsigned char* ldsg, const bf16_t* Qrow, const unsigned char* Kg, const unsigned char* Vg, int kvstride, int NT, int last_nh, int mode, int wpar, int c,
                                          f32x16 (&O)[DV / 32], float& l) {
    constexpr int KROW = NC * 128, VROW = DV * 2, KT = 64 * KROW, VT = 64 * VROW, BUF = KT + VT, KPW = KT / 8192, VPW = VT / 8192, PPW = KPW + VPW;
    const int tid = threadIdx.x, lane = tid & 63, r32 = lane & 31, hh = lane >> 5; const int w = __builtin_amdgcn_readfirstlane(tid >> 6);
    LAS const unsigned char* lds3 = (LAS const unsigned char*)ldsg; const unsigned lds0 = (unsigned)(uintptr_t)ldsg;
    unsigned ksrc[KPW], vsrc[VPW];
#pragma unroll
    for (int i = 0; i < KPW; ++i) { const int pos = 64 * (KPW * w + i) + lane; constexpr int CPR = KROW / 16; const int row = pos / CPR, cp = pos % CPR;
        const int cc = cp ^ (KROW == 256 ? (row & 15) : ((row >> 1) & 7)); ksrc[i] = (unsigned)(row * kvstride + cc * 16); }
#pragma unroll
    for (int i = 0; i < VPW; ++i) { const int pos = 64 * (VPW * w + i) + lane; constexpr int CPR = VROW / 16; const int row = pos / CPR, cp = pos % CPR;
        const int cc = cp ^ (VROW == 256 ? 4 * (row & 3) : 4 * ((row >> 1) & 1)); vsrc[i] = (unsigned)(row * kvstride + cc * 16); }
#define ATT_ISSUE(j) do { const size_t tb_ = (size_t)(j) * 64 * (size_t)kvstride; const unsigned sb_ = lds0 + ((j) & 3) * BUF; \
        _Pragma("unroll") for (int i_ = 0; i_ < KPW; ++i_) glds16(Kg + tb_ + ksrc[i_], (unsigned)__builtin_amdgcn_readfirstlane(sb_ + 1024 * (KPW * w + i_))); \
        _Pragma("unroll") for (int i_ = 0; i_ < VPW; ++i_) glds16(Vg + tb_ + vsrc[i_], (unsigned)__builtin_amdgcn_readfirstlane(sb_ + KT + 1024 * (VPW * w + i_))); } while (0)
    bf16x8 q[4];
#pragma unroll
    for (int ks = 0; ks < 4; ++ks) q[ks] = *(const bf16x8*)(Qrow + c * 64 + ks * 16 + hh * 8);
    ATT_ISSUE(0); if (NT > 1) ATT_ISSUE(1); if (NT > 2) ATT_ISSUE(2);
    asm volatile("" : "+v"(q[0]), "+v"(q[1]), "+v"(q[2]), "+v"(q[3]) :: "memory");
    const int kx = KROW == 256 ? (r32 & 15) : ((r32 >> 1) & 7);
    const int kb = r32 * KROW + ((hh ^ (kx & 1)) << 4), kxh = (kx & ~1) << 4, cb = c << 7;
    const int L = lane & 15, gp = (lane >> 4) & 1, sw = VROW == 256 ? ((L >> 2) & 3) : ((L >> 3) & 1);
    int vo[DV / 32];
#pragma unroll
    for (int db = 0; db < DV / 32; ++db) vo[db] = (4 * hh + (L >> 2)) * VROW + ((((db ^ sw) << 2) + 2 * gp + ((L & 3) >> 1)) << 4) + 8 * (L & 1);
#pragma nounroll
    for (int j = 0; j < NT; ++j) {
        {   const int rem = NT - 1 - j;
            if (rem >= 2) { if constexpr (PPW == 4) asm volatile("s_waitcnt vmcnt(8) lgkmcnt(0)\n\ts_barrier" ::: "memory"); else asm volatile("s_waitcnt vmcnt(4) lgkmcnt(0)\n\ts_barrier" ::: "memory"); }
            else if (rem == 1) { if constexpr (PPW == 4) asm volatile("s_waitcnt vmcnt(4) lgkmcnt(0)\n\ts_barrier" ::: "memory"); else asm volatile("s_waitcnt vmcnt(2) lgkmcnt(0)\n\ts_barrier" ::: "memory"); }
            else asm volatile("s_waitcnt vmcnt(0) lgkmcnt(0)\n\ts_barrier" ::: "memory"); }
        if (j + 3 < NT) ATT_ISSUE(j + 3);
        const bool active = mode == 0 ? (j <= wpar) : mode == 1 ? ((j & 3) == wpar) : ((j >> 1) == wpar);
        if (active) {
            const int nh = (j == NT - 1) ? last_nh : 2;
            LAS const unsigned char* Kt = lds3 + (j & 3) * BUF; LAS const unsigned char* Vt = Kt + KT;
            __builtin_amdgcn_iglp_opt(ATT_IGLP);
#pragma unroll
            for (int kh = 0; kh < 2; ++kh) {
                if (kh < nh) {
                    f32x16 X = {};
                    ATT_PRIO(1);
#pragma unroll
                    for (int ks = 0; ks < 4; ++ks) {
                        const int co = kb + ((cb + (ks << 5)) ^ kxh) + kh * 32 * KROW;
                        const bf16x8 a0 = *(LAS const bf16x8*)(Kt + co);
                        X = __builtin_amdgcn_mfma_f32_32x32x16_bf16(a0, q[ks], X, 0, 0, 0);
                    }
                    ATT_PRIO(0);
                    float s = 0.f; u32x4 pk[2];
#pragma unroll
                    for (int r = 0; r < 16; ++r) { X[r] = __builtin_amdgcn_exp2f(X[r]); s += X[r]; }
#pragma unroll
                    for (int s2 = 0; s2 < 2; ++s2) pk[s2] = (u32x4){cvtpk(X[8 * s2], X[8 * s2 + 1]), cvtpk(X[8 * s2 + 2], X[8 * s2 + 3]), cvtpk(X[8 * s2 + 4], X[8 * s2 + 5]), cvtpk(X[8 * s2 + 6], X[8 * s2 + 7])};
                    l += s;
                    ATT_PRIO(1);
#pragma unroll
                    for (int s2 = 0; s2 < 2; ++s2) {
                        const bf16x8 pa = __builtin_bit_cast(bf16x8, pk[s2]);
#pragma unroll
                        for (int db = 0; db < DV / 32; ++db) {
                            const s16x4 lo = vtr(Vt + vo[db] + (32 * kh + 16 * s2) * VROW), hi = vtr(Vt + vo[db] + (32 * kh + 16 * s2 + 8) * VROW);
                            const bf16x8 vb = (bf16x8){lo[0], lo[1], lo[2], lo[3], hi[0], hi[1], hi[2], hi[3]};
                            O[db] = __builtin_amdgcn_mfma_f32_32x32x16_bf16(pa, vb, O[db], 0, 0, 0);
                        }
                    }
                    ATT_PRIO(0);
                }
            }
        }
    }
    ATT_WAIT_BAR();
#undef ATT_ISSUE
}

template <int NDB>
__device__ __forceinline__ void tree_reduce4(f32x16 (&O)[NDB], float& l, LAS float* red, int w, int lane) {
    constexpr int SLOTF = (NDB * 16 + 1) * 64; const int grp = w >> 2, idx = w & 3;
#pragma unroll
    for (int step = 2; step >= 1; step >>= 1) {
        if (idx >= step && idx < 2 * step) { LAS float* s = red + (grp * 2 + idx - step) * SLOTF + lane;
#pragma unroll
            for (int db = 0; db < NDB; ++db) {
#pragma unroll
                for (int r = 0; r < 16; ++r) s[64 * (db * 16 + r)] = O[db][r];
                asm volatile("" ::: "memory"); }
            s[64 * NDB * 16] = l; }
        ATT_LBAR();
        if (idx < step) { LAS const float* s = red + (grp * 2 + idx) * SLOTF + lane;
#pragma unroll
            for (int db = 0; db < NDB; ++db) {
#pragma unroll
                for (int r = 0; r < 16; ++r) O[db][r] += s[64 * (db * 16 + r)];
                asm volatile("s_waitcnt lgkmcnt(0)" ::: "memory"); }
            l += s[64 * NDB * 16]; }
        ATT_LBAR();
    }
}
template <int RLO>
__device__ __forceinline__ void df_export(f32x16 (&O)[4], LAS float* wsf, LAS float* xs, int lane, int hh) {
    constexpr int XLO = 8 - RLO;
#pragma unroll
    for (int r = 0; r < 8; ++r) { const float a = wsf[crow(XLO + r, hh)];
#pragma unroll
        for (int db = 0; db < 4; ++db) xs[64 * (db * 16 + XLO + r) + lane] = O[db][XLO + r] * a; }
}
template <int RLO, bool FIRST>
__device__ __forceinline__ void df_finish(f32x16 (&O)[4], LAS float* wsf, LAS float* xs, int tok0, int h, const float* gsub, bf16_t* MIX, int lane, int r32, int hh) {
    float gs[4];
#pragma unroll
    for (int db = 0; db < 4; ++db) gs[db] = gsub[32 * db + r32] * ONE_M_LINIT;
    unsigned short gt[8][4];
#pragma unroll
    for (int r = 0; r < 8; ++r) { const bf16_t* p = MIX + (size_t)(tok0 + crow(RLO + r, hh)) * 1024 + h * 128 + r32;
#pragma unroll
        for (int db = 0; db < 4; ++db) gt[r][db] = p[32 * db]; }
#pragma unroll
    for (int r = 0; r < 8; ++r) {
        const int qr = crow(RLO + r, hh); const float a = wsf[qr];
        float o[4], ss = 0.f;
#pragma unroll
        for (int db = 0; db < 4; ++db) { const float own = O[db][RLO + r] * a, oth = xs[64 * (db * 16 + RLO + r) + lane]; o[db] = FIRST ? own - oth : oth - own; ss += o[db] * o[db]; }
        ss = sum32(ss);
        const float rs = __builtin_amdgcn_rsqf(ss * (1.0f / 128.0f) + EPSN);
        bf16_t* p = MIX + (size_t)(tok0 + qr) * 1024 + h * 128 + r32;
#pragma unroll
        for (int db = 0; db < 4; ++db) p[32 * db] = (bf16_t)f2bf(o[db] * rs * gs[db] * bf2f(gt[r][db]));
    }
}
__device__ __forceinline__ void diff_finish(f32x16 (&O)[4], float l, int c, bool doit, float lam, LAS float* wsf, LAS float* xs, int tok0, int h, const float* gsub, bf16_t* MIX) {
    int lane = threadIdx.x & 63; asm volatile("" : "+v"(lane), "+v"(tok0));
    const int r32 = lane & 31, hh = lane >> 5;
    const float ls = sum_xor32(l);
    if (hh == 0) wsf[r32] = (c == 0 ? 1.0f : lam) / ls;
    asm volatile("s_waitcnt lgkmcnt(0)" ::: "memory");
    if (doit) { if (c == 0) df_export<0>(O, wsf, xs, lane, hh); else df_export<8>(O, wsf, xs, lane, hh); }
    ATT_LBAR();
    if (doit) { if (c == 0) df_finish<0, true>(O, wsf, xs, tok0, h, gsub, MIX, lane, r32, hh); else df_finish<8, false>(O, wsf, xs, tok0, h, gsub, MIX, lane, r32, hh); }
    ATT_LBAR();
}
__device__ __forceinline__ void mem_finish(f32x16 (&O)[2], float l, int part, bool doit, bool pair, LAS float* wsf, LAS float* xs, int tok0, int h, bf16_t* MIX) {
    int lane = threadIdx.x & 63; asm volatile("" : "+v"(lane), "+v"(tok0));
    const int r32 = lane & 31, hh = lane >> 5;
    const float ls = sum_xor32(l);
    if (doit && part == 1) {
#pragma unroll
        for (int db = 0; db < 2; ++db)
#pragma unroll
            for (int r = 0; r < 16; ++r) xs[64 * (db * 16 + r) + lane] = O[db][r];
        xs[64 * 32 + lane] = ls;
    }
    ATT_LBAR();
    if (doit && part == 0) {
        const float lt = ls + (pair ? xs[64 * 32 + lane] : 0.f);
        if (hh == 0) wsf[r32] = 1.0f / lt;
        asm volatile("s_waitcnt lgkmcnt(0)" ::: "memory");
        unsigned short gt[16][2];
#pragma unroll
        for (int r = 0; r < 16; ++r) { const bf16_t* p = MIX + (size_t)(tok0 + crow(r, hh)) * 1024 + 768 + h * 64 + r32; gt[r][0] = p[0]; gt[r][1] = p[32]; }
#pragma unroll
        for (int r = 0; r < 16; ++r) {
            const int qr = crow(r, hh); const float a = wsf[qr];
            bf16_t* p = MIX + (size_t)(tok0 + qr) * 1024 + 768 + h * 64 + r32;
#pragma unroll
            for (int db = 0; db < 2; ++db) p[32 * db] = (bf16_t)f2bf((O[db][r] + (pair ? xs[64 * (db * 16 + r) + lane] : 0.f)) * a * bf2f(gt[r][db]));
        }
    }
    ATT_LBAR();
}
}

struct Args { const float* in[30]; float* out; unsigned char* ws; double rope_r0; double inv2pi; int ph_lo, ph_hi; };
enum { I_XP = 0, I_XS, I_MEM, I_CDK, I_CDV, I_CMK, I_CMV, I_SCONV, I_SH, I_NORMG, I_WIN, I_GQ, I_GK, I_LQ1, I_LK1, I_LQ2, I_LK2, I_GSUB, I_CONVW, I_CONVB, I_WA, I_BA, I_WX, I_BX,
       I_LAMBDA, I_MEMNG, I_WMEM, I_GMQ, I_GMK, I_WOUT };

__device__ __forceinline__ void p0_transpose_item(const float* W, int N, bf16_t* WT, int row_off, LAS float* scr, int item, int lane) {
    const int nblk = N / 32, kb = item / nblk, nb = item % nblk, k0 = 64 * kb, n0 = 32 * nb;
#pragma unroll 8
    for (int i = 0; i < 32; ++i) { const int kk = 2 * i + (lane >> 5); scr[kk * 33 + (lane & 31)] = W[(size_t)(k0 + kk) * N + n0 + (lane & 31)]; }
    asm volatile("s_waitcnt lgkmcnt(0)" ::: "memory");
    const int cl = n0 & 255, p0 = (n0 & ~255) + 128 * ((cl >> 5) & 1) + 32 * (cl >> 6);
    const int c = lane & 7;
#pragma unroll
    for (int j = 0; j < 4; ++j) { const int n = (lane >> 3) + 8 * j; const LAS float* s = scr + (8 * c) * 33 + n;
        u32x4 o; o.x = pk2(s[0 * 33], s[1 * 33]); o.y = pk2(s[2 * 33], s[3 * 33]); o.z = pk2(s[4 * 33], s[5 * 33]); o.w = pk2(s[6 * 33], s[7 * 33]);
        *(u32x4*)(WT + (size_t)(row_off + p0 + n) * 1024 + k0 + 8 * c) = o; }
    asm volatile("s_waitcnt lgkmcnt(0)" ::: "memory");
}
__device__ __forceinline__ void rms_row_to_bf16(const float* xrow, const float* g, bf16_t* orow, int lane) {
    const f32x4* xr = (const f32x4*)xrow + lane; const f32x4* gr = (const f32x4*)g + lane;
    f32x4 v[4]; float s = 0.f;
#pragma unroll
    for (int j = 0; j < 4; ++j) { v[j] = xr[64 * j]; s += (v[j].x * v[j].x + v[j].y * v[j].y) + (v[j].z * v[j].z + v[j].w * v[j].w); }
    const float rs = __builtin_amdgcn_rsqf(wave_sum(s) * (1.f / 1024.f) + EPSN);
    unsigned long long* o8 = (unsigned long long*)orow + lane;
#pragma unroll
    for (int j = 0; j < 4; ++j) { const f32x4 gg = gr[64 * j]; const f32x4 t = v[j] * gg * rs;
        o8[64 * j] = (unsigned long long)pk2(t.x, t.y) | ((unsigned long long)pk2(t.z, t.w) << 32); }
}

#define XB_TMO      128
#define XB_XCNT(j)  (256  + 64 * (j))
#define XB_XSUB(j)  (1280 + 64 * (j))
#define XB_XGEN(j)  (2304 + 64 * (j))
#define XB_TOP      3328
#define XB_TOPGEN   3392
#define XCD_BAR_WORDS 3456
#define XB_SPIN_CAP (1u << 18)

__device__ __forceinline__ unsigned xb_ld(unsigned* p)              { return __hip_atomic_load(p, __ATOMIC_RELAXED, __HIP_MEMORY_SCOPE_AGENT); }
__device__ __forceinline__ unsigned xb_add(unsigned* p, unsigned v) { return __hip_atomic_fetch_add(p, v, __ATOMIC_RELAXED, __HIP_MEMORY_SCOPE_AGENT); }
__device__ __forceinline__ unsigned xb_xcc_id() { return (unsigned)__builtin_amdgcn_s_getreg((3 << 11) | 20) & 0xFu; }
#define XB_SPIN(cond, bar) do { unsigned _sp = 0; while (cond) { __builtin_amdgcn_s_sleep(1); \
    if ((++_sp & 255u) == 0u) { if (xb_ld(&(bar)[XB_TMO])) break; if (_sp > XB_SPIN_CAP) { atomicAdd(&(bar)[XB_TMO], 1u); break; } } } } while (0)

struct XcdBarrier {
    unsigned* bar; unsigned x;
    volatile LAS unsigned* st;
};

__device__ __forceinline__ XcdBarrier xcd_barrier_post(unsigned* bar, volatile LAS unsigned* st) {
    XcdBarrier b; b.bar = bar; b.x = xb_xcc_id(); b.st = st;
    if (threadIdx.x == 0) (void)xb_add(&bar[XB_XCNT(b.x)], 1u);
    return b;
}
__device__ __forceinline__ void xcd_barrier_complete(unsigned* bar, unsigned x, unsigned& nloc, unsigned& nx) {
    const unsigned G = gridDim.x * gridDim.y * gridDim.z;
    unsigned sum, cnt, mine, sp = 0u;
    for (;;) {
        sum = 0u; cnt = 0u; mine = 0u;
#pragma unroll
        for (unsigned j = 0; j < 16; ++j) { const unsigned c = xb_ld(&bar[XB_XCNT(j)]); sum += c; cnt += (c > 0u) ? 1u : 0u; mine = (j == x) ? c : mine; }
        if (sum == G) break;
        __builtin_amdgcn_s_sleep(1);
        if ((++sp & 255u) == 0u) { if (xb_ld(&bar[XB_TMO])) break; if (sp > XB_SPIN_CAP) { atomicAdd(&bar[XB_TMO], 1u); break; } }
    }
    nloc = mine > 0u ? mine : 1u; nx = cnt > 0u ? cnt : 1u;
}

__device__ __forceinline__ void xcd_barrier(const XcdBarrier& b) {
    asm volatile("s_waitcnt vmcnt(0)" ::: "memory");
    __syncthreads();
    if (threadIdx.x == 0) {
        unsigned* bar = b.bar;
        __builtin_amdgcn_s_waitcnt(0);
        unsigned nloc = b.st[0], nx = b.st[1];
        if (nloc == 0u) { xcd_barrier_complete(bar, b.x, nloc, nx); b.st[0] = nloc; b.st[1] = nx; }
        const unsigned old = xb_add(&bar[XB_XSUB(b.x)], 1u);
        const unsigned gen = old / nloc;
        if (old + 1u == (gen + 1u) * nloc) {
            __builtin_amdgcn_fence(__ATOMIC_RELEASE, "agent");
            asm volatile("s_waitcnt vmcnt(0)" ::: "memory");
            const unsigned og = xb_add(&bar[XB_TOP], 1u);
            const unsigned tg = og / nx;
            if (og + 1u == (tg + 1u) * nx) xb_add(&bar[XB_TOPGEN], 1u);
            else XB_SPIN(xb_ld(&bar[XB_TOPGEN]) == tg, bar);
            __builtin_amdgcn_fence(__ATOMIC_ACQUIRE, "agent");
            xb_add(&bar[XB_XGEN(b.x)], 1u);
            asm volatile("s_waitcnt vmcnt(0)" ::: "memory");
        } else {
            XB_SPIN(xb_ld(&bar[XB_XGEN(b.x)]) == gen, bar);
            __builtin_amdgcn_fence(__ATOMIC_ACQUIRE, "agent");
            asm volatile("s_waitcnt vmcnt(0)" ::: "memory");
        }
    }
    __syncthreads();
}

__device__ __forceinline__ void grid_bar(unsigned* ctr, unsigned target) {
    asm volatile("s_waitcnt vmcnt(0) lgkmcnt(0)" ::: "memory");
    __syncthreads();
    if (threadIdx.x == 0) {
        __builtin_amdgcn_fence(__ATOMIC_RELEASE, "agent");
        asm volatile("s_waitcnt vmcnt(0)" ::: "memory");
        __hip_atomic_fetch_add(ctr, 1u, __ATOMIC_RELAXED, __HIP_MEMORY_SCOPE_AGENT);
        while (__hip_atomic_load(ctr, __ATOMIC_RELAXED, __HIP_MEMORY_SCOPE_AGENT) < target) __builtin_amdgcn_s_sleep(2);
        __builtin_amdgcn_fence(__ATOMIC_ACQUIRE, "agent");
        asm volatile("s_waitcnt vmcnt(0)" ::: "memory");
    }
    __syncthreads();
}

__device__ __forceinline__ void stagger(bool late, unsigned ticks) {
    if (late) { const unsigned long long t0 = __builtin_amdgcn_s_memrealtime(); while (__builtin_amdgcn_s_memrealtime() - t0 < ticks) __builtin_amdgcn_s_sleep(20); }
}

__global__ void __launch_bounds__(512, 2) fwd_kernel(Args args) {
    extern __shared__ __attribute__((aligned(16))) unsigned char lds[];
    const int tid = threadIdx.x, lane = tid & 63; const int wave = __builtin_amdgcn_readfirstlane(tid >> 6);
    const int G = gridDim.x, bx = blockIdx.x;
    const int vcu = (G % 8 == 0) ? (bx % 8) * (G / 8) + bx / 8 : bx;
    unsigned char* ws = args.ws; float* out = args.out;
    const int lo = args.ph_lo, hi = args.ph_hi;
#define IN(k) (lo <= (k) && (k) < hi)
#define GRID_SYNC(k) do { if (IN(k) && IN((k) + 1)) xcd_barrier(xbar); } while (0)
    XcdBarrier xbar; xbar.bar = (unsigned*)(ws + WS_BAR); xbar.x = 0; xbar.st = (volatile LAS unsigned*)((LAS unsigned char*)lds + LDS_BYTES - 16);
    if (hi - lo > 1) {
        if (bx == 0) for (int i = tid; i < XCD_BAR_WORDS; i += 512) __hip_atomic_store((unsigned*)(ws + WS_BAR) + i, 0u, __ATOMIC_RELAXED, __HIP_MEMORY_SCOPE_AGENT);
        if (tid < 2) xbar.st[tid] = 0u;
        cg::this_grid().sync();
        xbar = xcd_barrier_post((unsigned*)(ws + WS_BAR), xbar.st);
    }

    if (IN(0)) {
        bf16_t* const WIN = (bf16_t*)(ws + WS_WIN); bf16_t* const WOUT = (bf16_t*)(ws + WS_WOUT); f32x2v* const ROPE = (f32x2v*)(ws + WS_ROPE); bf16_t* const AALL = (bf16_t*)(ws + WS_AALL); bf16_t* const KS = (bf16_t*)(ws + WS_KS); bf16_t* const VS = (bf16_t*)(ws + WS_VS); bf16_t* const MKA = (bf16_t*)(ws + WS_MKA); bf16_t* const MVA = (bf16_t*)(ws + WS_MVA);
#ifndef SKIP_P0
        LAS float* scr = (LAS float*)((LAS unsigned char*)lds + wave * 16384);
        const int gw = vcu * 8 + wave, NGW = G * 8;
        constexpr int I_IN = 16 * 96, I_MEMW = 16 * 16, I_OUTW = 16 * 32;
        for (int it = gw; it < I_IN + I_MEMW + I_OUTW; it += NGW) {
            int r = it;
            if (r < I_IN) { p0_transpose_item(args.in[I_WIN], 3072, WIN, 0, scr, r, lane); continue; } r -= I_IN;
            if (r < I_MEMW) { p0_transpose_item(args.in[I_WMEM], 512, WIN, 3072, scr, r, lane); continue; } r -= I_MEMW;
            p0_transpose_item(args.in[I_WOUT], 1024, WOUT, 0, scr, r, lane);
        }
        for (int m = gw; m < AROWS; m += NGW) {
            const float* src = m < NTOK_P ? args.in[I_XP] + (size_t)m * 1024 : m < NTOK ? args.in[I_XS] + (size_t)(m - NTOK_P) * 1024 : args.in[I_MEM] + (size_t)(m - NTOK) * 1024;
            rms_row_to_bf16(src, m < NTOK ? args.in[I_NORMG] : args.in[I_MEMNG], AALL + (size_t)m * 1024, lane);
        }
        for (int m = gw; m < 2 * SBAT * PAST; m += NGW) {
            const int which = m >= SBAT * PAST, r = which ? m - SBAT * PAST : m, b = r >> 10, t = r & 1023;
            const f32x4* s = (const f32x4*)(args.in[which ? I_CDV : I_CDK] + (size_t)r * 512) + 2 * lane; const f32x4 a = s[0], c = s[1];
            u32x4 o; o.x = pk2(a.x, a.y); o.y = pk2(a.z, a.w); o.z = pk2(c.x, c.y); o.w = pk2(c.z, c.w);
            *((u32x4*)((which ? VS : KS) + ((size_t)b * KSROWS + t) * 512) + lane) = o;
        }
        for (int m = gw; m < 2 * SBAT * 256; m += NGW) {
            const int which = m >= SBAT * 256, r = which ? m - SBAT * 256 : m;
            const f32x4 a = *((const f32x4*)(args.in[which ? I_CMV : I_CMK] + (size_t)r * 256) + lane);
            u32x2 o; o.x = pk2(a.x, a.y); o.y = pk2(a.z, a.w);
            *((u32x2*)((which ? MVA : MKA) + (size_t)(NMEMROW + r) * 256) + lane) = o;
        }
        if (vcu == 0 && tid < 256) { const int k = tid >> 6; const float* src = k == 0 ? args.in[I_GQ] : k == 1 ? args.in[I_GK] : k == 2 ? args.in[I_GMQ] : args.in[I_GMK];
            ((float*)(ws + WS_GAIN))[tid] = src[tid & 63]; }
        for (int idx = (vcu * 512 + tid); idx < SEQ * 8; idx += G * 512) {
            const int pos = idx >> 3, i = idx & 7; double f = args.inv2pi;
            for (int k = 0; k < i; ++k) f *= args.rope_r0;
            double rev = (double)pos * f; rev -= __builtin_rint(rev);
            const float fr = (float)rev; ROPE[idx] = (f32x2v){__builtin_amdgcn_cosf(fr), __builtin_amdgcn_sinf(fr)};
        }
#endif
        asm volatile("s_waitcnt vmcnt(0) lgkmcnt(0)" ::: "memory"); __syncthreads();
    }
    GRID_SYNC(0);

    if (IN(1)) {
        bf16_t* const WIN = (bf16_t*)(ws + WS_WIN); bf16_t* const AALL = (bf16_t*)(ws + WS_AALL);
#ifndef SKIP_P1

        {   const f32x2v* const ROPE = (const f32x2v*)(ws + WS_ROPE); LAS f32x2v* tr = (LAS f32x2v*)((LAS unsigned char*)lds + LDS_TR); LAS f32x2v* ta = (LAS f32x2v*)((LAS unsigned char*)lds + LDS_TA);
            for (int i = tid; i < 1024; i += 512) tr[i] = ROPE[i];
            ta[tid] = ROPE[(size_t)(tid >> 3) * 128 * 8 + (tid & 7)];
            if (tid < 256) ((LAS float*)((LAS unsigned char*)lds + LDS_GAIN))[tid] = ((const float*)(ws + WS_GAIN))[tid];
            asm volatile("s_waitcnt vmcnt(0) lgkmcnt(0)" ::: "memory"); __syncthreads(); }
        pg8::Gemm g{AALL, WIN, AROWS, 3584, 1024}; SchedIn S{G, bx};
        EpiIn E{ws, out, (LAS unsigned char*)lds};
        pg8::gemm_phase<EpiIn, SchedIn, true, true>((LAS unsigned char*)lds, g, S, E);
#ifdef REP_P1
        asm volatile("s_waitcnt vmcnt(0) lgkmcnt(0)" ::: "memory"); __syncthreads();
        pg8::gemm_phase<EpiIn, SchedIn, true, true>((LAS unsigned char*)lds, g, S, E);
#endif
#endif
        asm volatile("s_waitcnt vmcnt(0) lgkmcnt(0)" ::: "memory"); __syncthreads();
    }
    GRID_SYNC(1);

    if (IN(2)) {
        bf16_t* const QB = (bf16_t*)(ws + WS_QB); bf16_t* const KB = (bf16_t*)(ws + WS_KB); bf16_t* const VB = (bf16_t*)(ws + WS_VB); bf16_t* const KS = (bf16_t*)(ws + WS_KS); bf16_t* const VS = (bf16_t*)(ws + WS_VS); bf16_t* const MIX = (bf16_t*)(ws + WS_MIX); float* const LX = (float*)(ws + WS_LX); bf16_t* const MQ = (bf16_t*)(ws + WS_MQ); bf16_t* const MKA = (bf16_t*)(ws + WS_MKA); bf16_t* const MVA = (bf16_t*)(ws + WS_MVA); float* const HL = (float*)(ws + WS_HL); float* const AC = (float*)(ws + WS_AC); float* const SEGA = (float*)(ws + WS_SEGA); float* const SEGH = (float*)(ws + WS_SEGH);
        LAS float* wsf = (LAS float*)((LAS unsigned char*)lds + LDS_WSF) + wave * 64;
        float lam;
        { const float d1 = wave_sum(args.in[I_LQ1][lane] * args.in[I_LK1][lane]), d2 = wave_sum(args.in[I_LQ2][lane] * args.in[I_LK2][lane]); lam = expf(d1) - expf(d2) + LAMBDA_INIT; }
        const int r32 = lane & 31;
#ifndef SKIP_P2A
        const int qg = wave & 3, cw = wave >> 2;
        LAS float* xs = (LAS float*)lds + qg * 4160;
        for (int vv = vcu; vv < 256; vv += G) {
            const int xcd = vv >> 5, kk = vv & 31;
#pragma nounroll
            for (int i = 0; i < 8; ++i) {
                const int bh = xcd * 4 + (i >> 1), b = bh >> 2, h = bh & 3;
                const int qb = (i & 1) ? 63 - kk : kk;
                const int tok0 = b * SEQ + qb * 128 + qg * 32;
                {   att::f32x16 O[4]; float l = 0.f;
#pragma unroll
                    for (int db = 0; db < 4; ++db) O[db] = att::f32x16{};
                    att::attn_loop<2, 128>(lds, QB + (size_t)(tok0 + r32) * 512 + h * 128, (const unsigned char*)(KB + (size_t)b * SEQ * 512 + h * 128), (const unsigned char*)(VB + (size_t)b * SEQ * 512 + h * 128),
                                           1024, 2 * qb + 2, 2, 0, 2 * qb + (qg >> 1), cw, O, l);
#ifdef REP_ATT
                    att::attn_loop<2, 128>(lds, QB + (size_t)(tok0 + r32) * 512 + h * 128, (const unsigned char*)(KB + (size_t)b * SEQ * 512 + h * 128), (const unsigned char*)(VB + (size_t)b * SEQ * 512 + h * 128),
                                           1024, 2 * qb + 2, 2, 0, 2 * qb + (qg >> 1), cw, O, l);
#endif
                    att::diff_finish(O, l, cw, true, lam, wsf, xs, tok0, h, args.in[I_GSUB], MIX); }
                {   att::f32x16 O[2]; float l = 0.f; O[0] = att::f32x16{}; O[1] = att::f32x16{};
                    att::attn_loop<1, 64>(lds, MQ + (size_t)(tok0 + r32) * 256 + h * 64, (const unsigned char*)(MKA + (size_t)b * 256 * 256 + h * 64), (const unsigned char*)(MVA + (size_t)b * 256 * 256 + h * 64),
                                          512, 4, 2, 2, cw, 0, O, l);
                    att::mem_finish(O, l, cw, true, true, wsf, xs, tok0, h, MIX); }
            }
        }
        for (int uu = vcu; uu < 128; uu += G) {
            const int b = uu >> 2, h = uu & 3, tok0 = NTOK_P + b * 32;
            {   att::f32x16 O[4]; float l = 0.f;
#pragma unroll
                for (int db = 0; db < 4; ++db) O[db] = att::f32x16{};
                att::attn_loop<2, 128>(lds, QB + (size_t)(tok0 + r32) * 512 + h * 128, (const unsigned char*)(KS + (size_t)b * KSROWS * 512 + h * 128), (const unsigned char*)(VS + (size_t)b * KSROWS * 512 + h * 128),
                                       1024, 17, 1, 1, qg, cw, O, l);
                att::tree_reduce4<4>(O, l, (LAS float*)lds, wave, lane);
                att::diff_finish(O, l, cw, qg == 0, lam, wsf, (LAS float*)lds, tok0, h, args.in[I_GSUB], MIX); }
            {   att::f32x16 O[2]; float l = 0.f; O[0] = att::f32x16{}; O[1] = att::f32x16{};
                att::attn_loop<1, 64>(lds, MQ + (size_t)(tok0 + r32) * 256 + h * 64, (const unsigned char*)(MKA + (size_t)(NB + b) * 256 * 256 + h * 64), (const unsigned char*)(MVA + (size_t)(NB + b) * 256 * 256 + h * 64),
                                      512, 4, 2, 1, cw == 0 ? qg : 7, 0, O, l);
                att::tree_reduce4<2>(O, l, (LAS float*)lds, wave, lane);
                att::mem_finish(O, l, 0, wave == 0, false, wsf, (LAS float*)lds, tok0, h, MIX); }
        }
#endif
#ifndef SKIP_P2L
        for (int uu = (G - 1 - vcu); uu < 640; uu += G) {
            const bool smp = uu >= 512; int b, n, row0, ntok, seg0;
            if (!smp) { b = uu >> 6; n = (uu >> 4) & 3; const int c = uu & 15; row0 = b * SEQ + c * 512; ntok = 512; seg0 = 8 * c; }
            else { const int r = uu - 512; b = r >> 2; n = r & 3; row0 = NTOK_P + b * 32; ntok = 32; seg0 = 0; }
            const int t0 = wave * 64, ch = n * 64 + lane;
            if (t0 < ntok) {
                const int ntw = (ntok - t0) < 64 ? (ntok - t0) : 64;
                const float* cw = args.in[I_CONVW]; const float cw0 = cw[ch], cw1 = cw[256 + ch], cw2 = cw[512 + ch], cw3 = cw[768 + ch], cb = args.in[I_CONVB][ch];
                float xm3, xm2, xm1;
                if (seg0 + wave > 0) { const float* p = LX + (size_t)(row0 + t0) * 256 + ch; xm3 = p[-3 * 256]; xm2 = p[-2 * 256]; xm1 = p[-256]; }
                else if (smp) { const float* p = args.in[I_SCONV] + (size_t)b * 3 * 256 + ch; xm3 = p[0]; xm2 = p[256]; xm1 = p[512]; }
                else { xm3 = 0.f; xm2 = 0.f; xm1 = 0.f; }
                LAS float* xc = (LAS float*)lds + wave * 4096;
                for (int tb = 0; tb < ntw; tb += 16) {
                    float xb[16];
#pragma unroll
                    for (int k = 0; k < 16; ++k) xb[k] = LX[(size_t)(row0 + t0 + tb + k) * 256 + ch];
#pragma unroll
                    for (int k = 0; k < 16; ++k) { const float x = xb[k]; xc[(tb + k) * 64 + lane] = cb + cw0 * xm3 + cw1 * xm2 + cw2 * xm1 + cw3 * x; xm3 = xm2; xm2 = xm1; xm1 = x; }
                }
                asm volatile("s_waitcnt lgkmcnt(0)" ::: "memory");
                f32x2v w2[64];
                { const float* pa = args.in[I_WA] + (size_t)n * 4096 + lane; const float* px = args.in[I_WX] + (size_t)n * 4096 + lane;
#pragma unroll
                  for (int i = 0; i < 64; ++i) w2[i] = (f32x2v){pa[i * 64], px[i * 64]}; }
                const float ba = args.in[I_BA][ch], bxx = args.in[I_BX][ch];
                const float sp = log1pf(expf(-args.in[I_LAMBDA][ch]));
                float hcur = smp ? args.in[I_SH][(size_t)b * 256 + ch] : 0.f, acur = 1.f;
                for (int t = 0; t < ntw; ++t) {
                    f32x2v g2 = {ba, bxx};
#pragma unroll
                    for (int i4 = 0; i4 < 16; ++i4) { const f32x4 xv = *(LAS const f32x4*)(xc + t * 64 + 4 * i4);
                        g2 = __builtin_elementwise_fma((f32x2v){xv.x, xv.x}, w2[4 * i4], g2); g2 = __builtin_elementwise_fma((f32x2v){xv.y, xv.y}, w2[4 * i4 + 1], g2);
                        g2 = __builtin_elementwise_fma((f32x2v){xv.z, xv.z}, w2[4 * i4 + 2], g2); g2 = __builtin_elementwise_fma((f32x2v){xv.w, xv.w}, w2[4 * i4 + 3], g2); }
                    const float xcj = xc[t * 64 + lane];
                    const float rg = sigmoidf_(g2.x), ig = sigmoidf_(g2.y);
                    const float la = -8.0f * rg * sp, a = fast_exp(la), y2 = 2.0f * la;
                    const float em = -y2 * (1.0f + y2 * (0.5f + y2 * (0.16666667f + y2 * (0.041666668f + y2 * 0.008333334f))));
                    const float bb = __builtin_amdgcn_sqrtf(em) * (ig * xcj);
                    hcur = a * hcur + bb; acur *= a;
                    const size_t row = (size_t)(row0 + t0 + t);
                    if (!smp) { HL[row * 256 + ch] = hcur; AC[row * 256 + ch] = acur; }
                    else { bf16_t* p = MIX + row * 1024 + 512 + ch; *p = (bf16_t)f2bf(hcur * bf2f(*p)); }
                }
                if (!smp) { const size_t si = ((size_t)b * 128 + seg0 + wave) * 256 + ch; SEGA[si] = acur; SEGH[si] = hcur; }
                else { out[O_HS + (size_t)b * 256 + ch] = hcur;
#pragma unroll
                    for (int k = 0; k < 3; ++k) out[O_CS + ((size_t)b * 3 + k) * 256 + ch] = LX[(size_t)(row0 + 29 + k) * 256 + ch]; }
            }
            asm volatile("s_waitcnt lgkmcnt(0)" ::: "memory"); __syncthreads();
        }
#endif
        asm volatile("s_waitcnt vmcnt(0) lgkmcnt(0)" ::: "memory"); __syncthreads();
    }
    GRID_SYNC(2);

    if (IN(3)) {
        bf16_t* const MIX = (bf16_t*)(ws + WS_MIX); float* const LX = (float*)(ws + WS_LX); float* const HL = (float*)(ws + WS_HL); float* const AC = (float*)(ws + WS_AC); float* const SEGA = (float*)(ws + WS_SEGA); float* const SEGH = (float*)(ws + WS_SEGH);
#ifndef SKIP_P3
        if (G >= 32 && vcu < 16) {
            bf16_t* const WOUT = (bf16_t*)(ws + WS_WOUT);
            pg8::Gemm g{MIX, WOUT, NTOK, 1024, 1024}; SchedOne S{NTOK_P / 256 + (vcu >> 2), vcu & 3};
            EpiOut E{args.in[I_XP], args.in[I_XS], out, (LAS unsigned char*)lds};
            pg8::gemm_phase<EpiOut, SchedOne, true, true>((LAS unsigned char*)lds, g, S, E);
        } else
        for (int uu = (G >= 32 ? vcu - 16 : vcu); uu < 256; uu += (G >= 32 ? G - 16 : G)) {
            const int b = uu >> 5, gI = uu & 31, ch = tid & 255, th = tid >> 8, s0 = 4 * gI + 2 * th;
            const float* sa = SEGA + (size_t)b * 128 * 256 + ch; const float* sh = SEGH + (size_t)b * 128 * 256 + ch;
            float H = 0.f;
            {   int s = 0;
                for (; s + 16 <= s0; s += 16) { float av[16], hv[16];
#pragma unroll
                    for (int k = 0; k < 16; ++k) { av[k] = sa[(s + k) * 256]; hv[k] = sh[(s + k) * 256]; }
#pragma unroll
                    for (int k = 0; k < 16; ++k) H = av[k] * H + hv[k]; }
                for (; s < s0; ++s) H = sa[s * 256] * H + sh[s * 256]; }
            for (int s = s0; s < s0 + 2; ++s) {
                const size_t rbase = (size_t)b * SEQ + 64 * s;
#pragma unroll 8
                for (int t = 0; t < 64; ++t) { const size_t row = rbase + t; const float hv = HL[row * 256 + ch] + AC[row * 256 + ch] * H;
                    bf16_t* p = MIX + row * 1024 + 512 + ch; *p = (bf16_t)f2bf(hv * bf2f(*p));
                    if (s == 127 && t == 63) out[O_HP + (size_t)b * 256 + ch] = hv; }
                H = sa[s * 256] * H + sh[s * 256];
            }
            if (gI == 31 && th == 0) {
#pragma unroll
                for (int k = 0; k < 3; ++k) out[O_CP + ((size_t)b * 3 + k) * 256 + ch] = LX[((size_t)b * SEQ + SEQ - 3 + k) * 256 + ch];
            }
        }
#endif
        asm volatile("s_waitcnt vmcnt(0) lgkmcnt(0)" ::: "memory"); __syncthreads();
    }
    GRID_SYNC(3);

    if (IN(4)) {
        bf16_t* const MIX = (bf16_t*)(ws + WS_MIX); bf16_t* const WOUT = (bf16_t*)(ws + WS_WOUT);
#ifndef SKIP_P4

        pg8::Gemm g{MIX, WOUT, NTOK, 1024, 1024}; SchedOut S{G, bx};
        EpiOut E{args.in[I_XP], args.in[I_XS], out, (LAS unsigned char*)lds};
        pg8::gemm_phase<EpiOut, SchedOut, true, true>((LAS unsigned char*)lds, g, S, E);
        if (G < 32) { asm volatile("s_waitcnt vmcnt(0) lgkmcnt(0)" ::: "memory"); __syncthreads();
            for (int k = bx; k < 16; k += G) { SchedOne S1{NTOK_P / 256 + (k >> 2), k & 3}; pg8::gemm_phase<EpiOut, SchedOne, true, true>((LAS unsigned char*)lds, g, S1, E); asm volatile("s_waitcnt vmcnt(0) lgkmcnt(0)" ::: "memory"); __syncthreads(); } }
#ifdef REP_P4
        asm volatile("s_waitcnt vmcnt(0) lgkmcnt(0)" ::: "memory"); __syncthreads();
        pg8::gemm_phase<EpiOut, SchedOut, true, true>((LAS unsigned char*)lds, g, S, E);
#endif
#endif
    }
#undef IN
#undef GRID_SYNC
}

extern "C" void kernel_launch(void* const* d_in, const int* in_sizes, int n_in, void* d_out, int out_size, void* d_ws, size_t ws_size, hipStream_t stream) {
    static int grid = 0;
    if (grid == 0) {
        if (n_in != 30 || (size_t)out_size != O_END || ws_size < WS_END) { fprintf(stderr, "kernel_launch: unexpected shapes (n_in %d out %d ws %zu)\n", n_in, out_size, ws_size); grid = -1; return; }
        int dev = 0, cus = 0, per_cu = 0;
        hipGetDevice(&dev); hipDeviceGetAttribute(&cus, hipDeviceAttributeMultiprocessorCount, dev);
        if (hipFuncSetAttribute((const void*)fwd_kernel, hipFuncAttributeMaxDynamicSharedMemorySize, LDS_BYTES) != hipSuccess) { fprintf(stderr, "kernel_launch: hipFuncSetAttribute failed\n"); grid = -1; return; }
        if (hipOccupancyMaxActiveBlocksPerMultiprocessor(&per_cu, (const void*)fwd_kernel, 512, LDS_BYTES) != hipSuccess || per_cu < 1) { fprintf(stderr, "kernel_launch: occupancy query says %d\n", per_cu); per_cu = 1; }
        (void)hipGetLastError();
        grid = cus;
    }
    if (grid < 0) return;
    Args a{};
    for (int i = 0; i < 30; ++i) a.in[i] = (const float*)d_in[i];
    a.out = (float*)d_out; a.ws = (unsigned char*)d_ws;
    a.rope_r0 = std::pow(500000.0, -1.0 / 8.0); a.inv2pi = 1.0 / (2.0 * M_PI);
#if MK_N_LAUNCHES == 1
    a.ph_lo = 0; a.ph_hi = 5;
    void* kargs[] = {&a};
    hipError_t e = hipLaunchCooperativeKernel((const void*)fwd_kernel, dim3(grid), dim3(512), kargs, LDS_BYTES, stream);
    if (e != hipSuccess) fprintf(stderr, "cooperative launch failed: %s (grid %d)\n", hipGetErrorString(e), grid);
#else
    for (int p = 0; p < 5; ++p) { a.ph_lo = p; a.ph_hi = p + 1; hipLaunchKernelGGL(fwd_kernel, dim3(grid), dim3(512), LDS_BYTES, stream, a); }
#endif
}
```
